# Optimizing an MI355X kernel written in HIP

```python
import math
import jax, jax.numpy as jnp
from jax import lax
import numpy as np

D_MODEL = 1024
BATCH = 8
SEQ = 2048
DEPTH = 1
DEC_BATCH = 128
DEC_SEQ = 4
PAST_LEN = 16384
PAGE_SIZE = 128

RET_HEADS = 4
RET_DK = 128
RET_DV = 128
RET_W = RET_HEADS * RET_DV
RET_CHUNK = 64
HG_HEADS = 4
HG_DK = 128
HG_DV = 128
HG_W = HG_HEADS * HG_DV
HG_CHUNK = 32
MIX_W = RET_W + HG_W
IN_W = 2 * RET_HEADS * RET_DK + 2 * RET_W + 2 * HG_HEADS * HG_DK + 2 * HG_W
N_MEM = 256
XA_HEADS = 4
XA_HD = D_MODEL // XA_HEADS
D_FF = -(-8 * D_MODEL // (3 * 256)) * 256
ROPE_BASE = 10000.0
EPS = 1e-6

kernel_name = 'hymba_retention_hgrn2_memxattn_step'


def _rmsnorm(x, g):
    xf = x.astype(jnp.float32)
    y = xf * lax.rsqrt(jnp.mean(xf * xf, axis=-1, keepdims=True) + EPS)
    return (y * g.astype(jnp.float32)).astype(x.dtype)


def _split_heads(x, n_heads):
    b, t, _ = x.shape
    return x.reshape(b, t, n_heads, -1).transpose(0, 2, 1, 3).astype(jnp.float32)


def _merge_heads(x):
    b, h, t, d = x.shape
    return x.transpose(0, 2, 1, 3).reshape(b, t, h * d)


def _head_rmsnorm(o):
    return o * lax.rsqrt(jnp.mean(o * o, axis=-1, keepdims=True) + EPS)


def _rotary(x, pos):
    half = x.shape[-1] // 2
    inv_freq = ROPE_BASE ** (-jnp.arange(half, dtype=jnp.float32) / half)
    ang = pos[:, None] * inv_freq[None, :]
    cos, sin = jnp.cos(ang), jnp.sin(ang)
    x1, x2 = x[..., :half], x[..., half:]
    return jnp.concatenate([x1 * cos - x2 * sin, x1 * sin + x2 * cos], axis=-1)


def _to_chunks(x, L):
    b, h, t, d = x.shape
    return x.reshape(b, h, t // L, L, d).transpose(2, 0, 1, 3, 4)


def _from_chunks(x):
    n, b, h, L, d = x.shape
    return x.transpose(1, 2, 0, 3, 4).reshape(b, h, n * L, d)


def _retention(q, k, v, s0):
    t = q.shape[2]
    L = math.gcd(t, RET_CHUNK)
    log_g = jnp.log(1.0 - 2.0 ** (-5.0 - jnp.arange(RET_HEADS, dtype=jnp.float32)))
    idx = jnp.arange(L, dtype=jnp.float32)
    rel = idx[:, None] - idx[None, :]
    causal = rel >= 0
    decay = jnp.where(causal, jnp.exp(log_g[:, None, None] * jnp.where(causal, rel, 0.0)), 0.0)
    q_dec = jnp.exp(log_g[:, None] * (idx + 1.0))[..., None]
    k_dec = jnp.exp(log_g[:, None] * (L - 1.0 - idx))[..., None]
    s_dec = jnp.exp(log_g * L)[:, None, None]

    def step(s, chunk):
        qc, kc, vc = chunk
        att = jnp.einsum('bhld,bhmd->bhlm', qc, kc) * decay
        o = jnp.einsum('bhlm,bhme->bhle', att, vc) + jnp.einsum('bhld,bhde->bhle', qc * q_dec, s)
        s = s_dec * s + jnp.einsum('bhld,bhle->bhde', kc * k_dec, vc)
        return s, o

    s, o = lax.scan(step, s0, (_to_chunks(q, L), _to_chunks(k, L), _to_chunks(v, L)))
    return _from_chunks(o), s


def _hgrn2(q, k, v, log_f, s0):
    t = q.shape[2]
    L = math.gcd(t, HG_CHUNK)
    causal = (jnp.arange(L)[:, None] >= jnp.arange(L)[None, :])[:, :, None]

    def step(s, chunk):
        qc, kc, vc, lf = chunk
        b = jnp.cumsum(lf, axis=2)
        diff = b[:, :, :, None, :] - b[:, :, None, :, :]
        dec = jnp.where(causal, jnp.exp(jnp.where(causal, diff, 0.0)), 0.0)
        att = jnp.einsum('bhtc,bhsc,bhtsc->bhts', qc, kc, dec)
        o = jnp.einsum('bhts,bhse->bhte', att, vc) + jnp.einsum('bhtc,bhce->bhte', qc * jnp.exp(b), s)
        b_last = b[:, :, -1:, :]
        s = jnp.exp(b_last[:, :, 0, :])[..., None] * s + jnp.einsum('bhsc,bhse->bhce', kc * jnp.exp(b_last - b), vc)
        return s, o

    s, o = lax.scan(step, s0, (_to_chunks(q, L), _to_chunks(k, L), _to_chunks(v, L), _to_chunks(log_f, L)))
    return _from_chunks(o), s


def _mixer(h, offset, s_ret0, s_hg0, w_in, ret_gain, hg_gain, lower, w_out):
    b, t, _ = h.shape
    sizes = [RET_HEADS * RET_DK, RET_HEADS * RET_DK, RET_W, RET_W, HG_HEADS * HG_DK, HG_HEADS * HG_DK, HG_W, HG_W]
    points = [int(p) for p in np.cumsum(sizes)[:-1]]
    rq, rk, rv, rg, hq, hf, hi, hgate = jnp.split(h @ w_in, points, axis=-1)
    pos = jnp.arange(t, dtype=jnp.float32) + offset
    q_r = _rotary(_split_heads(rq, RET_HEADS), pos)
    k_r = _rotary(_split_heads(rk, RET_HEADS), pos) * (RET_DK ** -0.5)
    v_r = _split_heads(rv, RET_HEADS)
    o_r, s_r = _retention(q_r, k_r, v_r, s_ret0.astype(jnp.float32))
    o_r = _merge_heads(_head_rmsnorm(o_r)) * ret_gain.astype(jnp.float32) * jax.nn.silu(rg.astype(jnp.float32))
    f = lower + (1.0 - lower) * jax.nn.sigmoid(hf.astype(jnp.float32))
    q_h = _split_heads(jax.nn.silu(hq.astype(jnp.float32)), HG_HEADS)
    k_h = _split_heads(1.0 - f, HG_HEADS)
    v_h = _split_heads(hi, HG_HEADS)
    o_h, s_h = _hgrn2(q_h, k_h, v_h, _split_heads(jnp.log(f), HG_HEADS), s_hg0.astype(jnp.float32))
    o_h = _merge_heads(_head_rmsnorm(o_h)) * hg_gain.astype(jnp.float32) * jax.nn.silu(hgate.astype(jnp.float32))
    out = jnp.concatenate([o_r, o_h], axis=-1).astype(h.dtype) @ w_out
    return out, s_r, s_h


def _mem_kv(mem, g_mem, w_xk, w_xv):
    b = mem.shape[0]
    m = _rmsnorm(mem, g_mem)
    k = (m @ w_xk).reshape(b, N_MEM, XA_HEADS, XA_HD)
    v = (m @ w_xv).reshape(b, N_MEM, XA_HEADS, XA_HD)
    return k, v


def _cross_attn(h, mk, mv, w_xq, w_xo):
    b, t, _ = h.shape
    q = (h @ w_xq).reshape(b, t, XA_HEADS, XA_HD)
    s = jnp.einsum('bthd,bmhd->bhtm', q, mk).astype(jnp.float32) * (XA_HD ** -0.5)
    p = jax.nn.softmax(s, axis=-1).astype(mv.dtype)
    o = jnp.einsum('bhtm,bmhd->bthd', p, mv).reshape(b, t, XA_HEADS * XA_HD)
    return o @ w_xo


def _swiglu(h, w_gate, w_up, w_down):
    return (jax.nn.silu(h @ w_gate) * (h @ w_up)) @ w_down


def _forward(x, offset, s_ret, s_hg, mem_k, mem_v, g_mix, w_in, ret_gain, hg_gain, hg_lb, w_out,
             g_xa, w_xq, w_xo, g_ffn, w_gate, w_up, w_down, g_final):
    lower_all = jnp.cumsum(jax.nn.softmax(hg_lb.astype(jnp.float32), axis=0), axis=0)
    new_ret, new_hg = [], []
    for l in range(DEPTH):
        mix, s_r, s_h = _mixer(_rmsnorm(x, g_mix[l]), offset, s_ret[l], s_hg[l], w_in[l],
                               ret_gain[l], hg_gain[l], lower_all[l], w_out[l])
        x = x + mix
        x = x + _cross_attn(_rmsnorm(x, g_xa[l]), mem_k[l], mem_v[l], w_xq[l], w_xo[l])
        x = x + _swiglu(_rmsnorm(x, g_ffn[l]), w_gate[l], w_up[l], w_down[l])
        new_ret.append(s_r)
        new_hg.append(s_h)
    return _rmsnorm(x, g_final), jnp.stack(new_ret).astype(x.dtype), jnp.stack(new_hg).astype(x.dtype)


def setup_inputs(seed: int = 0) -> dict:
    key = jax.random.key(seed)
    ks = jax.random.split(key, 24)

    def nrm(k, shape, scale):
        return jax.random.normal(k, shape, jnp.float32) * scale

    def gain(k, shape):
        return 1.0 + 0.01 * jax.random.normal(k, shape, jnp.float32)

    d = D_MODEL
    return {
        'x_prompt': nrm(ks[0], (BATCH, SEQ, d), 1.0),
        'x_sample': nrm(ks[1], (DEC_BATCH, DEC_SEQ, d), 1.0),
        'mem_prompt': nrm(ks[2], (BATCH, N_MEM, d), 1.0),
        'state_ret': nrm(ks[3], (DEPTH, DEC_BATCH, RET_HEADS, RET_DK, RET_DV), 0.5),
        'state_hgrn': nrm(ks[4], (DEPTH, DEC_BATCH, HG_HEADS, HG_DK, HG_DV), 0.5),
        'cache_mem_k': nrm(ks[5], (DEPTH, DEC_BATCH, N_MEM, XA_HEADS, XA_HD), 1.0),
        'cache_mem_v': nrm(ks[6], (DEPTH, DEC_BATCH, N_MEM, XA_HEADS, XA_HD), 1.0),
        'g_mix': gain(ks[7], (DEPTH, d)),
        'w_in': nrm(ks[8], (DEPTH, d, IN_W), d ** -0.5),
        'ret_gain': gain(ks[9], (DEPTH, RET_W)),
        'hg_gain': gain(ks[10], (DEPTH, HG_W)),
        'hg_lb': nrm(ks[11], (DEPTH + 1, HG_HEADS * HG_DK), 0.1),
        'w_out': nrm(ks[12], (DEPTH, MIX_W, d), MIX_W ** -0.5),
        'g_xa': gain(ks[13], (DEPTH, d)),
        'g_mem': gain(ks[14], (DEPTH, d)),
        'w_xq': nrm(ks[15], (DEPTH, d, XA_HEADS * XA_HD), d ** -0.5),
        'w_xk': nrm(ks[16], (DEPTH, d, XA_HEADS * XA_HD), d ** -0.5),
        'w_xv': nrm(ks[17], (DEPTH, d, XA_HEADS * XA_HD), d ** -0.5),
        'w_xo': nrm(ks[18], (DEPTH, XA_HEADS * XA_HD, d), (XA_HEADS * XA_HD) ** -0.5),
        'g_ffn': gain(ks[19], (DEPTH, d)),
        'w_gate': nrm(ks[20], (DEPTH, d, D_FF), d ** -0.5),
        'w_up': nrm(ks[21], (DEPTH, d, D_FF), d ** -0.5),
        'w_down': nrm(ks[22], (DEPTH, D_FF, d), D_FF ** -0.5),
        'g_final': gain(ks[23], (d,)),
    }


def reference(x_prompt, x_sample, mem_prompt, state_ret, state_hgrn, cache_mem_k, cache_mem_v,
              g_mix, w_in, ret_gain, hg_gain, hg_lb, w_out, g_xa, g_mem, w_xq, w_xk, w_xv, w_xo,
              g_ffn, w_gate, w_up, w_down, g_final):
    b = x_prompt.shape[0]
    mk, mv = [], []
    for l in range(DEPTH):
        k_l, v_l = _mem_kv(mem_prompt, g_mem[l], w_xk[l], w_xv[l])
        mk.append(k_l)
        mv.append(v_l)
    mem_k_prompt = jnp.stack(mk)
    mem_v_prompt = jnp.stack(mv)
    zero_ret = jnp.zeros((DEPTH, b, RET_HEADS, RET_DK, RET_DV), jnp.float32)
    zero_hg = jnp.zeros((DEPTH, b, HG_HEADS, HG_DK, HG_DV), jnp.float32)
    y_prompt, ret_p, hg_p = _forward(x_prompt, 0, zero_ret, zero_hg, mem_k_prompt, mem_v_prompt,
                                     g_mix, w_in, ret_gain, hg_gain, hg_lb, w_out, g_xa, w_xq, w_xo,
                                     g_ffn, w_gate, w_up, w_down, g_final)
    y_sample, ret_s, hg_s = _forward(x_sample, PAST_LEN, state_ret, state_hgrn, cache_mem_k, cache_mem_v,
                                     g_mix, w_in, ret_gain, hg_gain, hg_lb, w_out, g_xa, w_xq, w_xo,
                                     g_ffn, w_gate, w_up, w_down, g_final)
    return (y_prompt, y_sample, ret_p, hg_p, mem_k_prompt, mem_v_prompt, ret_s, hg_s)
```

```cpp
#include <hip/hip_runtime.h>
#include <cmath>
#include <cstdio>
#include <cstdint>

#define STEP 7
namespace pg8 {
#define PG8_LAS __attribute__((address_space(3)))
typedef unsigned short bf16_t;
typedef short bf16x8 __attribute__((ext_vector_type(8)));
typedef float f32x4 __attribute__((ext_vector_type(4)));
typedef unsigned u32x4 __attribute__((ext_vector_type(4)));
constexpr int BM = 256, BK = 64, HALF = 128, HTB = HALF * BK * 2  , STAGE_BYTES = 8 * HTB, NXCD = 8, WGM = 8;

__host__ __device__ __forceinline__ int lds_byte(int r, int c) { const int st = (r >> 4) * 2 + (c >> 5), rr = r & 15, cc = c & 31, ob = rr * 64 + cc * 2; return st * 1024 + (ob ^ (((ob >> 9) & 1) << 5)); }
__host__ __device__ __forceinline__ void stage_rc(int b, int& R, int& C) { const int st = b / 1024, sb = b % 1024, swz = sb ^ (((sb >> 9) & 1) << 5); R = (st >> 1) * 16 + swz / 64; C = (st & 1) * 32 + (swz % 64) / 2; }
__host__ __device__ __forceinline__ int perm32(int rho) { const int n = rho >> 4, i = rho & 15; return 8 * (i >> 2) + 4 * n + (i & 3); }

struct Unit { int pm, pn; };
struct Gemm { const bf16_t* A; const bf16_t* Bt; int M, N, K; };

struct StaticOrder {
    int nM, nN, nwg, G, c;
    __host__ __device__ void init(int M, int N, int G_, int c_) { nM = M / BM; nN = N / BM; nwg = nM * nN; G = G_; c = c_; }
    __host__ __device__ bool next(int i, Unit& u) const {
        const long L = (long)i * G + c; if (L >= nwg) return false;
        int wgid = (int)L; { const int q = nwg / NXCD, r = nwg % NXCD, xcd = wgid % NXCD, off = wgid / NXCD; wgid = (xcd < r ? xcd * (q + 1) : r * (q + 1) + (xcd - r) * q) + off; }
        const int nig = WGM * nN, gid = wgid / nig, fm = gid * WGM, gsz = (nM - fm) < WGM ? (nM - fm) : WGM;
        u.pm = fm + ((wgid % nig) % gsz); u.pn = (wgid % nig) / gsz; return true;
    }
    __device__ __forceinline__ void a_ready(const Unit&) const {}
    __device__ __forceinline__ void done(const Unit&) const {}
};

template <class Epi, class Sched, bool ALIGN_EPI = false, bool SP2 = false>
__device__ __forceinline__ void gemm_phase(PG8_LAS unsigned char* lds, const Gemm g, const Sched& S, const Epi& E) {
    const int tid = threadIdx.x, wid = __builtin_amdgcn_readfirstlane(tid >> 6), lane = tid & 63, wr = wid >> 2, wc = wid & 3, fr = lane & 15, fq = lane >> 4;
    const int K = g.K, nt = K / BK;
    unsigned voffA[2], voffB[2];
#pragma unroll
    for (int i = 0; i < 2; ++i) { int R, C; stage_rc(tid * 16 + i * 8192, R, C); const int Rb = Epi::PERM ? ((R & ~31) + perm32(R & 31)) : R;
        voffA[i] = (unsigned)(R * K + C) * 2u; voffB[i] = (unsigned)(Rb * K + C) * 2u; }
    const size_t kstep = (size_t)(BK * 2);
    const size_t hstep = (size_t)HALF * K * 2;
    const size_t tstep = 2 * hstep;
    const unsigned ldsw = (unsigned)wid * 1024u;
    const int aoff = lds_byte(wr * 64 + fr, fq * 8), boff = lds_byte(wc * 32 + fr, fq * 8);
#define PG8_SA(b, h) (((b) * 2 + (h)) * HTB)
#define PG8_SB(b, h) ((4 + (b) * 2 + (h)) * HTB)
#define PG8_STAGE(bufoff, gbase, voff) do { _Pragma("unroll") for (int _i = 0; _i < 2; ++_i) \
        __builtin_amdgcn_global_load_lds((const unsigned*)((const char*)(gbase) + (voff)[_i]), (PG8_LAS unsigned*)(lds + (bufoff) + ldsw + _i * 8192), 16, 0, 0); } while (0)
#define PG8_LDA(dst, b, h) do { _Pragma("unroll") for (int m = 0; m < 4; ++m) _Pragma("unroll") for (int k = 0; k < 2; ++k) dst[m][k] = *(const PG8_LAS bf16x8*)(lds + PG8_SA(b, h) + aoff + m * 2048 + k * 1024); } while (0)
#define PG8_LDB(dst, b, h) do { _Pragma("unroll") for (int n = 0; n < 2; ++n) _Pragma("unroll") for (int k = 0; k < 2; ++k) dst[n][k] = *(const PG8_LAS bf16x8*)(lds + PG8_SB(b, h) + boff + n * 2048 + k * 1024); } while (0)
#define PG8_MMA(ai, bj, At, Bt) do { __builtin_amdgcn_s_setprio(1); _Pragma("unroll") for (int m = 0; m < 4; ++m) _Pragma("unroll") for (int n = 0; n < 2; ++n) _Pragma("unroll") for (int k = 0; k < 2; ++k) \
        acc[ai][bj][m][n] = __builtin_amdgcn_mfma_f32_16x16x32_bf16(Bt[n][k], At[m][k], acc[ai][bj][m][n], 0, 0, 0); __builtin_amdgcn_s_setprio(0); } while (0)
#define PG8_WAIT_V(n) asm volatile("s_waitcnt vmcnt(" #n ")" ::: "memory")
#define PG8_WAIT_L(n) asm volatile("s_waitcnt lgkmcnt(" #n ")" ::: "memory")
#define PG8_BAR __builtin_amdgcn_s_barrier()
#define PG8_SCHED __builtin_amdgcn_sched_barrier(0)
    Unit cur, nxt; int ui = 0;
    if (!S.next(0, cur)) return;
    f32x4 acc[2][2][4][2];
#pragma unroll
    for (int a = 0; a < 2; ++a)
#pragma unroll
        for (int b = 0; b < 2; ++b)
#pragma unroll
            for (int m = 0; m < 4; ++m)
#pragma unroll
                for (int n = 0; n < 2; ++n) acc[a][b][m][n] = (f32x4){0.f, 0.f, 0.f, 0.f};
    bf16x8 At[4][2], B0[2][2], B1[2][2];
    const char* cA = (const char*)g.A + (size_t)cur.pm * tstep; const char* cB = (const char*)g.Bt + (size_t)cur.pn * tstep;
    S.a_ready(cur);
    if constexpr (SP2) {
        PG8_STAGE(PG8_SB(0, 0), cB, voffB); PG8_STAGE(PG8_SB(0, 1), cB + hstep, voffB); PG8_STAGE(PG8_SA(0, 0), cA, voffA); PG8_STAGE(PG8_SA(0, 1), cA + hstep, voffA);
        if (wr == 1) PG8_BAR;
        PG8_WAIT_V(2); PG8_BAR;
        PG8_STAGE(PG8_SB(1, 0), cB + kstep, voffB); PG8_STAGE(PG8_SA(1, 0), cA + kstep, voffA); PG8_STAGE(PG8_SB(1, 1), cB + hstep + kstep, voffB);
        PG8_WAIT_V(6); PG8_BAR;
    } else {
        PG8_STAGE(PG8_SB(0, 0), cB, voffB); PG8_STAGE(PG8_SA(0, 0), cA, voffA); PG8_STAGE(PG8_SB(0, 1), cB + hstep, voffB); PG8_STAGE(PG8_SA(0, 1), cA + hstep, voffA);
        if (wr == 1) PG8_BAR;
        PG8_WAIT_V(4); PG8_BAR;
        PG8_STAGE(PG8_SB(1, 0), cB + kstep, voffB); PG8_STAGE(PG8_SA(1, 0), cA + kstep, voffA); PG8_STAGE(PG8_SB(1, 1), cB + hstep + kstep, voffB);
        PG8_WAIT_V(6); PG8_BAR;
    }
    for (;;) {
        const bool has_next = S.next(ui + 1, nxt);
        const char* nA = has_next ? (const char*)g.A + (size_t)nxt.pm * tstep : cA; const char* nB = has_next ? (const char*)g.Bt + (size_t)nxt.pn * tstep : cB;
        for (int t = 0; t < nt; t += 2) {
            const bool last = (t == nt - 2);
            const char* a1 = cA + (size_t)(t + 1) * kstep;
            const char* a2 = last ? nA : cA + (size_t)(t + 2) * kstep; const char* b2 = last ? nB : cB + (size_t)(t + 2) * kstep;
            const char* a3 = a2 + kstep; const char* b3 = b2 + kstep;
            if (last && has_next) S.a_ready(nxt);
            if constexpr (SP2) {
            PG8_LDB(B0, 0, 0); PG8_LDB(B1, 0, 1); PG8_SCHED; PG8_LDA(At, 0, 0); PG8_STAGE(PG8_SA(1, 1), a1 + hstep, voffA);
            PG8_WAIT_V(8); PG8_WAIT_L(0); PG8_BAR; PG8_MMA(0, 0, At, B0); PG8_MMA(0, 1, At, B1); PG8_BAR; PG8_SCHED;
            PG8_LDA(At, 0, 1); PG8_STAGE(PG8_SB(0, 0), b2, voffB); PG8_STAGE(PG8_SB(0, 1), b2 + hstep, voffB); PG8_STAGE(PG8_SA(0, 0), a2, voffA);
            PG8_WAIT_V(8); PG8_WAIT_L(0); PG8_BAR; PG8_MMA(1, 0, At, B0); PG8_MMA(1, 1, At, B1); PG8_BAR; PG8_SCHED;
            PG8_LDB(B0, 1, 0); PG8_LDB(B1, 1, 1); PG8_SCHED; PG8_LDA(At, 1, 0); PG8_STAGE(PG8_SA(0, 1), a2 + hstep, voffA);
            PG8_WAIT_V(8); PG8_WAIT_L(0); PG8_BAR; PG8_MMA(0, 0, At, B0); PG8_MMA(0, 1, At, B1); PG8_BAR; PG8_SCHED;
            PG8_LDA(At, 1, 1); PG8_STAGE(PG8_SB(1, 0), b3, voffB); PG8_STAGE(PG8_SB(1, 1), b3 + hstep, voffB); PG8_STAGE(PG8_SA(1, 0), a3, voffA);
            PG8_WAIT_V(8); PG8_WAIT_L(0); PG8_BAR; PG8_MMA(1, 0, At, B0); PG8_MMA(1, 1, At, B1); PG8_BAR; PG8_SCHED;
            } else {
            PG8_LDB(B0, 0, 0); PG8_SCHED; PG8_LDA(At, 0, 0); PG8_STAGE(PG8_SA(1, 1), a1 + hstep, voffA);
            PG8_WAIT_L(8); PG8_BAR; PG8_WAIT_L(0); PG8_MMA(0, 0, At, B0); PG8_BAR; PG8_SCHED;
            PG8_LDB(B1, 0, 1); PG8_STAGE(PG8_SB(0, 0), b2, voffB);
            PG8_BAR; PG8_WAIT_L(0); PG8_MMA(0, 1, At, B1); PG8_BAR;
            PG8_LDA(At, 0, 1); PG8_STAGE(PG8_SA(0, 0), a2, voffA);
            PG8_BAR; PG8_WAIT_L(0); PG8_MMA(1, 0, At, B0); PG8_BAR; PG8_SCHED;
            PG8_STAGE(PG8_SB(0, 1), b2 + hstep, voffB);
            PG8_WAIT_V(6); PG8_BAR; PG8_MMA(1, 1, At, B1); PG8_BAR;
            PG8_LDB(B0, 1, 0); PG8_SCHED; PG8_LDA(At, 1, 0); PG8_STAGE(PG8_SA(0, 1), a2 + hstep, voffA);
            PG8_WAIT_L(8); PG8_BAR; PG8_WAIT_L(0); PG8_MMA(0, 0, At, B0); PG8_BAR; PG8_SCHED;
            PG8_LDB(B1, 1, 1); PG8_STAGE(PG8_SB(1, 0), b3, voffB);
            PG8_BAR; PG8_WAIT_L(0); PG8_MMA(0, 1, At, B1); PG8_BAR;
            PG8_LDA(At, 1, 1); PG8_STAGE(PG8_SA(1, 0), a3, voffA);
            PG8_BAR; PG8_WAIT_L(0); PG8_MMA(1, 0, At, B0); PG8_BAR; PG8_SCHED;
            PG8_STAGE(PG8_SB(1, 1), b3 + hstep, voffB);
            PG8_WAIT_V(6); PG8_BAR; PG8_MMA(1, 1, At, B1); PG8_BAR;
            }
        }
        if constexpr (ALIGN_EPI) { if (wr == 0) PG8_BAR; }
        if constexpr (!Epi::AFTER_DRAIN) { E(acc, cur, wr, wc, fr, fq); S.done(cur); }
        if (!has_next) break;
#pragma unroll
        for (int a = 0; a < 2; ++a)
#pragma unroll
            for (int b = 0; b < 2; ++b)
#pragma unroll
                for (int m = 0; m < 4; ++m)
#pragma unroll
                    for (int n = 0; n < 2; ++n) acc[a][b][m][n] = (f32x4){0.f, 0.f, 0.f, 0.f};
        cur = nxt; cA = nA; cB = nB; ++ui;
        if constexpr (ALIGN_EPI) { if (wr == 1) PG8_BAR; }
    }
    PG8_WAIT_V(0);
    if constexpr (!ALIGN_EPI) { if (wr == 0) PG8_BAR; }
    PG8_BAR;
    if constexpr (Epi::AFTER_DRAIN) { E.fused(acc, cur, wr, wc, fr, fq, lds, wid, lane); S.done(cur); }
#undef PG8_SA
#undef PG8_SB
#undef PG8_STAGE
#undef PG8_LDA
#undef PG8_LDB
#undef PG8_MMA
#undef PG8_WAIT_V
#undef PG8_WAIT_L
#undef PG8_BAR
#undef PG8_SCHED
}
}
#ifndef PG8_SP2
#define PG8_SP2 true
#endif
#ifndef PG8_ALIGN
#define PG8_ALIGN true
#endif

namespace mk {
using pg8::bf16_t; using pg8::f32x4; using pg8::u32x4; using pg8::Unit;
#define GAS __attribute__((address_space(1)))
#define LAS __attribute__((address_space(3)))
typedef GAS unsigned gu32;
#define RLX_AGENT __ATOMIC_RELAXED, __HIP_MEMORY_SCOPE_AGENT
#define LDS_WAIT() asm volatile("s_waitcnt lgkmcnt(0)" ::: "memory")
#define VM_WAIT() asm volatile("s_waitcnt vmcnt(0)" ::: "memory")

constexpr int D = 1024, T = 2048, NB = 8, MP = NB * T, SB = 128, ST = 4, MS = SB * ST, MT = MP + MS;
constexpr int INW = 4096, NMEM = 256, XH = 4, XHD = 256, DFF = 2816, PAST = 16384, MMEM = NB * NMEM;
constexpr int PBW = 3584;
constexpr float EPS = 1e-6f;
constexpr int NWAVES = 8;

constexpr size_t MiB = 1u << 20;
constexpr size_t WS_CTL = 0, CTL_ZERO_BYTES = 1 * MiB;
constexpr size_t WS_W_IN = 1 * MiB, WS_W_OUT = 9 * MiB, WS_W_XQ = 11 * MiB, WS_W_KV = 13 * MiB, WS_W_XO = 17 * MiB, WS_W_GU = 19 * MiB, WS_W_DN = 30 * MiB;
constexpr size_t WS_CS = 36 * MiB, WS_LOW = 38 * MiB, WS_RS0 = 39 * MiB, WS_RSM = WS_RS0 + 256 * 1024, WS_ST1 = 40 * MiB, WS_ST2 = 42 * MiB, WS_ST3 = 44 * MiB;
constexpr size_t WS_MB = 46 * MiB, WS_MK = 50 * MiB, WS_MV = 54 * MiB, WS_XB0 = 58 * MiB, WS_PB = 91 * MiB, WS_LF = 207 * MiB, WS_OB = 240 * MiB;
constexpr size_t WS_XB1 = 273 * MiB, WS_Q = 306 * MiB, WS_XB2 = 339 * MiB, WS_ACT = 372 * MiB, WS_END = 463 * MiB;
static_assert(WS_PB + (size_t)MT * PBW * 2 <= WS_LF && WS_LF + (size_t)MT * 512 * 4 <= WS_OB && WS_ACT + (size_t)MT * DFF * 2 <= WS_END, "ws map");
constexpr int CW_BAR = 4096;

constexpr int RING_OFF = 0, RING_BYTES = 155648, LDSCTL_OFF = RING_BYTES, MISC_OFF = LDSCTL_OFF + 320, LDS_BYTES = 163840;

typedef float f32x2_t __attribute__((ext_vector_type(2)));
typedef __bf16 bf16x2_t __attribute__((ext_vector_type(2)));
__device__ __forceinline__ unsigned pk_bf16(float lo, float hi) { f32x2_t v = {lo, hi}; bf16x2_t b = __builtin_convertvector(v, bf16x2_t); return __builtin_bit_cast(unsigned, b); }
__device__ __forceinline__ float bf2f(unsigned short h) { return __uint_as_float((unsigned)h << 16); }
__device__ __forceinline__ float silu_f(float x) { return x / (1.f + __expf(-x)); }
__device__ __forceinline__ float sigmoid_f(float x) { return 1.f / (1.f + __expf(-x)); }

__device__ __forceinline__ void sincos_d(double x, double& s, double& c) {
    const double two_over_pi = 0.63661977236758134308;
    const double pio2_hi = 1.57079632673412561417e+00, pio2_lo = 6.07710050650619224932e-11;
    double qd = rint(x * two_over_pi);
    double r = x - qd * pio2_hi; r -= qd * pio2_lo;
    long long q = (long long)qd;
    double r2 = r * r;
    double sp = r * (1.0 + r2 * (-1.0 / 6 + r2 * (1.0 / 120 + r2 * (-1.0 / 5040 + r2 * (1.0 / 362880 + r2 * (-1.0 / 39916800 + r2 * (1.0 / 6227020800.0 + r2 * (-1.0 / 1307674368000.0))))))));
    double cp = 1.0 + r2 * (-0.5 + r2 * (1.0 / 24 + r2 * (-1.0 / 720 + r2 * (1.0 / 40320 + r2 * (-1.0 / 3628800 + r2 * (1.0 / 479001600.0 + r2 * (-1.0 / 87178291200.0 + r2 * (1.0 / 20922789888000.0))))))));
    switch (q & 3) {
        case 0: s = sp; c = cp; break;
        case 1: s = cp; c = -sp; break;
        case 2: s = -sp; c = -cp; break;
        default: s = -cp; c = sp; break;
    }
}
__device__ __forceinline__ float wave_sum(float v) {
#pragma unroll
    for (int o = 1; o < 64; o <<= 1) v += __shfl_xor(v, o);
    return v;
}
#define XB_TMO      128
#define XB_XCNT(j)  (256  + 64 * (j))
#define XB_XSUB(j)  (1280 + 64 * (j))
#define XB_XGEN(j)  (2304 + 64 * (j))
#define XB_TOP      3328
#define XB_TOPGEN   3392
#define XCD_BAR_WORDS 3456
#define XB_SPIN_CAP (1u << 18)

__device__ __forceinline__ unsigned xb_ld(unsigned* p)              { return __hip_atomic_load(p, __ATOMIC_RELAXED, __HIP_MEMORY_SCOPE_AGENT); }
__device__ __forceinline__ unsigned xb_add(unsigned* p, unsigned v) { return __hip_atomic_fetch_add(p, v, __ATOMIC_RELAXED, __HIP_MEMORY_SCOPE_AGENT); }
__device__ __forceinline__ unsigned xb_xcc_id() { return (unsigned)__builtin_amdgcn_s_getreg((3 << 11) | 20) & 0xFu; }
#define XB_SPIN(cond, bar) do { unsigned _sp = 0; while (cond) { __builtin_amdgcn_s_sleep(1); \
    if ((++_sp & 255u) == 0u) { if (xb_ld(&(bar)[XB_TMO])) break; if (_sp > XB_SPIN_CAP) { atomicAdd(&(bar)[XB_TMO], 1u); break; } } } } while (0)

struct XcdBarrier {
    unsigned* bar; unsigned x;
    volatile LAS unsigned* st;
};

__device__ __forceinline__ XcdBarrier xcd_barrier_post(unsigned* bar, volatile LAS unsigned* st) {
    XcdBarrier b; b.bar = bar; b.x = xb_xcc_id(); b.st = st;
    if (threadIdx.x == 0) (void)xb_add(&bar[XB_XCNT(b.x)], 1u);
    return b;
}
__device__ __forceinline__ void xcd_barrier_complete(unsigned* bar, unsigned x, unsigned& nloc, unsigned& nx) {
    const unsigned G = gridDim.x * gridDim.y * gridDim.z;
    unsigned sum, cnt, mine, sp = 0u;
    for (;;) {
        sum = 0u; cnt = 0u; mine = 0u;
#pragma unroll
        for (unsigned j = 0; j < 16; ++j) { const unsigned c = xb_ld(&bar[XB_XCNT(j)]); sum += c; cnt += (c > 0u) ? 1u : 0u; mine = (j == x) ? c : mine; }
        if (sum == G) break;
        __builtin_amdgcn_s_sleep(1);
        if ((++sp & 255u) == 0u) { if (xb_ld(&bar[XB_TMO])) break; if (sp > XB_SPIN_CAP) { atomicAdd(&bar[XB_TMO], 1u); break; } }
    }
    nloc = mine > 0u ? mine : 1u; nx = cnt > 0u ? cnt : 1u;
}

__device__ __forceinline__ void xcd_barrier(const XcdBarrier& b) {
    asm volatile("s_waitcnt vmcnt(0)" ::: "memory");
    __syncthreads();
    if (threadIdx.x == 0) {
        unsigned* bar = b.bar;
        __builtin_amdgcn_s_waitcnt(0);
        unsigned nloc = b.st[0], nx = b.st[1];
        if (nloc == 0u) { xcd_barrier_complete(bar, b.x, nloc, nx); b.st[0] = nloc; b.st[1] = nx; }
        const unsigned old = xb_add(&bar[XB_XSUB(b.x)], 1u);
        const unsigned gen = old / nloc;
        if (old + 1u == (gen + 1u) * nloc) {
            __builtin_amdgcn_fence(__ATOMIC_RELEASE, "agent");
            asm volatile("s_waitcnt vmcnt(0)" ::: "memory");
            const unsigned og = xb_add(&bar[XB_TOP], 1u);
            const unsigned tg = og / nx;
            if (og + 1u == (tg + 1u) * nx) xb_add(&bar[XB_TOPGEN], 1u);
            else XB_SPIN(xb_ld(&bar[XB_TOPGEN]) == tg, bar);
            __builtin_amdgcn_fence(__ATOMIC_ACQUIRE, "agent");
            xb_add(&bar[XB_XGEN(b.x)], 1u);
            asm volatile("s_waitcnt vmcnt(0)" ::: "memory");
        } else {
            XB_SPIN(xb_ld(&bar[XB_XGEN(b.x)]) == gen, bar);
            __builtin_amdgcn_fence(__ATOMIC_ACQUIRE, "agent");
            asm volatile("s_waitcnt vmcnt(0)" ::: "memory");
        }
    }
    __syncthreads();
}
struct Args { const float* in[24]; float* out; unsigned char* ws; float inv_freq[64]; int ph_lo, ph_hi, li, pad; };
enum { I_XP = 0, I_XS, I_MEM, I_SRET, I_SHG, I_CK, I_CV, I_GMIX, I_WIN, I_RGAIN, I_HGAIN, I_HGLB, I_WOUT, I_GXA, I_GMEM, I_WXQ, I_WXK, I_WXV, I_WXO, I_GFFN, I_WGATE, I_WUP, I_WDOWN, I_GFINAL };
constexpr size_t O_Y = 0, O_RETP = (size_t)MT * D, O_HGP = O_RETP + (size_t)NB * 4 * 16384, O_MEMK = O_HGP + (size_t)NB * 4 * 16384, O_MEMV = O_MEMK + (size_t)MMEM * D,
                 O_RETS = O_MEMV + (size_t)MMEM * D, O_HGS = O_RETS + (size_t)SB * 4 * 16384;

struct Frame {
    LAS unsigned char* lds; volatile LAS unsigned* MISC; gu32* ctl;
    int tid, lane, wave, vcu, G;
};

__device__ __forceinline__ const float* wsrc(int mode, const float* s0, const float* s1, int n) {
    if (mode == 1) { if (n < 1024) { const int blk = n >> 9, h = (n & 511) >> 7, j = n & 127; return s0 + blk * 512 + h * 128 + (j >> 1) + 64 * (j & 1); } return s0 + n; }
    if (mode == 2) return n < 1024 ? s0 + n : s1 + (n - 1024);
    if (mode == 3) { const int jj = (n >> 3) * 4 + (n & 3); return (n & 4) ? s1 + jj : s0 + jj; }
    return s0 + n;
}
__device__ __forceinline__ void transpose_item(int mode, const float* s0, const float* s1, int ldw, const float* g, int K, int nblk, bf16_t* WT, LAS float* scr, int item, int lane) {
    const int kb = item / nblk, nb = item % nblk, k0 = 64 * kb, n0 = 32 * nb;
    const float* colp = wsrc(mode, s0, s1, n0 + (lane & 31));
#pragma unroll 8
    for (int i = 0; i < 32; ++i) { const int kk = 2 * i + (lane >> 5); float v = colp[(size_t)(k0 + kk) * ldw]; if (g) v *= g[k0 + kk]; scr[kk * 33 + (lane & 31)] = v; }
    LDS_WAIT(); asm volatile("" ::: "memory");
    const int c = lane & 7;
#pragma unroll
    for (int j = 0; j < 4; ++j) { const int n = (lane >> 3) + 8 * j; const LAS float* s = scr + (8 * c) * 33 + n;
        u32x4 o; o.x = pk_bf16(s[0 * 33], s[1 * 33]); o.y = pk_bf16(s[2 * 33], s[3 * 33]); o.z = pk_bf16(s[4 * 33], s[5 * 33]); o.w = pk_bf16(s[6 * 33], s[7 * 33]);
        *(GAS u32x4*)(WT + (size_t)(n0 + n) * K + k0 + 8 * c) = o; }
    LDS_WAIT(); asm volatile("" ::: "memory");
}
__device__ __forceinline__ void row_to_bf16(const float* xrow, bf16_t* orow, float* rs, int lane) {
    const GAS f32x4* xr = (const GAS f32x4*)xrow + lane;
    f32x4 v[4]; float s = 0.f;
#pragma unroll
    for (int j = 0; j < 4; ++j) { v[j] = xr[64 * j]; s += (v[j].x * v[j].x + v[j].y * v[j].y) + (v[j].z * v[j].z + v[j].w * v[j].w); }
    s = wave_sum(s);
    if (lane == 0) *rs = rsqrtf(s * (1.f / D) + EPS);
    GAS unsigned long long* o8 = (GAS unsigned long long*)orow + lane;
#pragma unroll
    for (int j = 0; j < 4; ++j) o8[64 * j] = (unsigned long long)pk_bf16(v[j].x, v[j].y) | ((unsigned long long)pk_bf16(v[j].z, v[j].w) << 32);
}
__device__ __forceinline__ void phase_prep(Frame& F, const Args& a) {
    unsigned char* ws = a.ws;
    LAS float* scr = (LAS float*)(F.lds + RING_OFF + F.wave * 16384);
    const int gw = F.vcu * NWAVES + F.wave, NGW = F.G * NWAVES;
    constexpr int I0 = (D / 64) * (INW / 32), I1 = (D / 64) * (D / 32), I3 = (D / 64) * (2 * D / 32), I5 = (D / 64) * (2 * DFF / 32), I6 = (DFF / 64) * (D / 32);
    constexpr int NITEMS = I0 + I1 + I1 + I3 + I1 + I5 + I6;
    for (int it = gw; it < NITEMS; it += NGW) {
        int r = it;
        if (r < I0) { transpose_item(1, a.in[I_WIN], nullptr, INW, a.in[I_GMIX], D, INW / 32, (bf16_t*)(ws + WS_W_IN), scr, r, F.lane); continue; } r -= I0;
        if (r < I1) { transpose_item(0, a.in[I_WOUT], nullptr, D, nullptr, D, D / 32, (bf16_t*)(ws + WS_W_OUT), scr, r, F.lane); continue; } r -= I1;
        if (r < I1) { transpose_item(0, a.in[I_WXQ], nullptr, D, a.in[I_GXA], D, D / 32, (bf16_t*)(ws + WS_W_XQ), scr, r, F.lane); continue; } r -= I1;
        if (r < I3) { transpose_item(2, a.in[I_WXK], a.in[I_WXV], D, a.in[I_GMEM], D, 2 * D / 32, (bf16_t*)(ws + WS_W_KV), scr, r, F.lane); continue; } r -= I3;
        if (r < I1) { transpose_item(0, a.in[I_WXO], nullptr, D, nullptr, D, D / 32, (bf16_t*)(ws + WS_W_XO), scr, r, F.lane); continue; } r -= I1;
        if (r < I5) { transpose_item(3, a.in[I_WGATE], a.in[I_WUP], DFF, a.in[I_GFFN], D, 2 * DFF / 32, (bf16_t*)(ws + WS_W_GU), scr, r, F.lane); continue; } r -= I5;
        transpose_item(0, a.in[I_WDOWN], nullptr, D, nullptr, DFF, D / 32, (bf16_t*)(ws + WS_W_DN), scr, r, F.lane);
    }
    for (int m = gw; m < MT + MMEM; m += NGW) {
        if (m < MP) row_to_bf16(a.in[I_XP] + (size_t)m * D, (bf16_t*)(ws + WS_XB0) + (size_t)m * D, (float*)(ws + WS_RS0) + m, F.lane);
        else if (m < MT) row_to_bf16(a.in[I_XS] + (size_t)(m - MP) * D, (bf16_t*)(ws + WS_XB0) + (size_t)m * D, (float*)(ws + WS_RS0) + m, F.lane);
        else row_to_bf16(a.in[I_MEM] + (size_t)(m - MT) * D, (bf16_t*)(ws + WS_MB) + (size_t)(m - MT) * D, (float*)(ws + WS_RSM) + (m - MT), F.lane);
    }
    float* cs = (float*)(ws + WS_CS);
    for (int e = F.vcu * 512 + F.tid; e < (T + ST) * 64; e += F.G * 512) {
        const int p = e >> 6, i = e & 63; const int pos = p < T ? p : PAST + (p - T);
        const float ang = (float)pos * a.inv_freq[i];
        double sd, cd; sincos_d((double)ang, sd, cd);
        cs[2 * e] = (float)cd; cs[2 * e + 1] = (float)sd;
    }
    if (F.vcu == 0) {
        const float* lb = a.in[I_HGLB]; float* low = (float*)(ws + WS_LOW);
        const int c = F.tid; const float x0 = lb[c], x1 = lb[512 + c]; const float m = fmaxf(x0, x1); const float e0 = expf(x0 - m), e1 = expf(x1 - m); low[c] = e0 / (e0 + e1);
    }
}
struct EpiMemKV {
    static constexpr bool PERM = true, AFTER_DRAIN = false;
    const float* rsm; float* outk; float* outv; bf16_t* mk; bf16_t* mv;
    __device__ __forceinline__ void operator()(const f32x4 (&acc)[2][2][4][2], const Unit& u, int wr, int wc, int fr, int fq) const {
        const bool isv = u.pn >= 4; float* of = isv ? outv : outk; bf16_t* ob = isv ? mv : mk;
        const int cn = (u.pn & 3) * 256 + wc * 32 + 8 * fq;
#pragma unroll
        for (int ai = 0; ai < 2; ++ai)
#pragma unroll
            for (int m = 0; m < 4; ++m) { const int row = u.pm * 256 + ai * 128 + wr * 64 + m * 16 + fr; const float rs = rsm[row];
#pragma unroll
                for (int bj = 0; bj < 2; ++bj) { const size_t off = (size_t)row * D + cn + bj * 128;
                    const f32x4 v0 = acc[ai][bj][m][0] * rs, v1 = acc[ai][bj][m][1] * rs;
                    *(f32x4*)(of + off) = v0; *(f32x4*)(of + off + 4) = v1;
                    u32x4 w; w.x = pk_bf16(v0[0], v0[1]); w.y = pk_bf16(v0[2], v0[3]); w.z = pk_bf16(v1[0], v1[1]); w.w = pk_bf16(v1[2], v1[3]);
                    *(u32x4*)(ob + off) = w; } }
    }
};
__device__ __forceinline__ u32x4 pk8(const f32x4& a, const f32x4& b) { u32x4 w; w.x = pk_bf16(a[0], a[1]); w.y = pk_bf16(a[2], a[3]); w.z = pk_bf16(b[0], b[1]); w.w = pk_bf16(b[2], b[3]); return w; }
__device__ __forceinline__ f32x4 silu4(const f32x4& v) { return (f32x4){silu_f(v[0]), silu_f(v[1]), silu_f(v[2]), silu_f(v[3])}; }
__device__ __forceinline__ float row_rs(const float* st, int row) {
    const f32x4* p = (const f32x4*)(st + (size_t)row * 16); const f32x4 a = p[0], b = p[1], c = p[2], d = p[3];
    const float s = ((a[0] + a[1]) + (a[2] + a[3])) + ((b[0] + b[1]) + (b[2] + b[3])) + ((c[0] + c[1]) + (c[2] + c[3])) + ((d[0] + d[1]) + (d[2] + d[3]));
    return rsqrtf(s * (1.f / D) + EPS);
}
struct EpiInProj {
    static constexpr bool PERM = true, AFTER_DRAIN = false;
    const float* rs0; const float* cs; const float* low; const float* rgain; const float* hgain; bf16_t* pb; float* lf;
    __device__ __forceinline__ void operator()(const f32x4 (&acc)[2][2][4][2], const Unit& u, int wr, int wc, int fr, int fq) const {
        const int kind = u.pn >> 1; const int colt = u.pn * 256 + wc * 32 + 8 * fq;
#pragma unroll
        for (int ai = 0; ai < 2; ++ai)
#pragma unroll
            for (int m = 0; m < 4; ++m) {
                const int row = u.pm * 256 + ai * 128 + wr * 64 + m * 16 + fr; const float rs = rs0[row];
                const bool samp = row >= MP; const int t = row & (T - 1); const int pidx = samp ? T + ((row - MP) & 3) : t;
#pragma unroll
                for (int bj = 0; bj < 2; ++bj) {
                    const int c0 = colt + bj * 128;
                    f32x4 v0 = acc[ai][bj][m][0] * rs, v1 = acc[ai][bj][m][1] * rs;
                    if (kind <= 1) {
                        const int h = (c0 & 511) >> 7, i0 = (c0 & 127) >> 1;
                        const f32x4* tp = (const f32x4*)(cs + ((size_t)pidx * 64 + i0) * 2); const f32x4 t0 = tp[0], t1 = tp[1];
                        const float lg = __log2f(1.f - exp2f(-5.f - (float)h)); const float e = (float)((t & 31) + 1);
                        float sc = kind == 0 ? 1.f : 0.08838834764831845f;
                        if (!samp) sc *= exp2f(kind == 0 ? e * lg : -e * lg);
                        f32x4 o0, o1;
                        o0[0] = (v0[0] * t0[0] - v0[1] * t0[1]) * sc; o0[1] = (v0[0] * t0[1] + v0[1] * t0[0]) * sc;
                        o0[2] = (v0[2] * t0[2] - v0[3] * t0[3]) * sc; o0[3] = (v0[2] * t0[3] + v0[3] * t0[2]) * sc;
                        o1[0] = (v1[0] * t1[0] - v1[1] * t1[1]) * sc; o1[1] = (v1[0] * t1[1] + v1[1] * t1[0]) * sc;
                        o1[2] = (v1[2] * t1[2] - v1[3] * t1[3]) * sc; o1[3] = (v1[2] * t1[3] + v1[3] * t1[2]) * sc;
                        *(u32x4*)(pb + (size_t)row * PBW + c0) = pk8(o0, o1);
                    } else if (kind == 2) {
                        *(u32x4*)(pb + (size_t)row * PBW + c0) = pk8(v0, v1);
                    } else if (kind == 3) {
                        const f32x4* gp = (const f32x4*)(rgain + (c0 - 1536));
                        *(u32x4*)(pb + (size_t)row * PBW + c0) = pk8(silu4(v0) * gp[0], silu4(v1) * gp[1]);
                    } else if (kind == 4) {
                        *(u32x4*)(pb + (size_t)row * PBW + c0) = pk8(silu4(v0), silu4(v1));
                    } else if (kind == 5) {
                        const f32x4* lp = (const f32x4*)(low + (c0 - 2560)); const f32x4 l0 = lp[0], l1 = lp[1];
                        f32x4 o0, o1;
#pragma unroll
                        for (int e = 0; e < 4; ++e) { o0[e] = __logf(l0[e] + (1.f - l0[e]) * sigmoid_f(v0[e])); o1[e] = __logf(l1[e] + (1.f - l1[e]) * sigmoid_f(v1[e])); }
                        float* lp2 = lf + (size_t)row * 512 + (c0 - 2560);
                        *(f32x4*)lp2 = o0; *(f32x4*)(lp2 + 4) = o1;
                    } else if (kind == 6) {
                        *(u32x4*)(pb + (size_t)row * PBW + c0 - 512) = pk8(v0, v1);
                    } else {
                        const f32x4* gp = (const f32x4*)(hgain + (c0 - 3584));
                        *(u32x4*)(pb + (size_t)row * PBW + c0 - 512) = pk8(silu4(v0) * gp[0], silu4(v1) * gp[1]);
                    }
                }
            }
    }
};
struct EpiResid {
    static constexpr bool PERM = true, AFTER_DRAIN = false;
    const float* xold_p; const float* xold_s; float* y; bf16_t* xb; float* st;
    __device__ __forceinline__ void operator()(const f32x4 (&acc)[2][2][4][2], const Unit& u, int wr, int wc, int fr, int fq) const {
        const int cn = u.pn * 256 + wc * 32 + 8 * fq;
#pragma unroll
        for (int ai = 0; ai < 2; ++ai)
#pragma unroll
            for (int m = 0; m < 4; ++m) {
                const int row = u.pm * 256 + ai * 128 + wr * 64 + m * 16 + fr;
                const float* xo = row < MP ? xold_p + (size_t)row * D : xold_s + (size_t)(row - MP) * D;
                float ss = 0.f;
#pragma unroll
                for (int bj = 0; bj < 2; ++bj) { const int c = cn + bj * 128;
                    const f32x4 v0 = *(const f32x4*)(xo + c) + acc[ai][bj][m][0], v1 = *(const f32x4*)(xo + c + 4) + acc[ai][bj][m][1];
                    ss += (v0[0] * v0[0] + v0[1] * v0[1]) + (v0[2] * v0[2] + v0[3] * v0[3]) + (v1[0] * v1[0] + v1[1] * v1[1]) + (v1[2] * v1[2] + v1[3] * v1[3]);
                    *(f32x4*)(y + (size_t)row * D + c) = v0; *(f32x4*)(y + (size_t)row * D + c + 4) = v1;
                    *(u32x4*)(xb + (size_t)row * D + c) = pk8(v0, v1); }
                ss += __shfl_xor(ss, 16); ss += __shfl_xor(ss, 32);
                if (fq == 0) st[(size_t)row * 16 + u.pn * 4 + wc] = ss;
            }
    }
};
struct EpiScaleBf16 {
    static constexpr bool PERM = true, AFTER_DRAIN = false;
    const float* st; bf16_t* o; float scale;
    __device__ __forceinline__ void operator()(const f32x4 (&acc)[2][2][4][2], const Unit& u, int wr, int wc, int fr, int fq) const {
        const int cn = u.pn * 256 + wc * 32 + 8 * fq;
#pragma unroll
        for (int ai = 0; ai < 2; ++ai)
#pragma unroll
            for (int m = 0; m < 4; ++m) { const int row = u.pm * 256 + ai * 128 + wr * 64 + m * 16 + fr; const float rs = row_rs(st, row) * scale;
#pragma unroll
                for (int bj = 0; bj < 2; ++bj) *(u32x4*)(o + (size_t)row * D + cn + bj * 128) = pk8(acc[ai][bj][m][0] * rs, acc[ai][bj][m][1] * rs); }
    }
};
struct EpiGateUp {
    static constexpr bool PERM = true, AFTER_DRAIN = false;
    const float* st; bf16_t* act;
    __device__ __forceinline__ void operator()(const f32x4 (&acc)[2][2][4][2], const Unit& u, int wr, int wc, int fr, int fq) const {
        const int jn = u.pn * 128 + wc * 16 + 4 * fq;
#pragma unroll
        for (int ai = 0; ai < 2; ++ai)
#pragma unroll
            for (int m = 0; m < 4; ++m) { const int row = u.pm * 256 + ai * 128 + wr * 64 + m * 16 + fr; const float rs = row_rs(st, row);
#pragma unroll
                for (int bj = 0; bj < 2; ++bj) { const f32x4 g = silu4(acc[ai][bj][m][0] * rs), up = acc[ai][bj][m][1] * rs; const f32x4 a = g * up;
                    unsigned long long w = (unsigned long long)pk_bf16(a[0], a[1]) | ((unsigned long long)pk_bf16(a[2], a[3]) << 32);
                    *(unsigned long long*)(act + (size_t)row * DFF + jn + bj * 64) = w; } }
    }
};
__device__ __forceinline__ void phase_final(Frame& F, const Args& a) {
    const int gw = F.vcu * NWAVES + F.wave, NGW = F.G * NWAVES;
    const float* st = (const float*)(a.ws + WS_ST3); const GAS f32x4* g4 = (const GAS f32x4*)a.in[I_GFINAL] + F.lane;
    for (int m = gw; m < MT; m += NGW) { const float rs = row_rs(st, m); GAS f32x4* yr = (GAS f32x4*)(a.out + O_Y + (size_t)m * D) + F.lane;
#pragma unroll
        for (int j = 0; j < 4; ++j) yr[64 * j] = yr[64 * j] * rs * g4[64 * j]; }
}
typedef short bf16x8v __attribute__((ext_vector_type(8)));
typedef short s16x4v __attribute__((ext_vector_type(4)));
typedef float f32x16v __attribute__((ext_vector_type(16)));
constexpr int RC_RS = 272;
constexpr int RC_TILE = 32 * RC_RS, RC_BUF = 3 * RC_TILE;
constexpr int RC_ORS = 528, RC_OSZ = 32 * RC_ORS;
constexpr int RC_OOFF = 2 * RC_BUF, RC_EOFF = RC_OOFF + 2 * RC_OSZ, RC_END = RC_EOFF + 2 * 512;
static_assert(RC_END <= RING_BYTES, "recurrence LDS");
__device__ __forceinline__ int crow(int r, int h) { return (r & 3) + 8 * (r >> 2) + 4 * h; }
__device__ __forceinline__ s16x4v tr16(const LAS unsigned char* p) { typedef short v4i16_t __attribute__((ext_vector_type(4))); return __builtin_bit_cast(s16x4v, __builtin_amdgcn_ds_read_tr16_b64_v4i16((LAS v4i16_t*)p)); }
__device__ __forceinline__ bf16x8v cat8(s16x4v lo, s16x4v hi) { return (bf16x8v){lo[0], lo[1], lo[2], lo[3], hi[0], hi[1], hi[2], hi[3]}; }
__device__ __forceinline__ bf16x8v pack_step(const f32x16v& x, int s) {
    u32x4 p; p.x = pk_bf16(x[8 * s], x[8 * s + 1]); p.y = pk_bf16(x[8 * s + 2], x[8 * s + 3]); p.z = pk_bf16(x[8 * s + 4], x[8 * s + 5]); p.w = pk_bf16(x[8 * s + 6], x[8 * s + 7]);
    return __builtin_bit_cast(bf16x8v, p);
}
#define MFMA32(a, b, c) __builtin_amdgcn_mfma_f32_32x32x16_bf16((a), (b), (c), 0, 0, 0)

__device__ __forceinline__ void rec_prompt_unit(Frame& F, const Args& a, int unit) {
    const int kind = unit >> 5, b = (unit >> 2) & 7, h = unit & 3;
    unsigned char* ws = a.ws;
    const bf16_t* pb = (const bf16_t*)(ws + WS_PB); const float* lf = (const float*)(ws + WS_LF); bf16_t* ob = (bf16_t*)(ws + WS_OB);
    LAS unsigned char* L = F.lds + RING_OFF;
    const int lane = F.lane, r32 = lane & 31, hh = lane >> 5, g = (lane >> 4) & 1, q4 = (lane & 15) >> 2, p4 = lane & 3;
    const int row_base = b * T;
    const int qcol = kind == 0 ? h * 128 : 2048 + h * 128, kcol = 512 + h * 128, vcol = kind == 0 ? 1024 + h * 128 : 2560 + h * 128, gcol = kind == 0 ? 1536 + h * 128 : 3072 + h * 128;
    const float Eret = exp2f(32.f * __log2f(1.f - exp2f(-5.f - (float)h)));
    const int pt = F.tid - 256;

    auto stage = [&](int c) {
        LAS unsigned char* B = L + (c & 1) * RC_BUF; const int r0 = row_base + 32 * c;
        if (kind == 0) {
#pragma unroll
            for (int arr = 0; arr < 3; ++arr) { const int col0 = arr == 0 ? qcol : (arr == 1 ? kcol : vcol);
#pragma unroll
                for (int j = 0; j < 2; ++j) { const int piece = pt + 256 * j, row = piece >> 4, ch = piece & 15;
                    const u32x4 v = *(const u32x4*)(pb + (size_t)(r0 + row) * PBW + col0 + ch * 8);
                    *(LAS u32x4*)(B + arr * RC_TILE + row * RC_RS + ch * 16) = v; } }
        } else {
            const int c1 = pt & 127, half = pt >> 7;
#pragma unroll
            for (int j = 0; j < 2; ++j) { const int piece = pt + 256 * j, row = piece >> 4, ch = piece & 15;
                const u32x4 v = *(const u32x4*)(pb + (size_t)(r0 + row) * PBW + vcol + ch * 8);
                *(LAS u32x4*)(B + 2 * RC_TILE + row * RC_RS + ch * 16) = v; }
            float lfv[16], qv[16]; float bsum = 0.f;
            if (half) {
#pragma unroll
                for (int t = 0; t < 16; ++t) bsum += lf[(size_t)(r0 + t) * 512 + h * 128 + c1];
            }
#pragma unroll
            for (int t = 0; t < 16; ++t) { const int tt = 16 * half + t; lfv[t] = lf[(size_t)(r0 + tt) * 512 + h * 128 + c1]; qv[t] = bf2f(pb[(size_t)(r0 + tt) * PBW + qcol + c1]); }
#pragma unroll
            for (int t = 0; t < 16; ++t) { const int tt = 16 * half + t; bsum += lfv[t];
                const float f = __expf(lfv[t]), eb = __expf(bsum), enb = __expf(-bsum);
                const float qe = qv[t] * eb, ke = (1.f - f) * enb;
                *(LAS bf16_t*)(B + tt * RC_RS + c1 * 2) = (bf16_t)(pk_bf16(qe, 0.f) & 0xffffu);
                *(LAS bf16_t*)(B + RC_TILE + tt * RC_RS + c1 * 2) = (bf16_t)(pk_bf16(ke, 0.f) & 0xffffu); }
            if (half) *(LAS float*)(L + RC_EOFF + (c & 1) * 512 + c1 * 4) = __expf(bsum);
        }
    };
    auto epilogue = [&](int c) {
        const int t = pt >> 3, cg = pt & 7; const int row = row_base + 32 * c + t;
        const LAS f32x4* op = (const LAS f32x4*)(L + RC_OOFF + (c & 1) * RC_OSZ + t * RC_ORS + cg * 64);
        f32x4 o[4]; float ss = 0.f;
#pragma unroll
        for (int j = 0; j < 4; ++j) { o[j] = op[j]; ss += (o[j][0] * o[j][0] + o[j][1] * o[j][1]) + (o[j][2] * o[j][2] + o[j][3] * o[j][3]); }
        ss += __shfl_xor(ss, 1); ss += __shfl_xor(ss, 2); ss += __shfl_xor(ss, 4);
        const float rs = rsqrtf(ss * (1.f / 128.f) + EPS);
        const u32x4* gp = (const u32x4*)(pb + (size_t)row * PBW + gcol + cg * 16);
        u32x4* dp = (u32x4*)(ob + (size_t)row * D + kind * 512 + h * 128 + cg * 16);
#pragma unroll
        for (int j = 0; j < 2; ++j) { const u32x4 gw = gp[j]; u32x4 w;
#pragma unroll
            for (int e = 0; e < 4; ++e) { const float g0 = __uint_as_float(gw[e] << 16), g1 = __uint_as_float(gw[e] & 0xffff0000u);
                const float o0 = o[2 * j + (e >> 1)][2 * (e & 1)], o1 = o[2 * j + (e >> 1)][2 * (e & 1) + 1];
                w[e] = pk_bf16(o0 * rs * g0, o1 * rs * g1); }
            dp[j] = w; }
    };

    f32x16v S[4];
#pragma unroll
    for (int dt = 0; dt < 4; ++dt)
#pragma unroll
        for (int i = 0; i < 16; ++i) S[dt][i] = 0.f;
    if (F.wave >= 4) stage(0);
    __syncthreads();
    for (int c = 0; c < T / 32; ++c) {
        if (F.wave < 4) {
            const int w = F.wave;
            const LAS unsigned char* B = L + (c & 1) * RC_BUF;
            const LAS unsigned char* QE = B; const LAS unsigned char* KE = B + RC_TILE; const LAS unsigned char* V = B + 2 * RC_TILE;
            f32x16v X;
#pragma unroll
            for (int i = 0; i < 16; ++i) X[i] = 0.f;
#pragma unroll
            for (int kk = 0; kk < 8; ++kk) { const bf16x8v ka = *(const LAS bf16x8v*)(KE + r32 * RC_RS + kk * 32 + hh * 16), qb = *(const LAS bf16x8v*)(QE + r32 * RC_RS + kk * 32 + hh * 16);
                X = MFMA32(ka, qb, X); }
#pragma unroll
            for (int i = 0; i < 16; ++i) if (crow(i, hh) > r32) X[i] = 0.f;
            bf16x8v vf[2];
#pragma unroll
            for (int kk = 0; kk < 2; ++kk) { const LAS unsigned char* vp = V + (16 * kk + 4 * hh + q4) * RC_RS + (32 * w + 16 * g + 4 * p4) * 2; vf[kk] = cat8(tr16(vp), tr16(vp + 8 * RC_RS)); }
            f32x16v o;
#pragma unroll
            for (int i = 0; i < 16; ++i) o[i] = 0.f;
#pragma unroll
            for (int kk = 0; kk < 2; ++kk) o = MFMA32(pack_step(X, kk), vf[kk], o);
#pragma unroll
            for (int dt = 0; dt < 4; ++dt)
#pragma unroll
                for (int kk = 0; kk < 2; ++kk) { const LAS unsigned char* qp = QE + r32 * RC_RS + (32 * dt + 16 * kk + 4 * hh) * 2;
                    const bf16x8v qa = cat8(*(const LAS s16x4v*)qp, *(const LAS s16x4v*)(qp + 16));
                    o = MFMA32(qa, pack_step(S[dt], kk), o); }
            { LAS unsigned char* OB = L + RC_OOFF + (c & 1) * RC_OSZ;
#pragma unroll
              for (int i = 0; i < 16; ++i) *(LAS float*)(OB + crow(i, hh) * RC_ORS + (32 * w + r32) * 4) = o[i]; }
#pragma unroll
            for (int dt = 0; dt < 4; ++dt)
#pragma unroll
                for (int kk = 0; kk < 2; ++kk) { const LAS unsigned char* kp = KE + (16 * kk + 4 * hh + q4) * RC_RS + (32 * dt + 16 * g + 4 * p4) * 2;
                    S[dt] = MFMA32(cat8(tr16(kp), tr16(kp + 8 * RC_RS)), vf[kk], S[dt]); }
            if (kind == 0) {
#pragma unroll
                for (int dt = 0; dt < 4; ++dt) S[dt] = S[dt] * Eret;
            } else {
                const LAS unsigned char* EB = L + RC_EOFF + (c & 1) * 512;
#pragma unroll
                for (int dt = 0; dt < 4; ++dt)
#pragma unroll
                    for (int gq = 0; gq < 4; ++gq) { const f32x4 e4 = *(const LAS f32x4*)(EB + (32 * dt + 8 * gq + 4 * hh) * 4);
#pragma unroll
                        for (int e = 0; e < 4; ++e) S[dt][4 * gq + e] *= e4[e]; }
            }
        } else {
            if (c + 1 < T / 32) stage(c + 1);
            if (c >= 1) epilogue(c - 1);
        }
        __syncthreads();
    }
    if (F.wave >= 4) epilogue(T / 32 - 1);
    else {
        const int w = F.wave; float* so = a.out + (kind == 0 ? O_RETP : O_HGP) + (size_t)(b * 4 + h) * 16384;
#pragma unroll
        for (int dt = 0; dt < 4; ++dt)
#pragma unroll
            for (int i = 0; i < 16; ++i) { const int dp = 32 * dt + crow(i, hh); const int dor = kind == 0 ? ((dp & 1) ? 64 + (dp >> 1) : (dp >> 1)) : dp;
                so[(size_t)dor * 128 + 32 * w + r32] = S[dt][i]; }
    }
    __syncthreads();
}

constexpr int SR_DQK = 0, SR_OPART = 8192, SR_RED = SR_OPART + 16384, SR_END = SR_RED + 64;
__device__ __forceinline__ void rec_sample_item(Frame& F, const Args& a, int item) {
    const int kind = item >> 9, bh = item & 511, b = bh >> 2, h = bh & 3;
    unsigned char* ws = a.ws;
    const bf16_t* pb = (const bf16_t*)(ws + WS_PB); const float* lf = (const float*)(ws + WS_LF); bf16_t* ob = (bf16_t*)(ws + WS_OB);
    LAS unsigned char* L = F.lds + RING_OFF;
    LAS float* DEC = (LAS float*)(L + SR_DQK); LAS float* KK = DEC + 512; LAS float* QQ = KK + 512;
    const int lane = F.lane, w = F.wave, rp = lane >> 5, e4 = (lane & 31) * 4;
    const int vcol = kind == 0 ? 1024 + h * 128 : 2560 + h * 128, gcol = kind == 0 ? 1536 + h * 128 : 3072 + h * 128;
    const float* s0 = a.in[kind == 0 ? I_SRET : I_SHG] + (size_t)bh * 16384;
    float* so = a.out + (kind == 0 ? O_RETS : O_HGS) + (size_t)bh * 16384;
    f32x4 S[8];
#pragma unroll
    for (int i = 0; i < 8; ++i) S[i] = *(const f32x4*)(s0 + (size_t)(16 * w + 2 * i + rp) * 128 + e4);
    const int tt = F.tid >> 7, d = F.tid & 127; const size_t rowt = (size_t)MP + b * 4 + tt;
    {
        float dec, k, q;
        if (kind == 0) { const int dp = d < 64 ? 2 * d : 2 * (d - 64) + 1; q = bf2f(pb[rowt * PBW + h * 128 + dp]); k = bf2f(pb[rowt * PBW + 512 + h * 128 + dp]); dec = 1.f - exp2f(-5.f - (float)h); }
        else { const float f = __expf(lf[rowt * 512 + h * 128 + d]); dec = f; k = 1.f - f; q = bf2f(pb[rowt * PBW + 2048 + h * 128 + d]); }
        DEC[tt * 128 + d] = dec; KK[tt * 128 + d] = k; QQ[tt * 128 + d] = q;
    }
    f32x4 v4[4];
#pragma unroll
    for (int t = 0; t < 4; ++t) { const unsigned long long u = *(const unsigned long long*)(pb + ((size_t)MP + b * 4 + t) * PBW + vcol + e4);
        v4[t] = (f32x4){__uint_as_float((unsigned)u << 16), __uint_as_float((unsigned)u & 0xffff0000u), __uint_as_float((unsigned)(u >> 32) << 16), __uint_as_float((unsigned)(u >> 32) & 0xffff0000u)}; }
    __syncthreads();
#pragma unroll
    for (int t = 0; t < 4; ++t) {
        f32x4 o = {0.f, 0.f, 0.f, 0.f};
#pragma unroll
        for (int i = 0; i < 8; ++i) { const int dd = t * 128 + 16 * w + 2 * i + rp; const float dec = DEC[dd], k = KK[dd], q = QQ[dd];
            S[i] = S[i] * dec + v4[t] * k; o += S[i] * q; }
#pragma unroll
        for (int e = 0; e < 4; ++e) o[e] += __shfl_xor(o[e], 32);
        if (rp == 0) *(LAS f32x4*)(L + SR_OPART + ((w * 4 + t) * 128 + e4) * 4) = o;
    }
#pragma unroll
    for (int i = 0; i < 8; ++i) *(f32x4*)(so + (size_t)(16 * w + 2 * i + rp) * 128 + e4) = S[i];
    __syncthreads();
    {
        const int e = d; float o = 0.f;
#pragma unroll
        for (int ww = 0; ww < 8; ++ww) o += *(const LAS float*)(L + SR_OPART + ((ww * 4 + tt) * 128 + e) * 4);
        float ss = wave_sum(o * o);
        LAS float* RED = (LAS float*)(L + SR_RED);
        if (lane == 0) RED[w] = ss;
        __syncthreads();
        ss = RED[w & ~1] + RED[w | 1];
        const float rs = rsqrtf(ss * (1.f / 128.f) + EPS);
        const float val = o * rs * bf2f(pb[rowt * PBW + gcol + e]);
        const float other = __shfl_xor(val, 1);
        if ((e & 1) == 0) *(unsigned*)(ob + rowt * D + kind * 512 + h * 128 + e) = pk_bf16(val, other);
    }
    __syncthreads();
}
constexpr int AT_KRS = 528, AT_VRS = 272, AT_STAGE = 69632, AT_SCR = 2 * AT_STAGE, AT_END = AT_SCR + 1024;
static_assert(128 * AT_KRS <= AT_STAGE && 256 * AT_VRS <= AT_STAGE && AT_END <= RING_BYTES, "attention LDS");
template <int N> struct IC { static constexpr int value = N; };

__device__ __forceinline__ void attn_prompt_unit(Frame& F, const Args& a, int unit) {
    const int b = unit >> 5, head = (unit >> 3) & 3, qb = unit & 7;
    unsigned char* ws = a.ws;
    const bf16_t* Q = (const bf16_t*)(ws + WS_Q); const bf16_t* MK = (const bf16_t*)(ws + WS_MK); const bf16_t* MV = (const bf16_t*)(ws + WS_MV); bf16_t* O = (bf16_t*)(ws + WS_OB);
    LAS unsigned char* L = F.lds + RING_OFF;
    const int lane = F.lane, w = F.wave, r32 = lane & 31, hh = lane >> 5, g = (lane >> 4) & 1, q4 = (lane & 15) >> 2, p4 = lane & 3, tid = F.tid;
    const int qrow0 = b * T + qb * 256 + w * 32;
    const bf16_t* qp = Q + (size_t)(qrow0 + r32) * D + head * XHD + 8 * hh;
    u32x4 ld[8];
    const bf16_t* kg = MK + (size_t)(b * NMEM + (tid >> 5)) * D + head * XHD + (tid & 31) * 8;
    const bf16_t* vg = MV + (size_t)(b * NMEM + (tid >> 4)) * D + head * XHD + (tid & 15) * 8;
    const int kl = (tid >> 5) * AT_KRS + (tid & 31) * 16, vl = (tid >> 4) * AT_VRS + (tid & 15) * 16;
    auto load_k = [&](int kh) { const bf16_t* p = kg + (size_t)kh * 128 * D; asm volatile("" : "+v"(p));
#pragma unroll
        for (int j = 0; j < 8; ++j) ld[j] = *(const u32x4*)(p + (size_t)j * 16 * D); };
    auto write_k = [&](int buf) { LAS unsigned char* p = L + buf * AT_STAGE + kl; asm volatile("" : "+v"(p));
#pragma unroll
        for (int j = 0; j < 8; ++j) *(LAS u32x4*)(p + j * 16 * AT_KRS) = ld[j]; };
    auto load_v = [&](int eh) { const bf16_t* p = vg + eh * 128; asm volatile("" : "+v"(p));
#pragma unroll
        for (int j = 0; j < 8; ++j) ld[j] = *(const u32x4*)(p + (size_t)j * 32 * D); };
    auto write_v = [&](int buf) { LAS unsigned char* p = L + buf * AT_STAGE + vl; asm volatile("" : "+v"(p));
#pragma unroll
        for (int j = 0; j < 8; ++j) *(LAS u32x4*)(p + j * 32 * AT_VRS) = ld[j]; };
    f32x16v Sc[8];
#pragma unroll
    for (int m = 0; m < 8; ++m)
#pragma unroll
        for (int i = 0; i < 16; ++i) Sc[m][i] = 0.f;
    auto pass1 = [&](auto KH, int buf) {
        constexpr int kh = decltype(KH)::value;
        const LAS unsigned char* B = L + buf * AT_STAGE + r32 * AT_KRS + 16 * hh;
#pragma unroll
        for (int kb = 0; kb < 4; ++kb) {
            bf16x8v qf[4];
#pragma unroll
            for (int k8 = 0; k8 < 4; ++k8) qf[k8] = *(const bf16x8v*)(qp + 16 * (4 * kb + k8));
#pragma unroll
            for (int k8 = 0; k8 < 4; ++k8)
#pragma unroll
                for (int mt = 0; mt < 4; ++mt) { const bf16x8v kf = *(const LAS bf16x8v*)(B + 32 * mt * AT_KRS + 32 * (4 * kb + k8));
                    Sc[4 * kh + mt] = MFMA32(kf, qf[k8], Sc[4 * kh + mt]); }
        }
    };
    load_k(0); write_k(0); __syncthreads();
    load_k(1); pass1(IC<0>{}, 0); write_k(1); __syncthreads();
    pass1(IC<1>{}, 1);
    load_v(0);
    float mx = Sc[0][0];
#pragma unroll
    for (int m = 0; m < 8; ++m)
#pragma unroll
        for (int i = 0; i < 16; ++i) mx = fmaxf(mx, Sc[m][i]);
    mx = fmaxf(mx, __shfl_xor(mx, 32));
    const float ml = mx * 1.4426950408889634f; float sum = 0.f;
    bf16x8v Pp[8][2];
#pragma unroll
    for (int m = 0; m < 8; ++m) {
#pragma unroll
        for (int i = 0; i < 16; ++i) { const float p = exp2f(Sc[m][i] * 1.4426950408889634f - ml); Sc[m][i] = p; sum += p; }
        Pp[m][0] = pack_step(Sc[m], 0); Pp[m][1] = pack_step(Sc[m], 1);
        asm volatile("" : "+v"(Pp[m][0]), "+v"(Pp[m][1]));
    }
    sum += __shfl_xor(sum, 32);
    LAS float* scr = (LAS float*)(L + AT_SCR) + w * 32;
    if (hh == 0) scr[r32] = 1.f / sum;
    write_v(0); __syncthreads();
    auto pass2 = [&](int eh, int buf) {
        f32x16v Oa[4];
#pragma unroll
        for (int et = 0; et < 4; ++et)
#pragma unroll
            for (int i = 0; i < 16; ++i) Oa[et][i] = 0.f;
        const LAS unsigned char* B = L + buf * AT_STAGE + (4 * hh + q4) * AT_VRS + (16 * g + 4 * p4) * 2;
#pragma unroll
        for (int mt = 0; mt < 8; ++mt)
#pragma unroll
            for (int kk = 0; kk < 2; ++kk)
#pragma unroll
                for (int et = 0; et < 4; ++et) { const LAS unsigned char* vp = B + (32 * mt + 16 * kk) * AT_VRS + 64 * et;
                    Oa[et] = MFMA32(Pp[mt][kk], cat8(tr16(vp), tr16(vp + 8 * AT_VRS)), Oa[et]); }
        f32x4 inv[4];
#pragma unroll
        for (int gq = 0; gq < 4; ++gq) inv[gq] = *(const LAS f32x4*)(scr + 8 * gq + 4 * hh);
#pragma unroll
        for (int et = 0; et < 4; ++et)
#pragma unroll
            for (int i = 0; i < 16; ++i) { const float val = Oa[et][i] * inv[i >> 2][i & 3]; const float other = __shfl_xor(val, 1);
                if (((lane ^ i) & 1) == 0) { const int row = qrow0 + crow(i, hh), col = head * XHD + 128 * eh + 32 * et + (r32 & ~1);
                    *(unsigned*)(O + (size_t)row * D + col) = (lane & 1) ? pk_bf16(other, val) : pk_bf16(val, other); } }
    };
    load_v(1); pass2(0, 0); write_v(1); __syncthreads();
    pass2(1, 1);
    __syncthreads();
}

constexpr int AS_SC = 0, AS_PL = 4096, AS_OPART = 8192, AS_END = AS_OPART + 32768;
__device__ __forceinline__ f32x4 bf4_to_f32(unsigned long long u) {
    return (f32x4){__uint_as_float((unsigned)u << 16), __uint_as_float((unsigned)u & 0xffff0000u), __uint_as_float((unsigned)(u >> 32) << 16), __uint_as_float((unsigned)(u >> 32) & 0xffff0000u)};
}
__device__ __forceinline__ void attn_sample_item(Frame& F, const Args& a, int item) {
    const int b = item >> 2, head = item & 3;
    unsigned char* ws = a.ws;
    const bf16_t* Q = (const bf16_t*)(ws + WS_Q); bf16_t* O = (bf16_t*)(ws + WS_OB);
    const float* Kf = a.in[I_CK] + ((size_t)b * NMEM * XH + head) * XHD; const float* Vf = a.in[I_CV] + ((size_t)b * NMEM * XH + head) * XHD;
    LAS unsigned char* L = F.lds + RING_OFF;
    const int lane = F.lane, w = F.wave, tid = F.tid;
    f32x4 q4v[4];
#pragma unroll
    for (int t = 0; t < 4; ++t) q4v[t] = bf4_to_f32(*(const unsigned long long*)(Q + ((size_t)MP + 4 * b + t) * D + head * XHD + 4 * lane));
    float r64[64], r32v[32], r16[16], r8[8], r4[4], r2[2];
#pragma unroll
    for (int pr = 0; pr < 2; ++pr) {
        float pa[32], pbv[32];
#pragma unroll
        for (int half = 0; half < 2; ++half) {
            f32x4 k4[8];
#pragma unroll
            for (int jj = 0; jj < 8; ++jj) k4[jj] = *(const f32x4*)(Kf + (size_t)(32 * w + 16 * half + 8 * pr + jj) * (XH * XHD) + 4 * lane);
#pragma unroll
            for (int jj = 0; jj < 8; ++jj)
#pragma unroll
                for (int t = 0; t < 4; ++t) { const float dv = (q4v[t][0] * k4[jj][0] + q4v[t][1] * k4[jj][1]) + (q4v[t][2] * k4[jj][2] + q4v[t][3] * k4[jj][3]);
                    if (half == 0) pa[jj * 4 + t] = dv; else pbv[jj * 4 + t] = dv; }
        }
        const bool bit = lane & 32;
#pragma unroll
        for (int i = 0; i < 32; ++i) { const float keep = bit ? pbv[i] : pa[i], send = bit ? pa[i] : pbv[i]; r64[32 * pr + i] = keep + __shfl_xor(send, 32); }
    }
    { const bool bit = lane & 16;
#pragma unroll
      for (int i = 0; i < 32; ++i) { const float keep = bit ? r64[i + 32] : r64[i], send = bit ? r64[i] : r64[i + 32]; r32v[i] = keep + __shfl_xor(send, 16); } }
    { const bool bit = lane & 8;
#pragma unroll
      for (int i = 0; i < 16; ++i) { const float keep = bit ? r32v[i + 16] : r32v[i], send = bit ? r32v[i] : r32v[i + 16]; r16[i] = keep + __shfl_xor(send, 8); } }
    { const bool bit = lane & 4;
#pragma unroll
      for (int i = 0; i < 8; ++i) { const float keep = bit ? r16[i + 8] : r16[i], send = bit ? r16[i] : r16[i + 8]; r8[i] = keep + __shfl_xor(send, 4); } }
    { const bool bit = lane & 2;
#pragma unroll
      for (int i = 0; i < 4; ++i) { const float keep = bit ? r8[i + 4] : r8[i], send = bit ? r8[i] : r8[i + 4]; r4[i] = keep + __shfl_xor(send, 2); } }
    { const bool bit = lane & 1;
#pragma unroll
      for (int i = 0; i < 2; ++i) { const float keep = bit ? r4[i + 2] : r4[i], send = bit ? r4[i] : r4[i + 2]; r2[i] = keep + __shfl_xor(send, 1); } }
    { LAS float* SC = (LAS float*)(L + AS_SC); const int m = 32 * w + (lane >> 1), t0 = 2 * (lane & 1); SC[t0 * 256 + m] = r2[0]; SC[(t0 + 1) * 256 + m] = r2[1]; }
    __syncthreads();
    if (w < 4) {
        const f32x4 s4 = *(const LAS f32x4*)(L + AS_SC + (w * 256 + 4 * lane) * 4);
        float mx = fmaxf(fmaxf(s4[0], s4[1]), fmaxf(s4[2], s4[3]));
#pragma unroll
        for (int o = 1; o < 64; o <<= 1) mx = fmaxf(mx, __shfl_xor(mx, o));
        f32x4 p; float sum = 0.f;
#pragma unroll
        for (int e = 0; e < 4; ++e) { p[e] = __expf(s4[e] - mx); sum += p[e]; }
        sum = wave_sum(sum); const float inv = 1.f / sum;
        LAS float* PL = (LAS float*)(L + AS_PL);
#pragma unroll
        for (int e = 0; e < 4; ++e) PL[(4 * lane + e) * 4 + w] = p[e] * inv;
    }
    __syncthreads();
    f32x4 acc[4];
#pragma unroll
    for (int t = 0; t < 4; ++t) acc[t] = (f32x4){0.f, 0.f, 0.f, 0.f};
#pragma unroll
    for (int grp = 0; grp < 4; ++grp) {
        f32x4 v4[8];
#pragma unroll
        for (int jj = 0; jj < 8; ++jj) v4[jj] = *(const f32x4*)(Vf + (size_t)(32 * w + 8 * grp + jj) * (XH * XHD) + 4 * lane);
#pragma unroll
        for (int jj = 0; jj < 8; ++jj) { const f32x4 p4v = *(const LAS f32x4*)(L + AS_PL + (32 * w + 8 * grp + jj) * 16);
#pragma unroll
            for (int t = 0; t < 4; ++t) acc[t] += v4[jj] * p4v[t]; }
    }
#pragma unroll
    for (int t = 0; t < 4; ++t) *(LAS f32x4*)(L + AS_OPART + ((w * 4 + t) * 256 + 4 * lane) * 4) = acc[t];
    __syncthreads();
    { const int t = tid >> 7, c2 = (tid & 127) * 2; float o0 = 0.f, o1 = 0.f;
#pragma unroll
      for (int ww = 0; ww < 8; ++ww) { const f32x2_t v = *(const LAS f32x2_t*)(L + AS_OPART + ((ww * 4 + t) * 256 + c2) * 4); o0 += v[0]; o1 += v[1]; }
      *(unsigned*)(O + ((size_t)MP + 4 * b + t) * D + head * XHD + c2) = pk_bf16(o0, o1); }
    __syncthreads();
}
enum { PH_PREP = 0, PH_INPROJ = 1, PH_REC = 2, PH_OUTPROJ = 3, PH_XQ = 4, PH_ATTN = 5, PH_XO = 6, PH_GU = 7, PH_DOWN = 8, PH_FINAL = 9, PH_MEMKV = 10, PH_COUNT = 11 };

__global__ void __launch_bounds__(NWAVES * 64, 2) mega(Args args) {
    extern __shared__ __attribute__((aligned(16))) unsigned char lds[];
    Frame F;
    F.lds = (LAS unsigned char*)lds; F.MISC = (volatile LAS unsigned*)(F.lds + MISC_OFF);
    F.tid = threadIdx.x; F.lane = F.tid & 63; F.wave = __builtin_amdgcn_readfirstlane(F.tid >> 6);
    F.G = gridDim.x; { const int bx = blockIdx.x; F.vcu = (F.G % 8 == 0) ? (bx % 8) * (F.G / 8) + bx / 8 : bx; }
    unsigned char* ws = args.ws;
    F.ctl = (gu32*)(ws + WS_CTL);
    for (int u = F.tid; u < (LDS_BYTES - LDSCTL_OFF) / 4; u += NWAVES * 64) ((LAS unsigned*)(F.lds + LDSCTL_OFF))[u] = 0u;
    __syncthreads();
    const int lo = args.ph_lo, hi = args.ph_hi;
    XcdBarrier bar; bar.bar = (unsigned*)(F.ctl + CW_BAR) + args.li * XCD_BAR_WORDS; bar.x = 0; bar.st = nullptr;
    if (hi - lo > 1) bar = xcd_barrier_post((unsigned*)(F.ctl + CW_BAR) + args.li * XCD_BAR_WORDS, F.MISC + 8);
#define IN(k) (lo <= (k) && (k) < hi)
#define BOTH(k) (IN(k) && IN((k) + 1))
    if (IN(PH_PREP)) { phase_prep(F, args); if (BOTH(PH_PREP)) xcd_barrier(bar); }
    if (IN(PH_INPROJ)) {
        pg8::Gemm g{(const bf16_t*)(ws + WS_XB0), (const bf16_t*)(ws + WS_W_IN), MT, INW, D};
        pg8::StaticOrder S; S.init(MT, INW, F.G, (int)blockIdx.x);
        EpiInProj E{(const float*)(ws + WS_RS0), (const float*)(ws + WS_CS), (const float*)(ws + WS_LOW), args.in[I_RGAIN], args.in[I_HGAIN], (bf16_t*)(ws + WS_PB), (float*)(ws + WS_LF)};
        pg8::gemm_phase<EpiInProj, pg8::StaticOrder, PG8_ALIGN, PG8_SP2>(F.lds + RING_OFF, g, S, E);
        {
            pg8::Gemm g2{(const bf16_t*)(ws + WS_MB), (const bf16_t*)(ws + WS_W_KV), MMEM, 2 * D, D};
            pg8::StaticOrder S2; S2.init(MMEM, 2 * D, F.G, F.G - 1 - (int)blockIdx.x);
            EpiMemKV E2{(const float*)(ws + WS_RSM), args.out + O_MEMK, args.out + O_MEMV, (bf16_t*)(ws + WS_MK), (bf16_t*)(ws + WS_MV)};
            pg8::gemm_phase<EpiMemKV, pg8::StaticOrder, PG8_ALIGN, PG8_SP2>(F.lds + RING_OFF, g2, S2, E2);
        }
        if (BOTH(PH_INPROJ)) xcd_barrier(bar);
    }
    if (IN(PH_REC)) {
        if ((int)blockIdx.x < 64) rec_prompt_unit(F, args, (int)blockIdx.x);
        else for (int it = (int)blockIdx.x - 64; it < 1024; it += F.G - 64) rec_sample_item(F, args, it);
        if (BOTH(PH_REC)) xcd_barrier(bar);
    }
    if (IN(PH_OUTPROJ)) {
        pg8::Gemm g{(const bf16_t*)(ws + WS_OB), (const bf16_t*)(ws + WS_W_OUT), MT, D, D};
        pg8::StaticOrder S; S.init(MT, D, F.G, (int)blockIdx.x);
        EpiResid E{args.in[I_XP], args.in[I_XS], args.out + O_Y, (bf16_t*)(ws + WS_XB1), (float*)(ws + WS_ST1)};
        pg8::gemm_phase<EpiResid, pg8::StaticOrder, PG8_ALIGN, PG8_SP2>(F.lds + RING_OFF, g, S, E);
        if (BOTH(PH_OUTPROJ)) xcd_barrier(bar);
    }
    if (IN(PH_XQ)) {
        pg8::Gemm g{(const bf16_t*)(ws + WS_XB1), (const bf16_t*)(ws + WS_W_XQ), MT, D, D};
        pg8::StaticOrder S; S.init(MT, D, F.G, (int)blockIdx.x);
        EpiScaleBf16 E{(const float*)(ws + WS_ST1), (bf16_t*)(ws + WS_Q), 0.0625f};
        pg8::gemm_phase<EpiScaleBf16, pg8::StaticOrder, PG8_ALIGN, PG8_SP2>(F.lds + RING_OFF, g, S, E);
        if (BOTH(PH_XQ)) xcd_barrier(bar);
    }
    if (IN(PH_ATTN)) {
        for (int u = (int)blockIdx.x; u < 256; u += F.G) attn_prompt_unit(F, args, u);
        for (int it = (int)blockIdx.x; it < 512; it += F.G) attn_sample_item(F, args, it);
        if (BOTH(PH_ATTN)) xcd_barrier(bar);
    }
    if (IN(PH_XO)) {
        pg8::Gemm g{(const bf16_t*)(ws + WS_OB), (const bf16_t*)(ws + WS_W_XO), MT, D, D};
        pg8::StaticOrder S; S.init(MT, D, F.G, (int)blockIdx.x);
        EpiResid E{args.out + O_Y, args.out + O_Y + (size_t)MP * D, args.out + O_Y, (bf16_t*)(ws + WS_XB2), (float*)(ws + WS_ST2)};
        pg8::gemm_phase<EpiResid, pg8::StaticOrder, PG8_ALIGN, PG8_SP2>(F.lds + RING_OFF, g, S, E);
        if (BOTH(PH_XO)) xcd_barrier(bar);
    }
    if (IN(PH_GU)) {
        pg8::Gemm g{(const bf16_t*)(ws + WS_XB2), (const bf16_t*)(ws + WS_W_GU), MT, 2 * DFF, D};
        pg8::StaticOrder S; S.init(MT, 2 * DFF, F.G, (int)blockIdx.x);
        EpiGateUp E{(const float*)(ws + WS_ST2), (bf16_t*)(ws + WS_ACT)};
        pg8::gemm_phase<EpiGateUp, pg8::StaticOrder, PG8_ALIGN, PG8_SP2>(F.lds + RING_OFF, g, S, E);
        if (BOTH(PH_GU)) xcd_barrier(bar);
    }
    if (IN(PH_DOWN)) {
        pg8::Gemm g{(const bf16_t*)(ws + WS_ACT), (const bf16_t*)(ws + WS_W_DN), MT, D, DFF};
        pg8::StaticOrder S; S.init(MT, D, F.G, (int)blockIdx.x);
        EpiResid E{args.out + O_Y, args.out + O_Y + (size_t)MP * D, args.out + O_Y, (bf16_t*)(ws + WS_XB1), (float*)(ws + WS_ST3)};
        pg8::gemm_phase<EpiResid, pg8::StaticOrder, PG8_ALIGN, PG8_SP2>(F.lds + RING_OFF, g, S, E);
        if (BOTH(PH_DOWN)) xcd_barrier(bar);
    }
    if (IN(PH_FINAL)) phase_final(F, args);
#undef IN
#undef BOTH
}

__global__ void __launch_bounds__(128) mixer_naive2(const bf16_t* __restrict__ pb, const float* __restrict__ lf, const float* __restrict__ s0_ret, const float* __restrict__ s0_hg,
                                                    float* __restrict__ sout_ret, float* __restrict__ sout_hg, float* o_f32, bf16_t* ob, int Tn, int row0, int prompt) {
    __shared__ float qs[128], ks[128], fs[128], red[2];
    const int bh = blockIdx.x, b = bh >> 2, h = bh & 3, e = threadIdx.x, kind = blockIdx.y;
    float S[128];
    const float* s0 = kind == 0 ? s0_ret : s0_hg;
#pragma unroll
    for (int d = 0; d < 128; ++d) { const int dor = kind == 0 ? ((d & 1) ? 64 + (d >> 1) : (d >> 1)) : d; S[d] = s0 ? s0[((size_t)bh * 128 + dor) * 128 + e] : 0.f; }
    const float gamma = 1.f - exp2f(-5.f - (float)h);
    for (int t = 0; t < Tn; ++t) {
        const size_t row = (size_t)row0 + (size_t)b * Tn + t;
        const bf16_t* pr = pb + row * PBW;
        __syncthreads();
        if (kind == 0) {
            float q = bf2f(pr[h * 128 + e]), k = bf2f(pr[512 + h * 128 + e]);
            if (prompt) { const float n = (float)((t & 31) + 1); q *= powf(gamma, -n); k *= powf(gamma, n); }
            qs[e] = q; ks[e] = k; fs[e] = gamma;
        } else {
            const float f = expf(lf[row * 512 + h * 128 + e]);
            fs[e] = f; ks[e] = 1.f - f; qs[e] = bf2f(pr[2048 + h * 128 + e]);
        }
        __syncthreads();
        const float v = bf2f(kind == 0 ? pr[1024 + h * 128 + e] : pr[2560 + h * 128 + e]);
        float o = 0.f;
#pragma unroll
        for (int d = 0; d < 128; ++d) { S[d] = fs[d] * S[d] + ks[d] * v; o += qs[d] * S[d]; }
        float ss = o * o;
        for (int of = 32; of > 0; of >>= 1) ss += __shfl_xor(ss, of);
        __syncthreads();
        if ((e & 63) == 0) red[e >> 6] = ss;
        __syncthreads();
        ss = red[0] + red[1];
        const float rs = rsqrtf(ss * (1.f / 128.f) + EPS);
        const float gate = bf2f(kind == 0 ? pr[1536 + h * 128 + e] : pr[3072 + h * 128 + e]);
        const float val = o * rs * gate;
        if (o_f32) o_f32[((size_t)b * Tn + t) * D + kind * 512 + h * 128 + e] = val;
        if (ob) { const float other = __shfl_xor(val, 1); if ((e & 1) == 0) *(unsigned*)(ob + row * D + kind * 512 + h * 128 + e) = pk_bf16(val, other); }
    }
    float* so = kind == 0 ? sout_ret : sout_hg;
#pragma unroll
    for (int d = 0; d < 128; ++d) { const int dor = kind == 0 ? ((d & 1) ? 64 + (d >> 1) : (d >> 1)) : d; so[((size_t)bh * 128 + dor) * 128 + e] = S[d]; }
}
__global__ void __launch_bounds__(256) xattn_naive2(const bf16_t* __restrict__ q, const bf16_t* __restrict__ Kb, const bf16_t* __restrict__ Vb, const float* __restrict__ Kf, const float* __restrict__ Vf,
                                                    bf16_t* __restrict__ out, int row0, int tpb) {
    __shared__ float qs[256], ps[256], red[4];
    const int r = blockIdx.x, head = blockIdx.y, b = r / tpb, tid = threadIdx.x; const size_t row = (size_t)row0 + r;
    qs[tid] = bf2f(q[row * D + head * XHD + tid]);
    __syncthreads();
    const size_t kro = (((size_t)b * NMEM + tid) * XH + head) * XHD;
    float s = 0.f;
    for (int d = 0; d < XHD; ++d) s += qs[d] * (Kf ? Kf[kro + d] : bf2f(Kb[kro + d]));
    for (int o = 32; o > 0; o >>= 1) {}
    float mx = s;
    for (int o = 32; o > 0; o >>= 1) mx = fmaxf(mx, __shfl_xor(mx, o));
    if ((tid & 63) == 0) red[tid >> 6] = mx;
    __syncthreads();
    mx = fmaxf(fmaxf(red[0], red[1]), fmaxf(red[2], red[3]));
    __syncthreads();
    const float p = expf(s - mx);
    float sum = p;
    for (int o = 32; o > 0; o >>= 1) sum += __shfl_xor(sum, o);
    if ((tid & 63) == 0) red[tid >> 6] = sum;
    __syncthreads();
    sum = (red[0] + red[1]) + (red[2] + red[3]);
    ps[tid] = p / sum;
    __syncthreads();
    float o = 0.f;
    for (int m = 0; m < NMEM; ++m) { const size_t vo = (((size_t)b * NMEM + m) * XH + head) * XHD + tid; o += ps[m] * (Vf ? Vf[vo] : bf2f(Vb[vo])); }
    const float other = __shfl_xor(o, 1);
    if ((tid & 1) == 0) *(unsigned*)(out + row * D + head * XHD + tid) = pk_bf16(o, other);
}
}
namespace nv {
constexpr int D = 1024, T = 2048, NB = 8, MP = NB * T, SB = 128, ST = 4, MS = SB * ST;
constexpr int INW = 4096, NMEM = 256, XH = 4, XHD = 256, DFF = 2816, PAST = 16384;
constexpr float EPS = 1e-6f;

struct RopeTab { float inv_freq[64]; };

__device__ __forceinline__ void sincos_d(double x, double& s, double& c) {
    const double two_over_pi = 0.63661977236758134308;
    const double pio2_hi = 1.57079632673412561417e+00, pio2_lo = 6.07710050650619224932e-11, pio2_lo2 = 2.02226624879595063154e-21;
    double qd = rint(x * two_over_pi);
    double r = x - qd * pio2_hi; r -= qd * pio2_lo; r -= qd * pio2_lo2;
    long long q = (long long)qd;
    double r2 = r * r;
    double sp = r * (1.0 + r2 * (-1.0 / 6 + r2 * (1.0 / 120 + r2 * (-1.0 / 5040 + r2 * (1.0 / 362880 + r2 * (-1.0 / 39916800 + r2 * (1.0 / 6227020800.0 + r2 * (-1.0 / 1307674368000.0))))))));
    double cp = 1.0 + r2 * (-0.5 + r2 * (1.0 / 24 + r2 * (-1.0 / 720 + r2 * (1.0 / 40320 + r2 * (-1.0 / 3628800 + r2 * (1.0 / 479001600.0 + r2 * (-1.0 / 87178291200.0 + r2 * (1.0 / 20922789888000.0))))))));
    switch (q & 3) {
        case 0: s = sp; c = cp; break;
        case 1: s = cp; c = -sp; break;
        case 2: s = -sp; c = -cp; break;
        default: s = -cp; c = sp; break;
    }
}

__device__ __forceinline__ float silu_f(float x) { return x / (1.f + expf(-x)); }
__device__ __forceinline__ float sigmoid_f(float x) { return 1.f / (1.f + expf(-x)); }

__device__ __forceinline__ float block_sum_256(float v, float* red) {
    for (int o = 32; o > 0; o >>= 1) v += __shfl_xor(v, o);
    const int w = threadIdx.x >> 6;
    __syncthreads();
    if ((threadIdx.x & 63) == 0) red[w] = v;
    __syncthreads();
    float s = 0.f;
    for (int i = 0; i < (int)(blockDim.x >> 6); ++i) s += red[i];
    return s;
}
__device__ __forceinline__ float block_max_256(float v, float* red) {
    for (int o = 32; o > 0; o >>= 1) v = fmaxf(v, __shfl_xor(v, o));
    const int w = threadIdx.x >> 6;
    __syncthreads();
    if ((threadIdx.x & 63) == 0) red[w] = v;
    __syncthreads();
    float s = red[0];
    for (int i = 1; i < (int)(blockDim.x >> 6); ++i) s = fmaxf(s, red[i]);
    return s;
}

__global__ void __launch_bounds__(256) rmsnorm_k(const float* x, const float* __restrict__ g, float* y) {
    __shared__ float red[4];
    const size_t row = blockIdx.x;
    const float4 v = ((const float4*)(x + row * D))[threadIdx.x];
    float ss = v.x * v.x + v.y * v.y + v.z * v.z + v.w * v.w;
    ss = block_sum_256(ss, red);
    const float rs = rsqrtf(ss * (1.f / D) + EPS);
    const float4 gg = ((const float4*)g)[threadIdx.x];
    float4 o; o.x = v.x * rs * gg.x; o.y = v.y * rs * gg.y; o.z = v.z * rs * gg.z; o.w = v.w * rs * gg.w;
    ((float4*)(y + row * D))[threadIdx.x] = o;
}

template <int MODE>
__global__ void __launch_bounds__(256) gemm_naive(const float* __restrict__ A, const float* __restrict__ B, const float* __restrict__ B2,
                                                  const float* R, float* C, int M, int N, int K) {
    __shared__ float As[16][64 + 4];
    __shared__ float Bs[16][64 + 4];
    __shared__ float Bs2[MODE == 2 ? 16 : 1][64 + 4];
    const int tx = threadIdx.x & 15, ty = threadIdx.x >> 4;
    const int m0 = blockIdx.y * 64, n0 = blockIdx.x * 64;
    float acc[4][4] = {}, acc2[4][4] = {};
    for (int k0 = 0; k0 < K; k0 += 16) {
        {
            const int r = threadIdx.x >> 2, c4 = (threadIdx.x & 3) * 4;
            const float4 v = *(const float4*)(A + (size_t)(m0 + r) * K + k0 + c4);
            As[c4 + 0][r] = v.x; As[c4 + 1][r] = v.y; As[c4 + 2][r] = v.z; As[c4 + 3][r] = v.w;
            const int kr = threadIdx.x >> 4, c = (threadIdx.x & 15) * 4;
            const float4 w = *(const float4*)(B + (size_t)(k0 + kr) * N + n0 + c);
            Bs[kr][c] = w.x; Bs[kr][c + 1] = w.y; Bs[kr][c + 2] = w.z; Bs[kr][c + 3] = w.w;
            if (MODE == 2) {
                const float4 w2 = *(const float4*)(B2 + (size_t)(k0 + kr) * N + n0 + c);
                Bs2[kr][c] = w2.x; Bs2[kr][c + 1] = w2.y; Bs2[kr][c + 2] = w2.z; Bs2[kr][c + 3] = w2.w;
            }
        }
        __syncthreads();
#pragma unroll
        for (int kk = 0; kk < 16; ++kk) {
            float a[4], b[4], b2[4];
#pragma unroll
            for (int i = 0; i < 4; ++i) a[i] = As[kk][ty * 4 + i];
#pragma unroll
            for (int j = 0; j < 4; ++j) { b[j] = Bs[kk][tx * 4 + j]; b2[j] = (MODE == 2) ? Bs2[kk][tx * 4 + j] : 0.f; }
#pragma unroll
            for (int i = 0; i < 4; ++i)
#pragma unroll
                for (int j = 0; j < 4; ++j) { acc[i][j] += a[i] * b[j]; if (MODE == 2) acc2[i][j] += a[i] * b2[j]; }
        }
        __syncthreads();
    }
#pragma unroll
    for (int i = 0; i < 4; ++i) {
        const size_t off = (size_t)(m0 + ty * 4 + i) * N + n0 + tx * 4;
        float4 o;
        if (MODE == 0) { o.x = acc[i][0]; o.y = acc[i][1]; o.z = acc[i][2]; o.w = acc[i][3]; }
        else if (MODE == 1) { const float4 r = *(const float4*)(R + off); o.x = r.x + acc[i][0]; o.y = r.y + acc[i][1]; o.z = r.z + acc[i][2]; o.w = r.w + acc[i][3]; }
        else { o.x = silu_f(acc[i][0]) * acc2[i][0]; o.y = silu_f(acc[i][1]) * acc2[i][1]; o.z = silu_f(acc[i][2]) * acc2[i][2]; o.w = silu_f(acc[i][3]) * acc2[i][3]; }
        *(float4*)(C + off) = o;
    }
}

__global__ void __launch_bounds__(128) mixer_naive(const float* __restrict__ proj, const float* __restrict__ s0_ret, const float* __restrict__ s0_hg,
                                                   float* __restrict__ sout_ret, float* __restrict__ sout_hg, float* __restrict__ o_out,
                                                   const float* __restrict__ ret_gain, const float* __restrict__ hg_gain, const float* __restrict__ hg_lb,
                                                   int Tn, int pos0, RopeTab rt) {
    __shared__ float qs[128], ks[128], fs[128], red[2];
    const int bh = blockIdx.x, b = bh >> 2, h = bh & 3, e = threadIdx.x, kind = blockIdx.y;
    float S[128];
    const float* s0 = kind == 0 ? s0_ret : s0_hg;
#pragma unroll
    for (int d = 0; d < 128; ++d) S[d] = s0 ? s0[((size_t)bh * 128 + d) * 128 + e] : 0.f;
    const float gamma = 1.f - exp2f(-5.f - (float)h);
    float lower = 0.f;
    if (kind == 1) { const float a = hg_lb[h * 128 + e], c = hg_lb[512 + h * 128 + e]; const float m = fmaxf(a, c); const float ea = expf(a - m), ec = expf(c - m); lower = ea / (ea + ec); }
    for (int t = 0; t < Tn; ++t) {
        const float* pr = proj + (size_t)(b * Tn + t) * INW;
        __syncthreads();
        if (kind == 0) {
            if (e < 64) {
                const float ang = (float)(pos0 + t) * rt.inv_freq[e];
                double sd, cd; sincos_d((double)ang, sd, cd);
                const float cs = (float)cd, sn = (float)sd;
                const float q1 = pr[h * 128 + e], q2 = pr[h * 128 + e + 64];
                qs[e] = q1 * cs - q2 * sn; qs[e + 64] = q1 * sn + q2 * cs;
                const float k1 = pr[512 + h * 128 + e], k2 = pr[512 + h * 128 + e + 64];
                const float sc = 0.08838834764831845f;
                ks[e] = (k1 * cs - k2 * sn) * sc; ks[e + 64] = (k1 * sn + k2 * cs) * sc;
            }
            fs[e] = gamma;
        } else {
            const float f = lower + (1.f - lower) * sigmoid_f(pr[2560 + h * 128 + e]);
            fs[e] = f; ks[e] = 1.f - f; qs[e] = silu_f(pr[2048 + h * 128 + e]);
        }
        __syncthreads();
        const float v = kind == 0 ? pr[1024 + h * 128 + e] : pr[3072 + h * 128 + e];
        float o = 0.f;
#pragma unroll
        for (int d = 0; d < 128; ++d) { S[d] = fs[d] * S[d] + ks[d] * v; o += qs[d] * S[d]; }
        float ss = o * o;
        for (int of = 32; of > 0; of >>= 1) ss += __shfl_xor(ss, of);
        __syncthreads();
        if ((e & 63) == 0) red[e >> 6] = ss;
        __syncthreads();
        ss = red[0] + red[1];
        const float rs = rsqrtf(ss * (1.f / 128.f) + EPS);
        const float gate = kind == 0 ? pr[1536 + h * 128 + e] : pr[3584 + h * 128 + e];
        const float gn = kind == 0 ? ret_gain[h * 128 + e] : hg_gain[h * 128 + e];
        o_out[(size_t)(b * Tn + t) * D + kind * 512 + h * 128 + e] = o * rs * gn * silu_f(gate);
    }
    float* so = kind == 0 ? sout_ret : sout_hg;
#pragma unroll
    for (int d = 0; d < 128; ++d) so[((size_t)bh * 128 + d) * 128 + e] = S[d];
}

__global__ void __launch_bounds__(256) xattn_naive(const float* __restrict__ q, const float* __restrict__ K, const float* __restrict__ V, float* __restrict__ out, int tpb) {
    __shared__ float qs[256], ps[256], red[4];
    const int row = blockIdx.x, head = blockIdx.y, b = row / tpb, tid = threadIdx.x;
    qs[tid] = q[(size_t)row * D + head * XHD + tid];
    __syncthreads();
    const float* kr = K + (((size_t)b * NMEM + tid) * XH + head) * XHD;
    float s = 0.f;
    for (int d = 0; d < XHD; d += 4) { const float4 kv = *(const float4*)(kr + d); s += qs[d] * kv.x + qs[d + 1] * kv.y + qs[d + 2] * kv.z + qs[d + 3] * kv.w; }
    s *= 0.0625f;
    const float mx = block_max_256(s, red);
    const float p = expf(s - mx);
    const float sum = block_sum_256(p, red);
    ps[tid] = p / sum;
    __syncthreads();
    float o = 0.f;
    for (int m = 0; m < NMEM; ++m) o += ps[m] * V[(((size_t)b * NMEM + m) * XH + head) * XHD + tid];
    out[(size_t)row * D + head * XHD + tid] = o;
}
}
extern "C" void kernel_launch(void* const* d_in, const int* in_sizes, int n_in, void* d_out, int out_size, void* d_ws, size_t ws_size, hipStream_t stream) {
    using namespace mk;
    static int grid = 0;
    if (grid == 0) {
        int dev = 0, cus = 0;
        if (hipGetDevice(&dev) != hipSuccess || hipDeviceGetAttribute(&cus, hipDeviceAttributeMultiprocessorCount, dev) != hipSuccess) { fprintf(stderr, "kernel_launch: device query failed\n"); grid = -1; return; }
        if (hipFuncSetAttribute((const void*)mega, hipFuncAttributeMaxDynamicSharedMemorySize, LDS_BYTES) != hipSuccess) { fprintf(stderr, "kernel_launch: hipFuncSetAttribute failed\n"); grid = -1; return; }
        (void)hipGetLastError();
        grid = cus;
    }
    if (grid < 0) return;
    hipMemsetAsync((char*)d_ws + WS_CTL, 0, CTL_ZERO_BYTES, stream);
    Args a{};
    for (int i = 0; i < 24; ++i) a.in[i] = (const float*)d_in[i];
    a.out = (float*)d_out; a.ws = (unsigned char*)d_ws;
    for (int i = 0; i < 64; ++i) a.inv_freq[i] = (float)std::pow(10000.0, -(double)i / 64.0);
    auto run = [&](int lo, int hi) { a.ph_lo = lo; a.ph_hi = hi; a.li = 0; hipLaunchKernelGGL(mega, dim3(grid), dim3(NWAVES * 64), LDS_BYTES, stream, a); };
    unsigned char* ws = (unsigned char*)d_ws; float* out = (float*)d_out;
#if STEP >= 7
    run(PH_PREP, PH_FINAL + 1);
#else
    run(PH_PREP, PH_PREP + 1);
    run(PH_INPROJ, PH_INPROJ + 1);
#if STEP == 2
    float* bufAp = (float*)(ws + 280 * MiB);
    float* bufAs = (float*)(ws + 344 * MiB);
    float* bufB = (float*)(ws + 91 * MiB);
    for (int pass = 0; pass < 2; ++pass) {
        const int nb = pass == 0 ? NB : SB, Tn = pass == 0 ? T : ST;
        mixer_naive2<<<dim3(nb * 4, 2), 128, 0, stream>>>((const bf16_t*)(ws + WS_PB), (const float*)(ws + WS_LF), pass == 0 ? nullptr : (const float*)d_in[3], pass == 0 ? nullptr : (const float*)d_in[4],
                                                          out + (pass == 0 ? O_RETP : O_RETS), out + (pass == 0 ? O_HGP : O_HGS), pass == 0 ? bufAp : bufAs, nullptr, Tn, pass == 0 ? 0 : MP, pass == 0);
    }
    for (int pass = 0; pass < 2; ++pass) {
        const int M = pass == 0 ? MP : MS, Tn = pass == 0 ? T : ST;
        float* bufA = pass == 0 ? bufAp : bufAs;
        const float* x = (const float*)d_in[pass == 0 ? 0 : 1];
        float* y = out + O_Y + (pass == 0 ? 0 : (size_t)MP * D);
        const float* mkp = pass == 0 ? out + O_MEMK : (const float*)d_in[5]; const float* mvp = pass == 0 ? out + O_MEMV : (const float*)d_in[6];
        nv::gemm_naive<1><<<dim3(D / 64, M / 64), 256, 0, stream>>>(bufA, (const float*)d_in[12], nullptr, x, y, M, D, D);
        nv::rmsnorm_k<<<M, 256, 0, stream>>>(y, (const float*)d_in[13], bufA);
        float* qb = bufB; float* ob = bufB + (size_t)MP * D;
        nv::gemm_naive<0><<<dim3(D / 64, M / 64), 256, 0, stream>>>(bufA, (const float*)d_in[15], nullptr, nullptr, qb, M, D, D);
        nv::xattn_naive<<<dim3(M, XH), 256, 0, stream>>>(qb, mkp, mvp, ob, Tn);
        nv::gemm_naive<1><<<dim3(D / 64, M / 64), 256, 0, stream>>>(ob, (const float*)d_in[18], nullptr, y, y, M, D, D);
        nv::rmsnorm_k<<<M, 256, 0, stream>>>(y, (const float*)d_in[19], bufA);
        nv::gemm_naive<2><<<dim3(DFF / 64, M / 64), 256, 0, stream>>>(bufA, (const float*)d_in[20], (const float*)d_in[21], nullptr, bufB, M, DFF, D);
        nv::gemm_naive<1><<<dim3(D / 64, M / 64), 256, 0, stream>>>(bufB, (const float*)d_in[22], nullptr, y, y, M, D, DFF);
        nv::rmsnorm_k<<<M, 256, 0, stream>>>(y, (const float*)d_in[23], y);
    }
#else
#if STEP >= 4
    run(PH_REC, PH_REC + 1);
#else
    for (int pass = 0; pass < 2; ++pass) {
        const int nb = pass == 0 ? NB : SB, Tn = pass == 0 ? T : ST;
        mixer_naive2<<<dim3(nb * 4, 2), 128, 0, stream>>>((const bf16_t*)(ws + WS_PB), (const float*)(ws + WS_LF), pass == 0 ? nullptr : (const float*)d_in[3], pass == 0 ? nullptr : (const float*)d_in[4],
                                                          out + (pass == 0 ? O_RETP : O_RETS), out + (pass == 0 ? O_HGP : O_HGS), nullptr, (bf16_t*)(ws + WS_OB), Tn, pass == 0 ? 0 : MP, pass == 0);
    }
#endif
    run(PH_OUTPROJ, PH_OUTPROJ + 1);
    run(PH_XQ, PH_XQ + 1);
#if STEP >= 6
    run(PH_ATTN, PH_ATTN + 1);
#else
    xattn_naive2<<<dim3(MP, XH), 256, 0, stream>>>((const bf16_t*)(ws + WS_Q), (const bf16_t*)(ws + WS_MK), (const bf16_t*)(ws + WS_MV), nullptr, nullptr, (bf16_t*)(ws + WS_OB), 0, T);
    xattn_naive2<<<dim3(MS, XH), 256, 0, stream>>>((const bf16_t*)(ws + WS_Q), nullptr, nullptr, (const float*)d_in[5], (const float*)d_in[6], (bf16_t*)(ws + WS_OB), MP, ST);
#endif
    run(PH_XO, PH_XO + 1);
    run(PH_GU, PH_GU + 1);
    run(PH_DOWN, PH_DOWN + 1);
    run(PH_FINAL, PH_FINAL + 1);
#endif
#endif
}
```

```cpp
#include <hip/hip_runtime.h>
#include <cmath>
#include <cstdio>
#include <cstdint>

#define STEP 7
#define DUP_PHASE (-1)
namespace pg8 {
#define PG8_LAS __attribute__((address_space(3)))
typedef unsigned short bf16_t;
typedef short bf16x8 __attribute__((ext_vector_type(8)));
typedef float f32x4 __attribute__((ext_vector_type(4)));
typedef unsigned u32x4 __attribute__((ext_vector_type(4)));
constexpr int BM = 256, BK = 64, HALF = 128, HTB = HALF * BK * 2  , STAGE_BYTES = 8 * HTB, NXCD = 8, WGM = 8;

__host__ __device__ __forceinline__ int lds_byte(int r, int c) { const int st = (r >> 4) * 2 + (c >> 5), rr = r & 15, cc = c & 31, ob = rr * 64 + cc * 2; return st * 1024 + (ob ^ (((ob >> 9) & 1) << 5)); }
__host__ __device__ __forceinline__ void stage_rc(int b, int& R, int& C) { const int st = b / 1024, sb = b % 1024, swz = sb ^ (((sb >> 9) & 1) << 5); R = (st >> 1) * 16 + swz / 64; C = (st & 1) * 32 + (swz % 64) / 2; }
__host__ __device__ __forceinline__ int perm32(int rho) { const int n = rho >> 4, i = rho & 15; return 8 * (i >> 2) + 4 * n + (i & 3); }

struct Unit { int pm, pn; };
struct Gemm { const bf16_t* A; const bf16_t* Bt; int M, N, K; };

struct StaticOrder {
    int nM, nN, nwg, G, c;
    __host__ __device__ void init(int M, int N, int G_, int c_) { nM = M / BM; nN = N / BM; nwg = nM * nN; G = G_; c = c_; }
    __host__ __device__ bool next(int i, Unit& u) const {
        const long L = (long)i * G + c; if (L >= nwg) return false;
        int wgid = (int)L; { const int q = nwg / NXCD, r = nwg % NXCD, xcd = wgid % NXCD, off = wgid / NXCD; wgid = (xcd < r ? xcd * (q + 1) : r * (q + 1) + (xcd - r) * q) + off; }
        const int nig = WGM * nN, gid = wgid / nig, fm = gid * WGM, gsz = (nM - fm) < WGM ? (nM - fm) : WGM;
        u.pm = fm + ((wgid % nig) % gsz); u.pn = (wgid % nig) / gsz; return true;
    }
    __device__ __forceinline__ void a_ready(const Unit&) const {}
    __device__ __forceinline__ void done(const Unit&) const {}
};

template <class Epi, class Sched, bool ALIGN_EPI = false, bool SP2 = false>
__device__ __forceinline__ void gemm_phase(PG8_LAS unsigned char* lds, const Gemm g, const Sched& S, const Epi& E, int wid_in) {
    const int lane = (int)__builtin_amdgcn_mbcnt_hi(~0u, __builtin_amdgcn_mbcnt_lo(~0u, 0u)), wid = __builtin_amdgcn_readfirstlane(wid_in), tid = wid * 64 + lane, wr = wid >> 2, wc = wid & 3, fr = lane & 15, fq = lane >> 4;
    const int K = g.K, nt = K / BK;
    unsigned voffA[2], voffB[2];
#pragma unroll
    for (int i = 0; i < 2; ++i) { int R, C; stage_rc(tid * 16 + i * 8192, R, C); const int Rb = Epi::PERM ? ((R & ~31) + perm32(R & 31)) : R;
        voffA[i] = (unsigned)(R * K + C) * 2u; voffB[i] = (unsigned)(Rb * K + C) * 2u; }
    const size_t kstep = (size_t)(BK * 2);
    const size_t hstep = (size_t)HALF * K * 2;
    const size_t tstep = 2 * hstep;
    const unsigned ldsw = (unsigned)wid * 1024u;
    const int aoff = lds_byte(wr * 64 + fr, fq * 8), boff = lds_byte(wc * 32 + fr, fq * 8);
#define PG8_SA(b, h) (((b) * 2 + (h)) * HTB)
#define PG8_SB(b, h) ((4 + (b) * 2 + (h)) * HTB)
#define PG8_STAGE(bufoff, gbase, voff) do { _Pragma("unroll") for (int _i = 0; _i < 2; ++_i) \
        __builtin_amdgcn_global_load_lds((const unsigned*)((const char*)(gbase) + (voff)[_i]), (PG8_LAS unsigned*)(lds + (bufoff) + ldsw + _i * 8192), 16, 0, 0); } while (0)
#define PG8_LDA(dst, b, h) do { _Pragma("unroll") for (int m = 0; m < 4; ++m) _Pragma("unroll") for (int k = 0; k < 2; ++k) dst[m][k] = *(const PG8_LAS bf16x8*)(lds + PG8_SA(b, h) + aoff + m * 2048 + k * 1024); } while (0)
#define PG8_LDB(dst, b, h) do { _Pragma("unroll") for (int n = 0; n < 2; ++n) _Pragma("unroll") for (int k = 0; k < 2; ++k) dst[n][k] = *(const PG8_LAS bf16x8*)(lds + PG8_SB(b, h) + boff + n * 2048 + k * 1024); } while (0)
#define PG8_MMA(ai, bj, At, Bt) do { __builtin_amdgcn_s_setprio(1); _Pragma("unroll") for (int m = 0; m < 4; ++m) _Pragma("unroll") for (int n = 0; n < 2; ++n) _Pragma("unroll") for (int k = 0; k < 2; ++k) \
        acc[ai][bj][m][n] = __builtin_amdgcn_mfma_f32_16x16x32_bf16(Bt[n][k], At[m][k], acc[ai][bj][m][n], 0, 0, 0); __builtin_amdgcn_s_setprio(0); } while (0)
#define PG8_WAIT_V(n) asm volatile("s_waitcnt vmcnt(" #n ")" ::: "memory")
#define PG8_WAIT_L(n) asm volatile("s_waitcnt lgkmcnt(" #n ")" ::: "memory")
#define PG8_BAR __builtin_amdgcn_s_barrier()
#define PG8_SCHED __builtin_amdgcn_sched_barrier(0)
    Unit cur, nxt; int ui = 0;
    if (!S.next(0, cur)) return;
    f32x4 acc[2][2][4][2];
#pragma unroll
    for (int a = 0; a < 2; ++a)
#pragma unroll
        for (int b = 0; b < 2; ++b)
#pragma unroll
            for (int m = 0; m < 4; ++m)
#pragma unroll
                for (int n = 0; n < 2; ++n) acc[a][b][m][n] = (f32x4){0.f, 0.f, 0.f, 0.f};
    bf16x8 At[4][2], B0[2][2], B1[2][2];
    const char* cA = (const char*)g.A + (size_t)cur.pm * tstep; const char* cB = (const char*)g.Bt + (size_t)cur.pn * tstep;
    S.a_ready(cur);
    if constexpr (SP2) {
        PG8_STAGE(PG8_SB(0, 0), cB, voffB); PG8_STAGE(PG8_SB(0, 1), cB + hstep, voffB); PG8_STAGE(PG8_SA(0, 0), cA, voffA); PG8_STAGE(PG8_SA(0, 1), cA + hstep, voffA);
        if (wr == 1) PG8_BAR;
        PG8_WAIT_V(2); PG8_BAR;
        PG8_STAGE(PG8_SB(1, 0), cB + kstep, voffB); PG8_STAGE(PG8_SA(1, 0), cA + kstep, voffA); PG8_STAGE(PG8_SB(1, 1), cB + hstep + kstep, voffB);
        PG8_WAIT_V(6); PG8_BAR;
    } else {
        PG8_STAGE(PG8_SB(0, 0), cB, voffB); PG8_STAGE(PG8_SA(0, 0), cA, voffA); PG8_STAGE(PG8_SB(0, 1), cB + hstep, voffB); PG8_STAGE(PG8_SA(0, 1), cA + hstep, voffA);
        if (wr == 1) PG8_BAR;
        PG8_WAIT_V(4); PG8_BAR;
        PG8_STAGE(PG8_SB(1, 0), cB + kstep, voffB); PG8_STAGE(PG8_SA(1, 0), cA + kstep, voffA); PG8_STAGE(PG8_SB(1, 1), cB + hstep + kstep, voffB);
        PG8_WAIT_V(6); PG8_BAR;
    }
    for (;;) {
        const bool has_next = S.next(ui + 1, nxt);
        const char* nA = has_next ? (const char*)g.A + (size_t)nxt.pm * tstep : cA; const char* nB = has_next ? (const char*)g.Bt + (size_t)nxt.pn * tstep : cB;
        for (int t = 0; t < nt; t += 2) {
            const bool last = (t == nt - 2);
            const char* a1 = cA + (size_t)(t + 1) * kstep;
            const char* a2 = last ? nA : cA + (size_t)(t + 2) * kstep; const char* b2 = last ? nB : cB + (size_t)(t + 2) * kstep;
            const char* a3 = a2 + kstep; const char* b3 = b2 + kstep;
            if (last && has_next) S.a_ready(nxt);
            if constexpr (SP2) {
            PG8_LDB(B0, 0, 0); PG8_LDB(B1, 0, 1); PG8_SCHED; PG8_LDA(At, 0, 0); PG8_STAGE(PG8_SA(1, 1), a1 + hstep, voffA);
            PG8_WAIT_V(8); PG8_WAIT_L(0); PG8_BAR; PG8_MMA(0, 0, At, B0); PG8_MMA(0, 1, At, B1); PG8_BAR; PG8_SCHED;
            PG8_LDA(At, 0, 1); PG8_STAGE(PG8_SB(0, 0), b2, voffB); PG8_STAGE(PG8_SB(0, 1), b2 + hstep, voffB); PG8_STAGE(PG8_SA(0, 0), a2, voffA);
            PG8_WAIT_V(8); PG8_WAIT_L(0); PG8_BAR; PG8_MMA(1, 0, At, B0); PG8_MMA(1, 1, At, B1); PG8_BAR; PG8_SCHED;
            PG8_LDB(B0, 1, 0); PG8_LDB(B1, 1, 1); PG8_SCHED; PG8_LDA(At, 1, 0); PG8_STAGE(PG8_SA(0, 1), a2 + hstep, voffA);
            PG8_WAIT_V(8); PG8_WAIT_L(0); PG8_BAR; PG8_MMA(0, 0, At, B0); PG8_MMA(0, 1, At, B1); PG8_BAR; PG8_SCHED;
            PG8_LDA(At, 1, 1); PG8_STAGE(PG8_SB(1, 0), b3, voffB); PG8_STAGE(PG8_SB(1, 1), b3 + hstep, voffB); PG8_STAGE(PG8_SA(1, 0), a3, voffA);
            PG8_WAIT_V(8); PG8_WAIT_L(0); PG8_BAR; PG8_MMA(1, 0, At, B0); PG8_MMA(1, 1, At, B1); PG8_BAR; PG8_SCHED;
            } else {
            PG8_LDB(B0, 0, 0); PG8_SCHED; PG8_LDA(At, 0, 0); PG8_STAGE(PG8_SA(1, 1), a1 + hstep, voffA);
            PG8_WAIT_L(8); PG8_BAR; PG8_WAIT_L(0); PG8_MMA(0, 0, At, B0); PG8_BAR; PG8_SCHED;
            PG8_LDB(B1, 0, 1); PG8_STAGE(PG8_SB(0, 0), b2, voffB);
            PG8_BAR; PG8_WAIT_L(0); PG8_MMA(0, 1, At, B1); PG8_BAR;
            PG8_LDA(At, 0, 1); PG8_STAGE(PG8_SA(0, 0), a2, voffA);
            PG8_BAR; PG8_WAIT_L(0); PG8_MMA(1, 0, At, B0); PG8_BAR; PG8_SCHED;
            PG8_STAGE(PG8_SB(0, 1), b2 + hstep, voffB);
            PG8_WAIT_V(6); PG8_BAR; PG8_MMA(1, 1, At, B1); PG8_BAR;
            PG8_LDB(B0, 1, 0); PG8_SCHED; PG8_LDA(At, 1, 0); PG8_STAGE(PG8_SA(0, 1), a2 + hstep, voffA);
            PG8_WAIT_L(8); PG8_BAR; PG8_WAIT_L(0); PG8_MMA(0, 0, At, B0); PG8_BAR; PG8_SCHED;
            PG8_LDB(B1, 1, 1); PG8_STAGE(PG8_SB(1, 0), b3, voffB);
            PG8_BAR; PG8_WAIT_L(0); PG8_MMA(0, 1, At, B1); PG8_BAR;
            PG8_LDA(At, 1, 1); PG8_STAGE(PG8_SA(1, 0), a3, voffA);
            PG8_BAR; PG8_WAIT_L(0); PG8_MMA(1, 0, At, B0); PG8_BAR; PG8_SCHED;
            PG8_STAGE(PG8_SB(1, 1), b3 + hstep, voffB);
            PG8_WAIT_V(6); PG8_BAR; PG8_MMA(1, 1, At, B1); PG8_BAR;
            }
        }
        if constexpr (ALIGN_EPI) { if (wr == 0) PG8_BAR; }
        if constexpr (!Epi::AFTER_DRAIN) { E(acc, cur, wr, wc, fr, fq); S.done(cur); }
        if (!has_next) break;
#pragma unroll
        for (int a = 0; a < 2; ++a)
#pragma unroll
            for (int b = 0; b < 2; ++b)
#pragma unroll
                for (int m = 0; m < 4; ++m)
#pragma unroll
                    for (int n = 0; n < 2; ++n) acc[a][b][m][n] = (f32x4){0.f, 0.f, 0.f, 0.f};
        cur = nxt; cA = nA; cB = nB; ++ui;
        if constexpr (ALIGN_EPI) { if (wr == 1) PG8_BAR; }
    }
    PG8_WAIT_V(0);
    if constexpr (!ALIGN_EPI) { if (wr == 0) PG8_BAR; }
    PG8_BAR;
    if constexpr (Epi::AFTER_DRAIN) { E.fused(acc, cur, wr, wc, fr, fq, lds, wid, lane); S.done(cur); }
#undef PG8_SA
#undef PG8_SB
#undef PG8_STAGE
#undef PG8_LDA
#undef PG8_LDB
#undef PG8_MMA
#undef PG8_WAIT_V
#undef PG8_WAIT_L
#undef PG8_BAR
#undef PG8_SCHED
}
}
#ifndef PG8_SP2
#define PG8_SP2 true
#endif
#ifndef PG8_ALIGN
#define PG8_ALIGN true
#endif

namespace mk {
using pg8::bf16_t; using pg8::f32x4; using pg8::u32x4; using pg8::Unit;
#define GAS __attribute__((address_space(1)))
#define LAS __attribute__((address_space(3)))
typedef GAS unsigned gu32;
#define RLX_AGENT __ATOMIC_RELAXED, __HIP_MEMORY_SCOPE_AGENT
#define LDS_WAIT() asm volatile("s_waitcnt lgkmcnt(0)" ::: "memory")
#define VM_WAIT() asm volatile("s_waitcnt vmcnt(0)" ::: "memory")

constexpr int D = 1024, T = 2048, NB = 8, MP = NB * T, SB = 128, ST = 4, MS = SB * ST, MT = MP + MS;
constexpr int INW = 4096, NMEM = 256, XH = 4, XHD = 256, DFF = 2816, PAST = 16384, MMEM = NB * NMEM;
constexpr int PBW = 4096;
constexpr float EPS = 1e-6f;
constexpr int NWAVES = 8;

constexpr size_t MiB = 1u << 20;
constexpr size_t WS_CTL = 0, CTL_ZERO_BYTES = 1 * MiB;
constexpr size_t WS_W_IN = 1 * MiB, WS_W_OUT = 9 * MiB, WS_W_XQ = 11 * MiB, WS_W_KV = 13 * MiB, WS_W_XO = 17 * MiB, WS_W_GU = 19 * MiB, WS_W_DN = 30 * MiB;
constexpr size_t WS_CS = 36 * MiB, WS_LOW = 38 * MiB, WS_RS0 = 39 * MiB, WS_RSM = WS_RS0 + 256 * 1024, WS_ST1 = 40 * MiB, WS_ST2 = 42 * MiB, WS_ST3 = 44 * MiB;
constexpr size_t WS_MB = 46 * MiB, WS_MK = 50 * MiB, WS_MV = 54 * MiB, WS_XB0 = 58 * MiB, WS_PB = 91 * MiB, WS_LF = 223 * MiB, WS_OB = 256 * MiB;
constexpr size_t WS_XB1 = 289 * MiB, WS_Q = 322 * MiB, WS_XB2 = 355 * MiB, WS_ACT = 388 * MiB, WS_END = 479 * MiB;
static_assert(WS_PB + (size_t)MT * PBW * 2 <= WS_LF && WS_LF + (size_t)MT * 512 * 4 <= WS_OB && WS_ACT + (size_t)MT * DFF * 2 <= WS_END, "ws map");
constexpr size_t WS_Y2 = WS_PB, WS_Y3 = WS_LF;
static_assert(WS_Y3 + (size_t)MT * D * 4 <= WS_XB1, "Y3 fits LF|OB");
constexpr int CW_BAR = 4096;

constexpr int RING_OFF = 0, RING_BYTES = 155648, LDSCTL_OFF = RING_BYTES, MISC_OFF = LDSCTL_OFF + 320, LDS_BYTES = 163840;

typedef float f32x2_t __attribute__((ext_vector_type(2)));
typedef __bf16 bf16x2_t __attribute__((ext_vector_type(2)));
__device__ __forceinline__ unsigned pk_bf16(float lo, float hi) { f32x2_t v = {lo, hi}; bf16x2_t b = __builtin_convertvector(v, bf16x2_t); return __builtin_bit_cast(unsigned, b); }
__device__ __forceinline__ float bf2f(unsigned short h) { return __uint_as_float((unsigned)h << 16); }
__device__ __forceinline__ float silu_f(float x) { return x / (1.f + __expf(-x)); }
__device__ __forceinline__ float sigmoid_f(float x) { return 1.f / (1.f + __expf(-x)); }

__device__ __forceinline__ void sincos_d(double x, double& s, double& c) {
    const double two_over_pi = 0.63661977236758134308;
    const double pio2_hi = 1.57079632673412561417e+00, pio2_lo = 6.07710050650619224932e-11;
    double qd = rint(x * two_over_pi);
    double r = x - qd * pio2_hi; r -= qd * pio2_lo;
    long long q = (long long)qd;
    double r2 = r * r;
    double sp = r * (1.0 + r2 * (-1.0 / 6 + r2 * (1.0 / 120 + r2 * (-1.0 / 5040 + r2 * (1.0 / 362880 + r2 * (-1.0 / 39916800 + r2 * (1.0 / 6227020800.0 + r2 * (-1.0 / 1307674368000.0))))))));
    double cp = 1.0 + r2 * (-0.5 + r2 * (1.0 / 24 + r2 * (-1.0 / 720 + r2 * (1.0 / 40320 + r2 * (-1.0 / 3628800 + r2 * (1.0 / 479001600.0 + r2 * (-1.0 / 87178291200.0 + r2 * (1.0 / 20922789888000.0))))))));
    switch (q & 3) {
        case 0: s = sp; c = cp; break;
        case 1: s = cp; c = -sp; break;
        case 2: s = -sp; c = -cp; break;
        default: s = -cp; c = sp; break;
    }
}
__device__ __forceinline__ float wave_sum(float v) {
#pragma unroll
    for (int o = 1; o < 64; o <<= 1) v += __shfl_xor(v, o);
    return v;
}
#define XB_TMO      128
#define XB_XCNT(j)  (256  + 64 * (j))
#define XB_XSUB(j)  (1280 + 64 * (j))
#define XB_XGEN(j)  (2304 + 64 * (j))
#define XB_TOP      3328
#define XB_TOPGEN   3392
#define XCD_BAR_WORDS 3456
#define XB_SPIN_CAP (1u << 18)

__device__ __forceinline__ unsigned xb_ld(unsigned* p)              { return __hip_atomic_load(p, __ATOMIC_RELAXED, __HIP_MEMORY_SCOPE_AGENT); }
__device__ __forceinline__ unsigned xb_add(unsigned* p, unsigned v) { return __hip_atomic_fetch_add(p, v, __ATOMIC_RELAXED, __HIP_MEMORY_SCOPE_AGENT); }
__device__ __forceinline__ unsigned xb_xcc_id() { return (unsigned)__builtin_amdgcn_s_getreg((3 << 11) | 20) & 0xFu; }
#define XB_SPIN(cond, bar) do { unsigned _sp = 0; while (cond) { __builtin_amdgcn_s_sleep(1); \
    if ((++_sp & 255u) == 0u) { if (xb_ld(&(bar)[XB_TMO])) break; if (_sp > XB_SPIN_CAP) { atomicAdd(&(bar)[XB_TMO], 1u); break; } } } } while (0)

struct XcdBarrier {
    unsigned* bar; unsigned x;
    volatile LAS unsigned* st;
    int wave;
};
__device__ __forceinline__ bool xb_leader(int wave) { return wave == 0 && __builtin_amdgcn_mbcnt_hi(~0u, __builtin_amdgcn_mbcnt_lo(~0u, 0u)) == 0u; }

__device__ __forceinline__ XcdBarrier xcd_barrier_post(unsigned* bar, volatile LAS unsigned* st, int wave) {
    XcdBarrier b; b.bar = bar; b.x = xb_xcc_id(); b.st = st; b.wave = wave;
    if (xb_leader(wave)) (void)xb_add(&bar[XB_XCNT(b.x)], 1u);
    return b;
}
__device__ __forceinline__ void xcd_barrier_complete(unsigned* bar, unsigned x, unsigned& nloc, unsigned& nx) {
    const unsigned G = gridDim.x * gridDim.y * gridDim.z;
    unsigned sum, cnt, mine, sp = 0u;
    for (;;) {
        sum = 0u; cnt = 0u; mine = 0u;
#pragma unroll
        for (unsigned j = 0; j < 16; ++j) { const unsigned c = xb_ld(&bar[XB_XCNT(j)]); sum += c; cnt += (c > 0u) ? 1u : 0u; mine = (j == x) ? c : mine; }
        if (sum == G) break;
        __builtin_amdgcn_s_sleep(1);
        if ((++sp & 255u) == 0u) { if (xb_ld(&bar[XB_TMO])) break; if (sp > XB_SPIN_CAP) { atomicAdd(&bar[XB_TMO], 1u); break; } }
    }
    nloc = mine > 0u ? mine : 1u; nx = cnt > 0u ? cnt : 1u;
}

__device__ __forceinline__ void xcd_barrier(const XcdBarrier& b) {
    asm volatile("s_waitcnt vmcnt(0)" ::: "memory");
    __syncthreads();
    if (xb_leader(b.wave)) {
        unsigned* bar = b.bar;
        __builtin_amdgcn_s_waitcnt(0);
        unsigned nloc = b.st[0], nx = b.st[1];
        if (nloc == 0u) { xcd_barrier_complete(bar, b.x, nloc, nx); b.st[0] = nloc; b.st[1] = nx; }
        const unsigned old = xb_add(&bar[XB_XSUB(b.x)], 1u);
        const unsigned gen = old / nloc;
        if (old + 1u == (gen + 1u) * nloc) {
            __builtin_amdgcn_fence(__ATOMIC_RELEASE, "agent");
            asm volatile("s_waitcnt vmcnt(0)" ::: "memory");
            const unsigned og = xb_add(&bar[XB_TOP], 1u);
            const unsigned tg = og / nx;
            if (og + 1u == (tg + 1u) * nx) xb_add(&bar[XB_TOPGEN], 1u);
            else XB_SPIN(xb_ld(&bar[XB_TOPGEN]) == tg, bar);
            __builtin_amdgcn_fence(__ATOMIC_ACQUIRE, "agent");
            xb_add(&bar[XB_XGEN(b.x)], 1u);
            asm volatile("s_waitcnt vmcnt(0)" ::: "memory");
        } else {
            XB_SPIN(xb_ld(&bar[XB_XGEN(b.x)]) == gen, bar);
            __builtin_amdgcn_fence(__ATOMIC_ACQUIRE, "agent");
            asm volatile("s_waitcnt vmcnt(0)" ::: "memory");
        }
    }
    __syncthreads();
}
struct Args { const float* in[24]; float* out; unsigned char* ws; float inv_freq[64]; int ph_lo, ph_hi, li, pad; };
enum { I_XP = 0, I_XS, I_MEM, I_SRET, I_SHG, I_CK, I_CV, I_GMIX, I_WIN, I_RGAIN, I_HGAIN, I_HGLB, I_WOUT, I_GXA, I_GMEM, I_WXQ, I_WXK, I_WXV, I_WXO, I_GFFN, I_WGATE, I_WUP, I_WDOWN, I_GFINAL };
constexpr size_t O_Y = 0, O_RETP = (size_t)MT * D, O_HGP = O_RETP + (size_t)NB * 4 * 16384, O_MEMK = O_HGP + (size_t)NB * 4 * 16384, O_MEMV = O_MEMK + (size_t)MMEM * D,
                 O_RETS = O_MEMV + (size_t)MMEM * D, O_HGS = O_RETS + (size_t)SB * 4 * 16384;

struct Frame {
    LAS unsigned char* lds; volatile LAS unsigned* MISC; gu32* ctl;
    int wave, vcu, G;
};
__device__ __forceinline__ int lane_id() { return (int)__builtin_amdgcn_mbcnt_hi(~0u, __builtin_amdgcn_mbcnt_lo(~0u, 0u)); }

__device__ __forceinline__ const float* wsrc(int mode, const float* s0, const float* s1, int n) {
    if (mode == 1) { if (n < 1024) { const int blk = n >> 9, h = (n & 511) >> 7, j = n & 127; return s0 + blk * 512 + h * 128 + (j >> 1) + 64 * (j & 1); } return s0 + n; }
    if (mode == 2) return n < 1024 ? s0 + n : s1 + (n - 1024);
    if (mode == 3) { const int jj = (n >> 3) * 4 + (n & 3); return (n & 4) ? s1 + jj : s0 + jj; }
    return s0 + n;
}
__device__ __forceinline__ void transpose_item(int mode, const float* s0, const float* s1, int ldw, const float* g, int K, int nblk, bf16_t* WT, LAS float* scr, int item, int lane) {
    const int kb = item / nblk, nb = item % nblk, k0 = 64 * kb, n0 = 32 * nb;
    const float* colp = wsrc(mode, s0, s1, n0 + (lane & 31));
#pragma unroll 8
    for (int i = 0; i < 32; ++i) { const int kk = 2 * i + (lane >> 5); float v = colp[(size_t)(k0 + kk) * ldw]; if (g) v *= g[k0 + kk]; scr[kk * 33 + (lane & 31)] = v; }
    LDS_WAIT(); asm volatile("" ::: "memory");
    const int c = lane & 7;
#pragma unroll
    for (int j = 0; j < 4; ++j) { const int n = (lane >> 3) + 8 * j; const LAS float* s = scr + (8 * c) * 33 + n;
        u32x4 o; o.x = pk_bf16(s[0 * 33], s[1 * 33]); o.y = pk_bf16(s[2 * 33], s[3 * 33]); o.z = pk_bf16(s[4 * 33], s[5 * 33]); o.w = pk_bf16(s[6 * 33], s[7 * 33]);
        *(GAS u32x4*)(WT + (size_t)(n0 + n) * K + k0 + 8 * c) = o; }
    LDS_WAIT(); asm volatile("" ::: "memory");
}
__device__ __forceinline__ void row_to_bf16(const float* xrow, bf16_t* orow, float* rs, int lane) {
    const GAS f32x4* xr = (const GAS f32x4*)xrow + lane;
    f32x4 v[4]; float s = 0.f;
#pragma unroll
    for (int j = 0; j < 4; ++j) { v[j] = xr[64 * j]; s += (v[j].x * v[j].x + v[j].y * v[j].y) + (v[j].z * v[j].z + v[j].w * v[j].w); }
    s = wave_sum(s);
    if (lane == 0) *rs = rsqrtf(s * (1.f / D) + EPS);
    GAS unsigned long long* o8 = (GAS unsigned long long*)orow + lane;
#pragma unroll
    for (int j = 0; j < 4; ++j) o8[64 * j] = (unsigned long long)pk_bf16(v[j].x, v[j].y) | ((unsigned long long)pk_bf16(v[j].z, v[j].w) << 32);
}
__device__ __forceinline__ void phase_prep(Frame& F, const Args& a) {
    unsigned char* ws = a.ws; const int lane = lane_id(), tid = F.wave * 64 + lane;
    LAS float* scr = (LAS float*)(F.lds + RING_OFF + F.wave * 16384);
    const int gw = F.vcu * NWAVES + F.wave, NGW = F.G * NWAVES;
    constexpr int I0 = (D / 64) * (INW / 32), I1 = (D / 64) * (D / 32), I3 = (D / 64) * (2 * D / 32), I5 = (D / 64) * (2 * DFF / 32), I6 = (DFF / 64) * (D / 32);
    constexpr int NITEMS = I0 + I1 + I1 + I3 + I1 + I5 + I6;
    for (int it = gw; it < NITEMS; it += NGW) {
        int r = it;
        if (r < I0) { transpose_item(1, a.in[I_WIN], nullptr, INW, a.in[I_GMIX], D, INW / 32, (bf16_t*)(ws + WS_W_IN), scr, r, lane); continue; } r -= I0;
        if (r < I1) { transpose_item(0, a.in[I_WOUT], nullptr, D, nullptr, D, D / 32, (bf16_t*)(ws + WS_W_OUT), scr, r, lane); continue; } r -= I1;
        if (r < I1) { transpose_item(0, a.in[I_WXQ], nullptr, D, a.in[I_GXA], D, D / 32, (bf16_t*)(ws + WS_W_XQ), scr, r, lane); continue; } r -= I1;
        if (r < I3) { transpose_item(2, a.in[I_WXK], a.in[I_WXV], D, a.in[I_GMEM], D, 2 * D / 32, (bf16_t*)(ws + WS_W_KV), scr, r, lane); continue; } r -= I3;
        if (r < I1) { transpose_item(0, a.in[I_WXO], nullptr, D, nullptr, D, D / 32, (bf16_t*)(ws + WS_W_XO), scr, r, lane); continue; } r -= I1;
        if (r < I5) { transpose_item(3, a.in[I_WGATE], a.in[I_WUP], DFF, a.in[I_GFFN], D, 2 * DFF / 32, (bf16_t*)(ws + WS_W_GU), scr, r, lane); continue; } r -= I5;
        transpose_item(0, a.in[I_WDOWN], nullptr, D, nullptr, DFF, D / 32, (bf16_t*)(ws + WS_W_DN), scr, r, lane);
    }
    for (int m = gw; m < MT + MMEM; m += NGW) {
        if (m < MP) row_to_bf16(a.in[I_XP] + (size_t)m * D, (bf16_t*)(ws + WS_XB0) + (size_t)m * D, (float*)(ws + WS_RS0) + m, lane);
        else if (m < MT) row_to_bf16(a.in[I_XS] + (size_t)(m - MP) * D, (bf16_t*)(ws + WS_XB0) + (size_t)m * D, (float*)(ws + WS_RS0) + m, lane);
        else row_to_bf16(a.in[I_MEM] + (size_t)(m - MT) * D, (bf16_t*)(ws + WS_MB) + (size_t)(m - MT) * D, (float*)(ws + WS_RSM) + (m - MT), lane);
    }
    float* cs = (float*)(ws + WS_CS);
    for (int e = F.vcu * 512 + tid; e < (T + ST) * 64; e += F.G * 512) {
        const int p = e >> 6, i = e & 63; const int pos = p < T ? p : PAST + (p - T);
        const float ang = (float)pos * a.inv_freq[i];
        double sd, cd; sincos_d((double)ang, sd, cd);
        cs[2 * e] = (float)cd; cs[2 * e + 1] = (float)sd;
    }
    if (F.vcu == 0) {
        const float* lb = a.in[I_HGLB]; float* low = (float*)(ws + WS_LOW);
        const int c = tid; const float x0 = lb[c], x1 = lb[512 + c]; const float m = fmaxf(x0, x1); const float e0 = expf(x0 - m), e1 = expf(x1 - m); low[c] = e0 / (e0 + e1);
    }
}
struct EpiMemKV {
    static constexpr bool PERM = true, AFTER_DRAIN = false;
    const float* rsm; float* outk; float* outv; bf16_t* mk; bf16_t* mv;
    __device__ __forceinline__ void operator()(const f32x4 (&acc)[2][2][4][2], const Unit& u, int wr, int wc, int fr, int fq) const {
        const bool isv = u.pn >= 4; float* of = isv ? outv : outk; bf16_t* ob = isv ? mv : mk;
        const int cn = (u.pn & 3) * 256 + wc * 32 + 8 * fq;
#pragma unroll
        for (int ai = 0; ai < 2; ++ai)
#pragma unroll
            for (int m = 0; m < 4; ++m) { const int row = u.pm * 256 + ai * 128 + wr * 64 + m * 16 + fr; const float rs = rsm[row];
#pragma unroll
                for (int bj = 0; bj < 2; ++bj) { const size_t off = (size_t)row * D + cn + bj * 128;
                    const f32x4 v0 = acc[ai][bj][m][0] * rs, v1 = acc[ai][bj][m][1] * rs;
                    *(f32x4*)(of + off) = v0; *(f32x4*)(of + off + 4) = v1;
                    u32x4 w; w.x = pk_bf16(v0[0], v0[1]); w.y = pk_bf16(v0[2], v0[3]); w.z = pk_bf16(v1[0], v1[1]); w.w = pk_bf16(v1[2], v1[3]);
                    *(u32x4*)(ob + off) = w; } }
    }
};
__device__ __forceinline__ u32x4 pk8(const f32x4& a, const f32x4& b) { u32x4 w; w.x = pk_bf16(a[0], a[1]); w.y = pk_bf16(a[2], a[3]); w.z = pk_bf16(b[0], b[1]); w.w = pk_bf16(b[2], b[3]); return w; }
__device__ __forceinline__ f32x4 silu4(const f32x4& v) { return (f32x4){silu_f(v[0]), silu_f(v[1]), silu_f(v[2]), silu_f(v[3])}; }
__device__ __forceinline__ float row_rs(const float* st, int row) {
    const f32x4* p = (const f32x4*)(st + (size_t)row * 16); const f32x4 a = p[0], b = p[1], c = p[2], d = p[3];
    const float s = ((a[0] + a[1]) + (a[2] + a[3])) + ((b[0] + b[1]) + (b[2] + b[3])) + ((c[0] + c[1]) + (c[2] + c[3])) + ((d[0] + d[1]) + (d[2] + d[3]));
    return rsqrtf(s * (1.f / D) + EPS);
}
__device__ __forceinline__ float scan16(float x) {
    x += __builtin_bit_cast(float, __builtin_amdgcn_update_dpp(0, __builtin_bit_cast(int, x), 0x111, 0xf, 0xf, true));
    x += __builtin_bit_cast(float, __builtin_amdgcn_update_dpp(0, __builtin_bit_cast(int, x), 0x112, 0xf, 0xf, true));
    x += __builtin_bit_cast(float, __builtin_amdgcn_update_dpp(0, __builtin_bit_cast(int, x), 0x114, 0xf, 0xf, true));
    x += __builtin_bit_cast(float, __builtin_amdgcn_update_dpp(0, __builtin_bit_cast(int, x), 0x118, 0xf, 0xf, true));
    return x;
}
struct EpiInProj {
    static constexpr bool PERM = true, AFTER_DRAIN = false;
    const float* rs0; const float* cs; const float* low; const float* rgain; const float* hgain; bf16_t* pb; float* lf;
    __device__ __forceinline__ void operator()(const f32x4 (&acc)[2][2][4][2], const Unit& u, int wr, int wc, int fr, int fq) const {
        const int kind = u.pn >> 1; const int colt = u.pn * 256 + wc * 32 + 8 * fq;
        f32x4 carry[2][2];
#pragma unroll
        for (int x = 0; x < 2; ++x) { carry[x][0] = (f32x4){0.f, 0.f, 0.f, 0.f}; carry[x][1] = (f32x4){0.f, 0.f, 0.f, 0.f}; }
#pragma unroll
        for (int ai = 0; ai < 2; ++ai)
#pragma unroll
            for (int m = 0; m < 4; ++m) {
                const int row = u.pm * 256 + ai * 128 + wr * 64 + m * 16 + fr; const float rs = rs0[row];
                const bool samp = row >= MP; const int t = row & (T - 1); const int pidx = samp ? T + ((row - MP) & 3) : t;
#pragma unroll
                for (int bj = 0; bj < 2; ++bj) {
                    const int c0 = colt + bj * 128;
                    f32x4 v0 = acc[ai][bj][m][0] * rs, v1 = acc[ai][bj][m][1] * rs;
                    if (kind <= 1) {
                        const int h = (c0 & 511) >> 7, i0 = (c0 & 127) >> 1;
                        const f32x4* tp = (const f32x4*)(cs + ((size_t)pidx * 64 + i0) * 2); const f32x4 t0 = tp[0], t1 = tp[1];
                        const float lg = __log2f(1.f - exp2f(-5.f - (float)h)); const float e = (float)((t & 31) + 1);
                        float sc = kind == 0 ? 1.f : 0.08838834764831845f;
                        if (!samp) sc *= exp2f(kind == 0 ? e * lg : -e * lg);
                        f32x4 o0, o1;
                        o0[0] = (v0[0] * t0[0] - v0[1] * t0[1]) * sc; o0[1] = (v0[0] * t0[1] + v0[1] * t0[0]) * sc;
                        o0[2] = (v0[2] * t0[2] - v0[3] * t0[3]) * sc; o0[3] = (v0[2] * t0[3] + v0[3] * t0[2]) * sc;
                        o1[0] = (v1[0] * t1[0] - v1[1] * t1[1]) * sc; o1[1] = (v1[0] * t1[1] + v1[1] * t1[0]) * sc;
                        o1[2] = (v1[2] * t1[2] - v1[3] * t1[3]) * sc; o1[3] = (v1[2] * t1[3] + v1[3] * t1[2]) * sc;
                        *(u32x4*)(pb + (size_t)row * PBW + c0) = pk8(o0, o1);
                    } else if (kind == 2) {
                        *(u32x4*)(pb + (size_t)row * PBW + c0) = pk8(v0, v1);
                    } else if (kind == 3) {
                        const f32x4* gp = (const f32x4*)(rgain + (c0 - 1536));
                        *(u32x4*)(pb + (size_t)row * PBW + c0) = pk8(silu4(v0) * gp[0], silu4(v1) * gp[1]);
                    } else if (kind == 4) {
                        *(u32x4*)(pb + (size_t)row * PBW + c0) = pk8(silu4(v0), silu4(v1));
                    } else if (kind == 5) {
                        const f32x4* lp = (const f32x4*)(low + (c0 - 2560)); const f32x4 l0 = lp[0], l1 = lp[1];
                        f32x4 o0, o1, k0, k1;
#pragma unroll
                        for (int e = 0; e < 4; ++e) { const float s0 = sigmoid_f(v0[e]), s1 = sigmoid_f(v1[e]);
                            o0[e] = __logf(l0[e] + (1.f - l0[e]) * s0); o1[e] = __logf(l1[e] + (1.f - l1[e]) * s1);
                            k0[e] = (1.f - l0[e]) * (1.f - s0); k1[e] = (1.f - l1[e]) * (1.f - s1); }
                        *(u32x4*)(pb + (size_t)row * PBW + 3584 + (c0 - 2560)) = pk8(k0, k1);
                        if (!samp) {
#pragma unroll
                            for (int e = 0; e < 4; ++e) { o0[e] = scan16(o0[e]); o1[e] = scan16(o1[e]); }
                            if (m & 1) { o0 = o0 + carry[bj][0]; o1 = o1 + carry[bj][1]; }
                            else {
#pragma unroll
                                for (int e = 0; e < 4; ++e) { carry[bj][0][e] = __shfl(o0[e], (fq << 4) | 15); carry[bj][1][e] = __shfl(o1[e], (fq << 4) | 15); } }
                        }
                        float* lp2 = lf + (size_t)row * 512 + (c0 - 2560);
                        *(f32x4*)lp2 = o0; *(f32x4*)(lp2 + 4) = o1;
                    } else if (kind == 6) {
                        *(u32x4*)(pb + (size_t)row * PBW + c0 - 512) = pk8(v0, v1);
                    } else {
                        const f32x4* gp = (const f32x4*)(hgain + (c0 - 3584));
                        *(u32x4*)(pb + (size_t)row * PBW + c0 - 512) = pk8(silu4(v0) * gp[0], silu4(v1) * gp[1]);
                    }
                }
            }
    }
};
struct EpiResid {
    static constexpr bool PERM = true, AFTER_DRAIN = false;
    const float* xold_p; const float* xold_s; float* y; bf16_t* xb; float* st;
    __device__ __forceinline__ void operator()(const f32x4 (&acc)[2][2][4][2], const Unit& u, int wr, int wc, int fr, int fq) const {
        const int cn = u.pn * 256 + wc * 32 + 8 * fq;
#pragma unroll
        for (int ai = 0; ai < 2; ++ai)
#pragma unroll
            for (int m = 0; m < 4; ++m) {
                const int row = u.pm * 256 + ai * 128 + wr * 64 + m * 16 + fr;
                const float* xo = row < MP ? xold_p + (size_t)row * D : xold_s + (size_t)(row - MP) * D;
                float ss = 0.f;
#pragma unroll
                for (int bj = 0; bj < 2; ++bj) { const int c = cn + bj * 128;
                    const f32x4 v0 = *(const f32x4*)(xo + c) + acc[ai][bj][m][0], v1 = *(const f32x4*)(xo + c + 4) + acc[ai][bj][m][1];
                    ss += (v0[0] * v0[0] + v0[1] * v0[1]) + (v0[2] * v0[2] + v0[3] * v0[3]) + (v1[0] * v1[0] + v1[1] * v1[1]) + (v1[2] * v1[2] + v1[3] * v1[3]);
                    *(f32x4*)(y + (size_t)row * D + c) = v0; *(f32x4*)(y + (size_t)row * D + c + 4) = v1;
                    *(u32x4*)(xb + (size_t)row * D + c) = pk8(v0, v1); }
                ss += __shfl_xor(ss, 16); ss += __shfl_xor(ss, 32);
                if (fq == 0) st[(size_t)row * 16 + u.pn * 4 + wc] = ss;
            }
    }
};
struct EpiScaleBf16 {
    static constexpr bool PERM = true, AFTER_DRAIN = false;
    const float* st; bf16_t* o; float scale;
    __device__ __forceinline__ void operator()(const f32x4 (&acc)[2][2][4][2], const Unit& u, int wr, int wc, int fr, int fq) const {
        const int cn = u.pn * 256 + wc * 32 + 8 * fq;
#pragma unroll
        for (int ai = 0; ai < 2; ++ai)
#pragma unroll
            for (int m = 0; m < 4; ++m) { const int row = u.pm * 256 + ai * 128 + wr * 64 + m * 16 + fr; const float rs = row_rs(st, row) * scale;
#pragma unroll
                for (int bj = 0; bj < 2; ++bj) *(u32x4*)(o + (size_t)row * D + cn + bj * 128) = pk8(acc[ai][bj][m][0] * rs, acc[ai][bj][m][1] * rs); }
    }
};
struct EpiGateUp {
    static constexpr bool PERM = true, AFTER_DRAIN = false;
    const float* st; bf16_t* act;
    __device__ __forceinline__ void operator()(const f32x4 (&acc)[2][2][4][2], const Unit& u, int wr, int wc, int fr, int fq) const {
        const int jn = u.pn * 128 + wc * 16 + 4 * fq;
#pragma unroll
        for (int ai = 0; ai < 2; ++ai)
#pragma unroll
            for (int m = 0; m < 4; ++m) { const int row = u.pm * 256 + ai * 128 + wr * 64 + m * 16 + fr; const float rs = row_rs(st, row);
#pragma unroll
                for (int bj = 0; bj < 2; ++bj) { const f32x4 g = silu4(acc[ai][bj][m][0] * rs), up = acc[ai][bj][m][1] * rs; const f32x4 a = g * up;
                    unsigned long long w = (unsigned long long)pk_bf16(a[0], a[1]) | ((unsigned long long)pk_bf16(a[2], a[3]) << 32);
                    *(unsigned long long*)(act + (size_t)row * DFF + jn + bj * 64) = w; } }
    }
};
__device__ __forceinline__ void phase_final(Frame& F, const Args& a) {
    const int gw = F.vcu * NWAVES + F.wave, NGW = F.G * NWAVES, lane = lane_id();
    const float* st = (const float*)(a.ws + WS_ST3); const GAS f32x4* g4 = (const GAS f32x4*)a.in[I_GFINAL] + lane;
    for (int m = gw; m < MT; m += NGW) { const float rs = row_rs(st, m); GAS f32x4* yr = (GAS f32x4*)(a.out + O_Y + (size_t)m * D) + lane;
        const GAS f32x4* xr = (const GAS f32x4*)((const float*)(a.ws + WS_Y3) + (size_t)m * D) + lane;
#pragma unroll
        for (int j = 0; j < 4; ++j) yr[64 * j] = xr[64 * j] * rs * g4[64 * j]; }
}
typedef short bf16x8v __attribute__((ext_vector_type(8)));
typedef short s16x4v __attribute__((ext_vector_type(4)));
typedef float f32x16v __attribute__((ext_vector_type(16)));
constexpr int RC_RS = 272;
constexpr int RC_TILE = 32 * RC_RS, RC_BUF = 3 * RC_TILE;
constexpr int RC_ORS = 528, RC_OSZ = 32 * RC_ORS;
constexpr int RC_OOFF = 2 * RC_BUF, RC_EOFF = RC_OOFF + 2 * RC_OSZ, RC_END = RC_EOFF + 2 * 512;
static_assert(RC_END <= RING_BYTES, "recurrence LDS");
__device__ __forceinline__ int crow(int r, int h) { return (r & 3) + 8 * (r >> 2) + 4 * h; }
__device__ __forceinline__ s16x4v tr16(const LAS unsigned char* p) { typedef short v4i16_t __attribute__((ext_vector_type(4))); return __builtin_bit_cast(s16x4v, __builtin_amdgcn_ds_read_tr16_b64_v4i16((LAS v4i16_t*)p)); }
__device__ __forceinline__ bf16x8v cat8(s16x4v lo, s16x4v hi) { return (bf16x8v){lo[0], lo[1], lo[2], lo[3], hi[0], hi[1], hi[2], hi[3]}; }
__device__ __forceinline__ bf16x8v pack_step(const f32x16v& x, int s) {
    u32x4 p; p.x = pk_bf16(x[8 * s], x[8 * s + 1]); p.y = pk_bf16(x[8 * s + 2], x[8 * s + 3]); p.z = pk_bf16(x[8 * s + 4], x[8 * s + 5]); p.w = pk_bf16(x[8 * s + 6], x[8 * s + 7]);
    return __builtin_bit_cast(bf16x8v, p);
}
#define MFMA32(a, b, c) __builtin_amdgcn_mfma_f32_32x32x16_bf16((a), (b), (c), 0, 0, 0)

#define RC_LDS_BARRIER() do { asm volatile("s_waitcnt lgkmcnt(0)" ::: "memory"); __builtin_amdgcn_s_barrier(); asm volatile("" ::: "memory"); } while (0)
__device__ __forceinline__ void rec_prompt_unit(Frame& F, const Args& a, int unit) {
    const int kind = unit >> 5, b = (unit >> 2) & 7, h = unit & 3;
    unsigned char* ws = a.ws;
    const bf16_t* pb = (const bf16_t*)(ws + WS_PB); const float* lf = (const float*)(ws + WS_LF); bf16_t* ob = (bf16_t*)(ws + WS_OB);
    LAS unsigned char* L = F.lds + RING_OFF;
    const int lane = lane_id(), r32 = lane & 31, hh = lane >> 5, g = (lane >> 4) & 1, q4 = (lane & 15) >> 2, p4 = lane & 3;
    const int row_base = b * T;
    const int qcol = kind == 0 ? h * 128 : 2048 + h * 128, kcol = 512 + h * 128, vcol = kind == 0 ? 1024 + h * 128 : 2560 + h * 128, gcol = kind == 0 ? 1536 + h * 128 : 3072 + h * 128;
    const float Eret = exp2f(32.f * __log2f(1.f - exp2f(-5.f - (float)h)));
    const int pt = F.wave * 64 + lane - 256;

    u32x4 pre[6]; f32x4 preb[4]; u32x4 gpre[2];
    const int prow = pt >> 4, pch = pt & 15;
    const bf16_t* pbase = pb + (size_t)(row_base + prow) * PBW + pch * 8;
    const float* lbase = lf + (size_t)(row_base + prow) * 512 + h * 128 + pch * 8;
    const int lofs = prow * RC_RS + pch * 16;
    auto stage_load = [&](int c) {
        const bf16_t* p = pbase + (size_t)32 * c * PBW; asm volatile("" : "+v"(p));
        if (kind == 0) {
#pragma unroll
            for (int j = 0; j < 2; ++j) { pre[j] = *(const u32x4*)(p + (size_t)16 * j * PBW + qcol); pre[2 + j] = *(const u32x4*)(p + (size_t)16 * j * PBW + kcol); pre[4 + j] = *(const u32x4*)(p + (size_t)16 * j * PBW + vcol); }
        } else {
            const float* lp = lbase + (size_t)32 * c * 512; asm volatile("" : "+v"(lp));
#pragma unroll
            for (int j = 0; j < 2; ++j) { pre[j] = *(const u32x4*)(p + (size_t)16 * j * PBW + qcol); pre[2 + j] = *(const u32x4*)(p + (size_t)16 * j * PBW + 3584 + h * 128); pre[4 + j] = *(const u32x4*)(p + (size_t)16 * j * PBW + vcol);
                preb[2 * j] = *(const f32x4*)(lp + (size_t)16 * j * 512); preb[2 * j + 1] = *(const f32x4*)(lp + (size_t)16 * j * 512 + 4); }
        }
    };
    auto stage_write = [&](int c) {
        LAS unsigned char* B = L + (c & 1) * RC_BUF + lofs; asm volatile("" : "+v"(B));
        if (kind == 0) {
#pragma unroll
            for (int j = 0; j < 2; ++j) { *(LAS u32x4*)(B + 16 * j * RC_RS) = pre[j]; *(LAS u32x4*)(B + RC_TILE + 16 * j * RC_RS) = pre[2 + j]; *(LAS u32x4*)(B + 2 * RC_TILE + 16 * j * RC_RS) = pre[4 + j]; }
        } else {
#pragma unroll
            for (int j = 0; j < 2; ++j) {
                u32x4 qo, ko; f32x4 eb[2];
#pragma unroll
                for (int x = 0; x < 2; ++x)
#pragma unroll
                    for (int e = 0; e < 4; ++e) eb[x][e] = exp2f(preb[2 * j + x][e] * 1.4426950408889634f);
#pragma unroll
                for (int e = 0; e < 4; ++e) { const unsigned qw = pre[j][e], kw = pre[2 + j][e];
                    const float e0 = eb[e >> 1][2 * (e & 1)], e1 = eb[e >> 1][2 * (e & 1) + 1];
                    qo[e] = pk_bf16(__uint_as_float(qw << 16) * e0, __uint_as_float(qw & 0xffff0000u) * e1);
                    ko[e] = pk_bf16(__uint_as_float(kw << 16) * __builtin_amdgcn_rcpf(e0), __uint_as_float(kw & 0xffff0000u) * __builtin_amdgcn_rcpf(e1)); }
                *(LAS u32x4*)(B + 16 * j * RC_RS) = qo; *(LAS u32x4*)(B + RC_TILE + 16 * j * RC_RS) = ko; *(LAS u32x4*)(B + 2 * RC_TILE + 16 * j * RC_RS) = pre[4 + j];
                if (j == 1 && prow == 15) { LAS float* Ep = (LAS float*)(L + RC_EOFF + (c & 1) * 512) + pch * 8; *(LAS f32x4*)Ep = eb[0]; *(LAS f32x4*)(Ep + 4) = eb[1]; }
            }
        }
    };
    const int et = pt >> 3, ecg = pt & 7;
    auto gate_load = [&](int c) { const u32x4* gp = (const u32x4*)(pb + (size_t)(row_base + 32 * c + et) * PBW + gcol + ecg * 16); gpre[0] = gp[0]; gpre[1] = gp[1]; };
    auto epilogue = [&](int c) {
        const int row = row_base + 32 * c + et;
        const LAS f32x4* op = (const LAS f32x4*)(L + RC_OOFF + (c & 1) * RC_OSZ + et * RC_ORS + ecg * 64);
        f32x4 o[4]; float ss = 0.f;
#pragma unroll
        for (int j = 0; j < 4; ++j) { o[j] = op[j]; ss += (o[j][0] * o[j][0] + o[j][1] * o[j][1]) + (o[j][2] * o[j][2] + o[j][3] * o[j][3]); }
        ss += __shfl_xor(ss, 1); ss += __shfl_xor(ss, 2); ss += __shfl_xor(ss, 4);
        const float rs = rsqrtf(ss * (1.f / 128.f) + EPS);
        u32x4* dp = (u32x4*)(ob + (size_t)row * D + kind * 512 + h * 128 + ecg * 16);
#pragma unroll
        for (int j = 0; j < 2; ++j) { const u32x4 gw = gpre[j]; u32x4 w;
#pragma unroll
            for (int e = 0; e < 4; ++e) { const float g0 = __uint_as_float(gw[e] << 16), g1 = __uint_as_float(gw[e] & 0xffff0000u);
                const float o0 = o[2 * j + (e >> 1)][2 * (e & 1)], o1 = o[2 * j + (e >> 1)][2 * (e & 1) + 1];
                w[e] = pk_bf16(o0 * rs * g0, o1 * rs * g1); }
            dp[j] = w; }
    };

    if (F.wave >= 4) {
        stage_load(0); stage_write(0); stage_load(1);
        RC_LDS_BARRIER();
        for (int c = 0; c < T / 32; ++c) {
            if (c + 1 < T / 32) { stage_write(c + 1); if (c + 2 < T / 32) stage_load(c + 2); }
            if (c >= 1) epilogue(c - 1);
            gate_load(c);
            RC_LDS_BARRIER();
        }
        epilogue(T / 32 - 1);
    } else {
        f32x16v S[4];
#pragma unroll
        for (int dt = 0; dt < 4; ++dt)
#pragma unroll
            for (int i = 0; i < 16; ++i) S[dt][i] = 0.f;
        RC_LDS_BARRIER();
        for (int c = 0; c < T / 32; ++c) {
        const int w = F.wave;
        const LAS unsigned char* B = L + (c & 1) * RC_BUF;
        const LAS unsigned char* QE = B; const LAS unsigned char* KE = B + RC_TILE; const LAS unsigned char* V = B + 2 * RC_TILE;
        f32x16v X;
#pragma unroll
        for (int i = 0; i < 16; ++i) X[i] = 0.f;
#pragma unroll
        for (int kk = 0; kk < 8; ++kk) { const bf16x8v ka = *(const LAS bf16x8v*)(KE + r32 * RC_RS + kk * 32 + hh * 16), qb = *(const LAS bf16x8v*)(QE + r32 * RC_RS + kk * 32 + hh * 16);
            X = MFMA32(ka, qb, X); }
#pragma unroll
        for (int i = 0; i < 16; ++i) if (crow(i, hh) > r32) X[i] = 0.f;
        bf16x8v vf[2];
#pragma unroll
        for (int kk = 0; kk < 2; ++kk) { const LAS unsigned char* vp = V + (16 * kk + 4 * hh + q4) * RC_RS + (32 * w + 16 * g + 4 * p4) * 2; vf[kk] = cat8(tr16(vp), tr16(vp + 8 * RC_RS)); }
        f32x16v o;
#pragma unroll
        for (int i = 0; i < 16; ++i) o[i] = 0.f;
#pragma unroll
        for (int kk = 0; kk < 2; ++kk) o = MFMA32(pack_step(X, kk), vf[kk], o);
#pragma unroll
        for (int dt = 0; dt < 4; ++dt)
#pragma unroll
            for (int kk = 0; kk < 2; ++kk) { const LAS unsigned char* qp = QE + r32 * RC_RS + (32 * dt + 16 * kk + 4 * hh) * 2;
                const bf16x8v qa = cat8(*(const LAS s16x4v*)qp, *(const LAS s16x4v*)(qp + 16));
                o = MFMA32(qa, pack_step(S[dt], kk), o); }
        { LAS unsigned char* OB = L + RC_OOFF + (c & 1) * RC_OSZ;
#pragma unroll
          for (int i = 0; i < 16; ++i) *(LAS float*)(OB + crow(i, hh) * RC_ORS + (32 * w + r32) * 4) = o[i]; }
#pragma unroll
        for (int dt = 0; dt < 4; ++dt)
#pragma unroll
            for (int kk = 0; kk < 2; ++kk) { const LAS unsigned char* kp = KE + (16 * kk + 4 * hh + q4) * RC_RS + (32 * dt + 16 * g + 4 * p4) * 2;
                S[dt] = MFMA32(cat8(tr16(kp), tr16(kp + 8 * RC_RS)), vf[kk], S[dt]); }
        if (kind == 0) {
#pragma unroll
            for (int dt = 0; dt < 4; ++dt) S[dt] = S[dt] * Eret;
        } else {
            const LAS unsigned char* EB = L + RC_EOFF + (c & 1) * 512;
#pragma unroll
            for (int dt = 0; dt < 4; ++dt)
#pragma unroll
                for (int gq = 0; gq < 4; ++gq) { const f32x4 e4 = *(const LAS f32x4*)(EB + (32 * dt + 8 * gq + 4 * hh) * 4);
#pragma unroll
                    for (int e = 0; e < 4; ++e) S[dt][4 * gq + e] *= e4[e]; }
        }
            RC_LDS_BARRIER();
        }
        const int w = F.wave; float* so = a.out + (kind == 0 ? O_RETP : O_HGP) + (size_t)(b * 4 + h) * 16384;
#pragma unroll
        for (int dt = 0; dt < 4; ++dt)
#pragma unroll
            for (int i = 0; i < 16; ++i) { const int dp = 32 * dt + crow(i, hh); const int dor = kind == 0 ? ((dp & 1) ? 64 + (dp >> 1) : (dp >> 1)) : dp;
                so[(size_t)dor * 128 + 32 * w + r32] = S[dt][i]; }
    }
    __syncthreads();
}
constexpr int SR_DQK = 0, SR_OPART = 8192, SR_RED = SR_OPART + 16384, SR_END = SR_RED + 64;
__device__ __forceinline__ void rec_sample_item(Frame& F, const Args& a, int item) {
    const int kind = item >> 9, bh = item & 511, b = bh >> 2, h = bh & 3;
    unsigned char* ws = a.ws;
    const bf16_t* pb = (const bf16_t*)(ws + WS_PB); const float* lf = (const float*)(ws + WS_LF); bf16_t* ob = (bf16_t*)(ws + WS_OB);
    LAS unsigned char* L = F.lds + RING_OFF;
    LAS float* DEC = (LAS float*)(L + SR_DQK); LAS float* KK = DEC + 512; LAS float* QQ = KK + 512;
    const int lane = lane_id(), w = F.wave, rp = lane >> 5, e4 = (lane & 31) * 4, tid_ = w * 64 + lane;
    const int vcol = kind == 0 ? 1024 + h * 128 : 2560 + h * 128, gcol = kind == 0 ? 1536 + h * 128 : 3072 + h * 128;
    const float* s0 = a.in[kind == 0 ? I_SRET : I_SHG] + (size_t)bh * 16384;
    float* so = a.out + (kind == 0 ? O_RETS : O_HGS) + (size_t)bh * 16384;
    f32x4 S[8];
#pragma unroll
    for (int i = 0; i < 8; ++i) S[i] = *(const f32x4*)(s0 + (size_t)(16 * w + 2 * i + rp) * 128 + e4);
    const int tt = tid_ >> 7, d = tid_ & 127; const size_t rowt = (size_t)MP + b * 4 + tt;
    {
        float dec, k, q;
        if (kind == 0) { const int dp = d < 64 ? 2 * d : 2 * (d - 64) + 1; q = bf2f(pb[rowt * PBW + h * 128 + dp]); k = bf2f(pb[rowt * PBW + 512 + h * 128 + dp]); dec = 1.f - exp2f(-5.f - (float)h); }
        else { const float f = __expf(lf[rowt * 512 + h * 128 + d]); dec = f; k = 1.f - f; q = bf2f(pb[rowt * PBW + 2048 + h * 128 + d]); }
        DEC[tt * 128 + d] = dec; KK[tt * 128 + d] = k; QQ[tt * 128 + d] = q;
    }
    f32x4 v4[4];
#pragma unroll
    for (int t = 0; t < 4; ++t) { const unsigned long long u = *(const unsigned long long*)(pb + ((size_t)MP + b * 4 + t) * PBW + vcol + e4);
        v4[t] = (f32x4){__uint_as_float((unsigned)u << 16), __uint_as_float((unsigned)u & 0xffff0000u), __uint_as_float((unsigned)(u >> 32) << 16), __uint_as_float((unsigned)(u >> 32) & 0xffff0000u)}; }
    __syncthreads();
#pragma unroll
    for (int t = 0; t < 4; ++t) {
        f32x4 o = {0.f, 0.f, 0.f, 0.f};
#pragma unroll
        for (int i = 0; i < 8; ++i) { const int dd = t * 128 + 16 * w + 2 * i + rp; const float dec = DEC[dd], k = KK[dd], q = QQ[dd];
            S[i] = S[i] * dec + v4[t] * k; o += S[i] * q; }
#pragma unroll
        for (int e = 0; e < 4; ++e) o[e] += __shfl_xor(o[e], 32);
        if (rp == 0) *(LAS f32x4*)(L + SR_OPART + ((w * 4 + t) * 128 + e4) * 4) = o;
    }
#pragma unroll
    for (int i = 0; i < 8; ++i) *(f32x4*)(so + (size_t)(16 * w + 2 * i + rp) * 128 + e4) = S[i];
    __syncthreads();
    {
        const int e = d; float o = 0.f;
#pragma unroll
        for (int ww = 0; ww < 8; ++ww) o += *(const LAS float*)(L + SR_OPART + ((ww * 4 + tt) * 128 + e) * 4);
        float ss = wave_sum(o * o);
        LAS float* RED = (LAS float*)(L + SR_RED);
        if (lane == 0) RED[w] = ss;
        __syncthreads();
        ss = RED[w & ~1] + RED[w | 1];
        const float rs = rsqrtf(ss * (1.f / 128.f) + EPS);
        const float val = o * rs * bf2f(pb[rowt * PBW + gcol + e]);
        const float other = __shfl_xor(val, 1);
        if ((e & 1) == 0) *(unsigned*)(ob + rowt * D + kind * 512 + h * 128 + e) = pk_bf16(val, other);
    }
    __syncthreads();
}
constexpr int AT_KRS = 528, AT_VRS = 272, AT_STAGE = 69632, AT_SCR = 2 * AT_STAGE, AT_END = AT_SCR + 1024;
static_assert(128 * AT_KRS <= AT_STAGE && 256 * AT_VRS <= AT_STAGE && AT_END <= RING_BYTES, "attention LDS");
template <int N> struct IC { static constexpr int value = N; };

__device__ __forceinline__ void attn_prompt_unit(Frame& F, const Args& a, int unit) {
    const int b = unit >> 5, head = (unit >> 3) & 3, qb = unit & 7;
    unsigned char* ws = a.ws;
    const bf16_t* Q = (const bf16_t*)(ws + WS_Q); const bf16_t* MK = (const bf16_t*)(ws + WS_MK); const bf16_t* MV = (const bf16_t*)(ws + WS_MV); bf16_t* O = (bf16_t*)(ws + WS_OB);
    LAS unsigned char* L = F.lds + RING_OFF;
    const int lane = lane_id(), w = F.wave, r32 = lane & 31, hh = lane >> 5, g = (lane >> 4) & 1, q4 = (lane & 15) >> 2, p4 = lane & 3, tid = w * 64 + lane;
    const int qrow0 = b * T + qb * 256 + w * 32;
    const bf16_t* qp = Q + (size_t)(qrow0 + r32) * D + head * XHD + 8 * hh;
    u32x4 ld[8];
    const bf16_t* kg = MK + (size_t)(b * NMEM + (tid >> 5)) * D + head * XHD + (tid & 31) * 8;
    const bf16_t* vg = MV + (size_t)(b * NMEM + (tid >> 4)) * D + head * XHD + (tid & 15) * 8;
    const int kl = (tid >> 5) * AT_KRS + (tid & 31) * 16, vl = (tid >> 4) * AT_VRS + (tid & 15) * 16;
    auto load_k = [&](int kh) { const bf16_t* p = kg + (size_t)kh * 128 * D; asm volatile("" : "+v"(p));
#pragma unroll
        for (int j = 0; j < 8; ++j) ld[j] = *(const u32x4*)(p + (size_t)j * 16 * D); };
    auto write_k = [&](int buf) { LAS unsigned char* p = L + buf * AT_STAGE + kl; asm volatile("" : "+v"(p));
#pragma unroll
        for (int j = 0; j < 8; ++j) *(LAS u32x4*)(p + j * 16 * AT_KRS) = ld[j]; };
    auto load_v = [&](int eh) { const bf16_t* p = vg + eh * 128; asm volatile("" : "+v"(p));
#pragma unroll
        for (int j = 0; j < 8; ++j) ld[j] = *(const u32x4*)(p + (size_t)j * 32 * D); };
    auto write_v = [&](int buf) { LAS unsigned char* p = L + buf * AT_STAGE + vl; asm volatile("" : "+v"(p));
#pragma unroll
        for (int j = 0; j < 8; ++j) *(LAS u32x4*)(p + j * 32 * AT_VRS) = ld[j]; };
    f32x16v Sc[8];
#pragma unroll
    for (int m = 0; m < 8; ++m)
#pragma unroll
        for (int i = 0; i < 16; ++i) Sc[m][i] = 0.f;
    auto pass1 = [&](auto KH, int buf) {
        constexpr int kh = decltype(KH)::value;
        const LAS unsigned char* B = L + buf * AT_STAGE + r32 * AT_KRS + 16 * hh;
#pragma unroll
        for (int kb = 0; kb < 4; ++kb) {
            bf16x8v qf[4];
#pragma unroll
            for (int k8 = 0; k8 < 4; ++k8) qf[k8] = *(const bf16x8v*)(qp + 16 * (4 * kb + k8));
#pragma unroll
            for (int k8 = 0; k8 < 4; ++k8)
#pragma unroll
                for (int mt = 0; mt < 4; ++mt) { const bf16x8v kf = *(const LAS bf16x8v*)(B + 32 * mt * AT_KRS + 32 * (4 * kb + k8));
                    Sc[4 * kh + mt] = MFMA32(kf, qf[k8], Sc[4 * kh + mt]); }
        }
    };
    load_k(0); write_k(0); __syncthreads();
    load_k(1); pass1(IC<0>{}, 0); write_k(1); __syncthreads();
    pass1(IC<1>{}, 1);
    load_v(0);
    float mx = Sc[0][0];
#pragma unroll
    for (int m = 0; m < 8; ++m)
#pragma unroll
        for (int i = 0; i < 16; ++i) mx = fmaxf(mx, Sc[m][i]);
    mx = fmaxf(mx, __shfl_xor(mx, 32));
    const float ml = mx * 1.4426950408889634f; float sum = 0.f;
    bf16x8v Pp[8][2];
#pragma unroll
    for (int m = 0; m < 8; ++m) {
#pragma unroll
        for (int i = 0; i < 16; ++i) { const float p = exp2f(Sc[m][i] * 1.4426950408889634f - ml); Sc[m][i] = p; sum += p; }
        Pp[m][0] = pack_step(Sc[m], 0); Pp[m][1] = pack_step(Sc[m], 1);
        asm volatile("" : "+v"(Pp[m][0]), "+v"(Pp[m][1]));
    }
    sum += __shfl_xor(sum, 32);
    LAS float* scr = (LAS float*)(L + AT_SCR) + w * 32;
    if (hh == 0) scr[r32] = 1.f / sum;
    write_v(0); __syncthreads();
    auto pass2 = [&](int eh, int buf) {
        f32x16v Oa[4];
#pragma unroll
        for (int et = 0; et < 4; ++et)
#pragma unroll
            for (int i = 0; i < 16; ++i) Oa[et][i] = 0.f;
        const LAS unsigned char* B = L + buf * AT_STAGE + (4 * hh + q4) * AT_VRS + (16 * g + 4 * p4) * 2;
#pragma unroll
        for (int mt = 0; mt < 8; ++mt)
#pragma unroll
            for (int kk = 0; kk < 2; ++kk)
#pragma unroll
                for (int et = 0; et < 4; ++et) { const LAS unsigned char* vp = B + (32 * mt + 16 * kk) * AT_VRS + 64 * et;
                    Oa[et] = MFMA32(Pp[mt][kk], cat8(tr16(vp), tr16(vp + 8 * AT_VRS)), Oa[et]); }
        f32x4 inv[4];
#pragma unroll
        for (int gq = 0; gq < 4; ++gq) inv[gq] = *(const LAS f32x4*)(scr + 8 * gq + 4 * hh);
#pragma unroll
        for (int et = 0; et < 4; ++et)
#pragma unroll
            for (int i = 0; i < 16; ++i) { const float val = Oa[et][i] * inv[i >> 2][i & 3]; const float other = __shfl_xor(val, 1);
                if (((lane ^ i) & 1) == 0) { const int row = qrow0 + crow(i, hh), col = head * XHD + 128 * eh + 32 * et + (r32 & ~1);
                    *(unsigned*)(O + (size_t)row * D + col) = (lane & 1) ? pk_bf16(other, val) : pk_bf16(val, other); } }
    };
    load_v(1); pass2(0, 0); write_v(1); __syncthreads();
    pass2(1, 1);
    __syncthreads();
}

constexpr int AS_SC = 0, AS_PL = 4096, AS_OPART = 8192, AS_END = AS_OPART + 32768;
__device__ __forceinline__ f32x4 bf4_to_f32(unsigned long long u) {
    return (f32x4){__uint_as_float((unsigned)u << 16), __uint_as_float((unsigned)u & 0xffff0000u), __uint_as_float((unsigned)(u >> 32) << 16), __uint_as_float((unsigned)(u >> 32) & 0xffff0000u)};
}
__device__ __forceinline__ void attn_sample_item(Frame& F, const Args& a, int item) {
    const int b = item >> 2, head = item & 3;
    unsigned char* ws = a.ws;
    const bf16_t* Q = (const bf16_t*)(ws + WS_Q); bf16_t* O = (bf16_t*)(ws + WS_OB);
    const float* Kf = a.in[I_CK] + ((size_t)b * NMEM * XH + head) * XHD; const float* Vf = a.in[I_CV] + ((size_t)b * NMEM * XH + head) * XHD;
    LAS unsigned char* L = F.lds + RING_OFF;
    const int lane = lane_id(), w = F.wave, tid = w * 64 + lane;
    f32x4 q4v[4];
#pragma unroll
    for (int t = 0; t < 4; ++t) q4v[t] = bf4_to_f32(*(const unsigned long long*)(Q + ((size_t)MP + 4 * b + t) * D + head * XHD + 4 * lane));
    float r64[64], r32v[32], r16[16], r8[8], r4[4], r2[2];
#pragma unroll
    for (int pr = 0; pr < 2; ++pr) {
        float pa[32], pbv[32];
#pragma unroll
        for (int half = 0; half < 2; ++half) {
            f32x4 k4[8];
#pragma unroll
            for (int jj = 0; jj < 8; ++jj) k4[jj] = *(const f32x4*)(Kf + (size_t)(32 * w + 16 * half + 8 * pr + jj) * (XH * XHD) + 4 * lane);
#pragma unroll
            for (int jj = 0; jj < 8; ++jj)
#pragma unroll
                for (int t = 0; t < 4; ++t) { const float dv = (q4v[t][0] * k4[jj][0] + q4v[t][1] * k4[jj][1]) + (q4v[t][2] * k4[jj][2] + q4v[t][3] * k4[jj][3]);
                    if (half == 0) pa[jj * 4 + t] = dv; else pbv[jj * 4 + t] = dv; }
        }
        const bool bit = lane & 32;
#pragma unroll
        for (int i = 0; i < 32; ++i) { const float keep = bit ? pbv[i] : pa[i], send = bit ? pa[i] : pbv[i]; r64[32 * pr + i] = keep + __shfl_xor(send, 32); }
    }
    { const bool bit = lane & 16;
#pragma unroll
      for (int i = 0; i < 32; ++i) { const float keep = bit ? r64[i + 32] : r64[i], send = bit ? r64[i] : r64[i + 32]; r32v[i] = keep + __shfl_xor(send, 16); } }
    { const bool bit = lane & 8;
#pragma unroll
      for (int i = 0; i < 16; ++i) { const float keep = bit ? r32v[i + 16] : r32v[i], send = bit ? r32v[i] : r32v[i + 16]; r16[i] = keep + __shfl_xor(send, 8); } }
    { const bool bit = lane & 4;
#pragma unroll
      for (int i = 0; i < 8; ++i) { const float keep = bit ? r16[i + 8] : r16[i], send = bit ? r16[i] : r16[i + 8]; r8[i] = keep + __shfl_xor(send, 4); } }
    { const bool bit = lane & 2;
#pragma unroll
      for (int i = 0; i < 4; ++i) { const float keep = bit ? r8[i + 4] : r8[i], send = bit ? r8[i] : r8[i + 4]; r4[i] = keep + __shfl_xor(send, 2); } }
    { const bool bit = lane & 1;
#pragma unroll
      for (int i = 0; i < 2; ++i) { const float keep = bit ? r4[i + 2] : r4[i], send = bit ? r4[i] : r4[i + 2]; r2[i] = keep + __shfl_xor(send, 1); } }
    { LAS float* SC = (LAS float*)(L + AS_SC); const int m = 32 * w + (lane >> 1), t0 = 2 * (lane & 1); SC[t0 * 256 + m] = r2[0]; SC[(t0 + 1) * 256 + m] = r2[1]; }
    __syncthreads();
    if (w < 4) {
        const f32x4 s4 = *(const LAS f32x4*)(L + AS_SC + (w * 256 + 4 * lane) * 4);
        float mx = fmaxf(fmaxf(s4[0], s4[1]), fmaxf(s4[2], s4[3]));
#pragma unroll
        for (int o = 1; o < 64; o <<= 1) mx = fmaxf(mx, __shfl_xor(mx, o));
        f32x4 p; float sum = 0.f;
#pragma unroll
        for (int e = 0; e < 4; ++e) { p[e] = __expf(s4[e] - mx); sum += p[e]; }
        sum = wave_sum(sum); const float inv = 1.f / sum;
        LAS float* PL = (LAS float*)(L + AS_PL);
#pragma unroll
        for (int e = 0; e < 4; ++e) PL[(4 * lane + e) * 4 + w] = p[e] * inv;
    }
    __syncthreads();
    f32x4 acc[4];
#pragma unroll
    for (int t = 0; t < 4; ++t) acc[t] = (f32x4){0.f, 0.f, 0.f, 0.f};
#pragma unroll
    for (int grp = 0; grp < 4; ++grp) {
        f32x4 v4[8];
#pragma unroll
        for (int jj = 0; jj < 8; ++jj) v4[jj] = *(const f32x4*)(Vf + (size_t)(32 * w + 8 * grp + jj) * (XH * XHD) + 4 * lane);
#pragma unroll
        for (int jj = 0; jj < 8; ++jj) { const f32x4 p4v = *(const LAS f32x4*)(L + AS_PL + (32 * w + 8 * grp + jj) * 16);
#pragma unroll
            for (int t = 0; t < 4; ++t) acc[t] += v4[jj] * p4v[t]; }
    }
#pragma unroll
    for (int t = 0; t < 4; ++t) *(LAS f32x4*)(L + AS_OPART + ((w * 4 + t) * 256 + 4 * lane) * 4) = acc[t];
    __syncthreads();
    { const int t = tid >> 7, c2 = (tid & 127) * 2; float o0 = 0.f, o1 = 0.f;
#pragma unroll
      for (int ww = 0; ww < 8; ++ww) { const f32x2_t v = *(const LAS f32x2_t*)(L + AS_OPART + ((ww * 4 + t) * 256 + c2) * 4); o0 += v[0]; o1 += v[1]; }
      *(unsigned*)(O + ((size_t)MP + 4 * b + t) * D + head * XHD + c2) = pk_bf16(o0, o1); }
    __syncthreads();
}
constexpr int MU_SLAB = 32 * 64 * 4;
template <class G>
__device__ __forceinline__ void mini_unit(Frame& F, const bf16_t* __restrict__ A, const bf16_t* __restrict__ Wt, int K, int unit, const G& gran) {
    const int rb = unit >> 4, cb = unit & 15;
    const int lane = lane_id(), w = F.wave, r32 = lane & 31, hh = lane >> 5, ct = w & 1, ks = w >> 1;
    LAS unsigned char* L = F.lds + RING_OFF;
    const int kq = K >> 2;
    const bf16_t* ap = A + (size_t)(MP + 32 * rb + r32) * K + ks * kq + 8 * hh;
    const bf16_t* wp = Wt + (size_t)(64 * cb + 32 * ct + r32) * K + ks * kq + 8 * hh;
    f32x16v acc;
#pragma unroll
    for (int i = 0; i < 16; ++i) acc[i] = 0.f;
    for (int k0 = 0; k0 < kq; k0 += 128) {
        bf16x8v af[8], wf[8];
#pragma unroll
        for (int j = 0; j < 8; ++j) { const int k = k0 + 16 * j; if (k < kq) { af[j] = *(const bf16x8v*)(ap + k); wf[j] = *(const bf16x8v*)(wp + k); } }
#pragma unroll
        for (int j = 0; j < 8; ++j) { const int k = k0 + 16 * j; if (k < kq) acc = MFMA32(wf[j], af[j], acc); }
    }
    { LAS float* C = (LAS float*)(L + ks * MU_SLAB) + r32 * 64 + 32 * ct;
#pragma unroll
      for (int gq = 0; gq < 4; ++gq) *(LAS f32x4*)(C + 8 * gq + 4 * hh) = (f32x4){acc[4 * gq], acc[4 * gq + 1], acc[4 * gq + 2], acc[4 * gq + 3]}; }
    __syncthreads();
    { const int tid = w * 64 + lane, m = tid >> 4, g = tid & 15;
      const LAS f32x4* C = (const LAS f32x4*)(L + (m * 64 + 4 * g) * 4);
      const f32x4 v = (C[0] + C[MU_SLAB / 16]) + (C[2 * MU_SLAB / 16] + C[3 * MU_SLAB / 16]);
      gran(MP + 32 * rb + m, 64 * cb + 4 * g, v, cb, g); }
    __syncthreads();
}
struct GranResid {
    const float* xold_s; float* y; bf16_t* xb; float* st;
    __device__ __forceinline__ void operator()(int row, int col, const f32x4& acc, int cb, int g) const {
        const f32x4 v = *(const f32x4*)(xold_s + (size_t)(row - MP) * D + col) + acc;
        *(f32x4*)(y + (size_t)row * D + col) = v;
        *(unsigned long long*)(xb + (size_t)row * D + col) = (unsigned long long)pk_bf16(v[0], v[1]) | ((unsigned long long)pk_bf16(v[2], v[3]) << 32);
        float ss = (v[0] * v[0] + v[1] * v[1]) + (v[2] * v[2] + v[3] * v[3]);
        ss += __shfl_xor(ss, 1); ss += __shfl_xor(ss, 2); ss += __shfl_xor(ss, 4); ss += __shfl_xor(ss, 8);
        if (g == 0) st[(size_t)row * 16 + cb] = ss;
    }
};
struct GranScale {
    const float* st; bf16_t* o; float scale;
    __device__ __forceinline__ void operator()(int row, int col, const f32x4& acc, int, int) const {
        const float rs = row_rs(st, row) * scale;
        *(unsigned long long*)(o + (size_t)row * D + col) = (unsigned long long)pk_bf16(acc[0] * rs, acc[1] * rs) | ((unsigned long long)pk_bf16(acc[2] * rs, acc[3] * rs) << 32);
    }
};
#ifndef DUP_PHASE
#define DUP_PHASE (-1)
#endif
enum { PH_PREP = 0, PH_INPROJ = 1, PH_REC = 2, PH_OUTPROJ = 3, PH_XQ = 4, PH_ATTN = 5, PH_XO = 6, PH_GU = 7, PH_DOWN = 8, PH_FINAL = 9, PH_MEMKV = 10, PH_COUNT = 11 };

__global__ void __launch_bounds__(NWAVES * 64, 2) mega(Args args) {
    extern __shared__ __attribute__((aligned(16))) unsigned char lds[];
    Frame F;
    F.lds = (LAS unsigned char*)lds; F.MISC = (volatile LAS unsigned*)(F.lds + MISC_OFF);
    F.wave = __builtin_amdgcn_readfirstlane((int)threadIdx.x >> 6);
    F.G = gridDim.x; { const int bx = blockIdx.x; F.vcu = (F.G % 8 == 0) ? (bx % 8) * (F.G / 8) + bx / 8 : bx; }
    unsigned char* ws = args.ws;
    F.ctl = (gu32*)(ws + WS_CTL);
    for (int u = (int)threadIdx.x; u < (LDS_BYTES - LDSCTL_OFF) / 4; u += NWAVES * 64) ((LAS unsigned*)(F.lds + LDSCTL_OFF))[u] = 0u;
    __syncthreads();
    const int lo = args.ph_lo, hi = args.ph_hi;
    XcdBarrier bar; bar.bar = (unsigned*)(F.ctl + CW_BAR) + args.li * XCD_BAR_WORDS; bar.x = 0; bar.st = nullptr; bar.wave = F.wave;
    if (hi - lo > 1) bar = xcd_barrier_post((unsigned*)(F.ctl + CW_BAR) + args.li * XCD_BAR_WORDS, F.MISC + 8, F.wave);
#define IN(k) (lo <= (k) && (k) < hi)
#define BOTH(k) (IN(k) && IN((k) + 1))
    if (IN(PH_PREP)) for (int rep = 0; rep < (DUP_PHASE == PH_PREP ? 2 : 1); ++rep) { phase_prep(F, args); if (BOTH(PH_PREP) || rep + 1 < (DUP_PHASE == PH_PREP ? 2 : 1)) xcd_barrier(bar); }
    if (IN(PH_INPROJ)) for (int rep = 0; rep < (DUP_PHASE == PH_INPROJ ? 2 : 1); ++rep) {
        pg8::Gemm g{(const bf16_t*)(ws + WS_XB0), (const bf16_t*)(ws + WS_W_IN), MT, INW, D};
        pg8::StaticOrder S; S.init(MT, INW, F.G, (int)blockIdx.x);
        EpiInProj E{(const float*)(ws + WS_RS0), (const float*)(ws + WS_CS), (const float*)(ws + WS_LOW), args.in[I_RGAIN], args.in[I_HGAIN], (bf16_t*)(ws + WS_PB), (float*)(ws + WS_LF)};
        pg8::gemm_phase<EpiInProj, pg8::StaticOrder, PG8_ALIGN, PG8_SP2>(F.lds + RING_OFF, g, S, E, F.wave);
        {
            pg8::Gemm g2{(const bf16_t*)(ws + WS_MB), (const bf16_t*)(ws + WS_W_KV), MMEM, 2 * D, D};
            pg8::StaticOrder S2; S2.init(MMEM, 2 * D, F.G, F.G - 1 - (int)blockIdx.x);
            EpiMemKV E2{(const float*)(ws + WS_RSM), args.out + O_MEMK, args.out + O_MEMV, (bf16_t*)(ws + WS_MK), (bf16_t*)(ws + WS_MV)};
            pg8::gemm_phase<EpiMemKV, pg8::StaticOrder, PG8_ALIGN, PG8_SP2>(F.lds + RING_OFF, g2, S2, E2, F.wave);
        }
        if (BOTH(PH_INPROJ) || rep + 1 < (DUP_PHASE == PH_INPROJ ? 2 : 1)) xcd_barrier(bar);
    }
    if (IN(PH_REC)) for (int rep = 0; rep < (DUP_PHASE == PH_REC ? 2 : 1); ++rep) {
        if ((int)blockIdx.x < 64) { if (!(args.pad & 1)) rec_prompt_unit(F, args, (int)blockIdx.x); }
        else if (!(args.pad & 2)) for (int it = (int)blockIdx.x - 64; it < 1024; it += F.G - 64) rec_sample_item(F, args, it);
        if (BOTH(PH_REC) || rep + 1 < (DUP_PHASE == PH_REC ? 2 : 1)) xcd_barrier(bar);
    }
    if (IN(PH_OUTPROJ)) for (int rep = 0; rep < (DUP_PHASE == PH_OUTPROJ ? 2 : 1); ++rep) {
        pg8::Gemm g{(const bf16_t*)(ws + WS_OB), (const bf16_t*)(ws + WS_W_OUT), MP, D, D};
        pg8::StaticOrder S; S.init(MP, D, F.G, (int)blockIdx.x);
        EpiResid E{args.in[I_XP], args.in[I_XS], args.out + O_Y, (bf16_t*)(ws + WS_XB1), (float*)(ws + WS_ST1)};
        pg8::gemm_phase<EpiResid, pg8::StaticOrder, PG8_ALIGN, PG8_SP2>(F.lds + RING_OFF, g, S, E, F.wave);
        { GranResid Gm{args.in[I_XS], args.out + O_Y, (bf16_t*)(ws + WS_XB1), (float*)(ws + WS_ST1)};
          for (int u = (int)blockIdx.x; u < 256; u += F.G) mini_unit(F, (const bf16_t*)(ws + WS_OB), (const bf16_t*)(ws + WS_W_OUT), D, u, Gm); }
        if (BOTH(PH_OUTPROJ) || rep + 1 < (DUP_PHASE == PH_OUTPROJ ? 2 : 1)) xcd_barrier(bar);
    }
    if (IN(PH_XQ)) for (int rep = 0; rep < (DUP_PHASE == PH_XQ ? 2 : 1); ++rep) {
        pg8::Gemm g{(const bf16_t*)(ws + WS_XB1), (const bf16_t*)(ws + WS_W_XQ), MP, D, D};
        pg8::StaticOrder S; S.init(MP, D, F.G, (int)blockIdx.x);
        EpiScaleBf16 E{(const float*)(ws + WS_ST1), (bf16_t*)(ws + WS_Q), 0.0625f};
        pg8::gemm_phase<EpiScaleBf16, pg8::StaticOrder, PG8_ALIGN, PG8_SP2>(F.lds + RING_OFF, g, S, E, F.wave);
        { GranScale Gm{(const float*)(ws + WS_ST1), (bf16_t*)(ws + WS_Q), 0.0625f};
          for (int u = (int)blockIdx.x; u < 256; u += F.G) mini_unit(F, (const bf16_t*)(ws + WS_XB1), (const bf16_t*)(ws + WS_W_XQ), D, u, Gm); }
        if (BOTH(PH_XQ) || rep + 1 < (DUP_PHASE == PH_XQ ? 2 : 1)) xcd_barrier(bar);
    }
    if (IN(PH_ATTN)) for (int rep = 0; rep < (DUP_PHASE == PH_ATTN ? 2 : 1); ++rep) {
        for (int u = (int)blockIdx.x; u < 256; u += F.G) attn_prompt_unit(F, args, u);
        for (int it = (int)blockIdx.x; it < 512; it += F.G) attn_sample_item(F, args, it);
        if (BOTH(PH_ATTN) || rep + 1 < (DUP_PHASE == PH_ATTN ? 2 : 1)) xcd_barrier(bar);
    }
    if (IN(PH_XO)) for (int rep = 0; rep < (DUP_PHASE == PH_XO ? 2 : 1); ++rep) {
        pg8::Gemm g{(const bf16_t*)(ws + WS_OB), (const bf16_t*)(ws + WS_W_XO), MP, D, D};
        pg8::StaticOrder S; S.init(MP, D, F.G, (int)blockIdx.x);
        EpiResid E{args.out + O_Y, args.out + O_Y + (size_t)MP * D, (float*)(ws + WS_Y2), (bf16_t*)(ws + WS_XB2), (float*)(ws + WS_ST2)};
        pg8::gemm_phase<EpiResid, pg8::StaticOrder, PG8_ALIGN, PG8_SP2>(F.lds + RING_OFF, g, S, E, F.wave);
        { GranResid Gm{args.out + O_Y + (size_t)MP * D, (float*)(ws + WS_Y2), (bf16_t*)(ws + WS_XB2), (float*)(ws + WS_ST2)};
          for (int u = (int)blockIdx.x; u < 256; u += F.G) mini_unit(F, (const bf16_t*)(ws + WS_OB), (const bf16_t*)(ws + WS_W_XO), D, u, Gm); }
        if (BOTH(PH_XO) || rep + 1 < (DUP_PHASE == PH_XO ? 2 : 1)) xcd_barrier(bar);
    }
    if (IN(PH_GU)) for (int rep = 0; rep < (DUP_PHASE == PH_GU ? 2 : 1); ++rep) {
        pg8::Gemm g{(const bf16_t*)(ws + WS_XB2), (const bf16_t*)(ws + WS_W_GU), MT, 2 * DFF, D};
        pg8::StaticOrder S; S.init(MT, 2 * DFF, F.G, (int)blockIdx.x);
        EpiGateUp E{(const float*)(ws + WS_ST2), (bf16_t*)(ws + WS_ACT)};
        pg8::gemm_phase<EpiGateUp, pg8::StaticOrder, PG8_ALIGN, PG8_SP2>(F.lds + RING_OFF, g, S, E, F.wave);
        if (BOTH(PH_GU) || rep + 1 < (DUP_PHASE == PH_GU ? 2 : 1)) xcd_barrier(bar);
    }
    if (IN(PH_DOWN)) for (int rep = 0; rep < (DUP_PHASE == PH_DOWN ? 2 : 1); ++rep) {
        pg8::Gemm g{(const bf16_t*)(ws + WS_ACT), (const bf16_t*)(ws + WS_W_DN), MP, D, DFF};
        pg8::StaticOrder S; S.init(MP, D, F.G, (int)blockIdx.x);
        EpiResid E{(const float*)(ws + WS_Y2), (const float*)(ws + WS_Y2) + (size_t)MP * D, (float*)(ws + WS_Y3), (bf16_t*)(ws + WS_XB1), (float*)(ws + WS_ST3)};
        pg8::gemm_phase<EpiResid, pg8::StaticOrder, PG8_ALIGN, PG8_SP2>(F.lds + RING_OFF, g, S, E, F.wave);
        { GranResid Gm{(const float*)(ws + WS_Y2) + (size_t)MP * D, (float*)(ws + WS_Y3), (bf16_t*)(ws + WS_XB1), (float*)(ws + WS_ST3)};
          for (int u = (int)blockIdx.x; u < 256; u += F.G) mini_unit(F, (const bf16_t*)(ws + WS_ACT), (const bf16_t*)(ws + WS_W_DN), DFF, u, Gm); }
        if (BOTH(PH_DOWN) || rep + 1 < (DUP_PHASE == PH_DOWN ? 2 : 1)) xcd_barrier(bar);
    }
    if (IN(PH_FINAL)) for (int rep = 0; rep < (DUP_PHASE == PH_FINAL ? 2 : 1); ++rep) { phase_final(F, args); if (rep + 1 < (DUP_PHASE == PH_FINAL ? 2 : 1)) xcd_barrier(bar); }
#undef IN
#undef BOTH
}

__global__ void __launch_bounds__(128) mixer_naive2(const bf16_t* __restrict__ pb, const float* __restrict__ lf, const float* __restrict__ s0_ret, const float* __restrict__ s0_hg,
                                                    float* __restrict__ sout_ret, float* __restrict__ sout_hg, float* o_f32, bf16_t* ob, int Tn, int row0, int prompt) {
    __shared__ float qs[128], ks[128], fs[128], red[2];
    const int bh = blockIdx.x, b = bh >> 2, h = bh & 3, e = threadIdx.x, kind = blockIdx.y;
    float S[128];
    const float* s0 = kind == 0 ? s0_ret : s0_hg;
#pragma unroll
    for (int d = 0; d < 128; ++d) { const int dor = kind == 0 ? ((d & 1) ? 64 + (d >> 1) : (d >> 1)) : d; S[d] = s0 ? s0[((size_t)bh * 128 + dor) * 128 + e] : 0.f; }
    const float gamma = 1.f - exp2f(-5.f - (float)h);
    for (int t = 0; t < Tn; ++t) {
        const size_t row = (size_t)row0 + (size_t)b * Tn + t;
        const bf16_t* pr = pb + row * PBW;
        __syncthreads();
        if (kind == 0) {
            float q = bf2f(pr[h * 128 + e]), k = bf2f(pr[512 + h * 128 + e]);
            if (prompt) { const float n = (float)((t & 31) + 1); q *= powf(gamma, -n); k *= powf(gamma, n); }
            qs[e] = q; ks[e] = k; fs[e] = gamma;
        } else {
            const float f = expf(lf[row * 512 + h * 128 + e]);
            fs[e] = f; ks[e] = 1.f - f; qs[e] = bf2f(pr[2048 + h * 128 + e]);
        }
        __syncthreads();
        const float v = bf2f(kind == 0 ? pr[1024 + h * 128 + e] : pr[2560 + h * 128 + e]);
        float o = 0.f;
#pragma unroll
        for (int d = 0; d < 128; ++d) { S[d] = fs[d] * S[d] + ks[d] * v; o += qs[d] * S[d]; }
        float ss = o * o;
        for (int of = 32; of > 0; of >>= 1) ss += __shfl_xor(ss, of);
        __syncthreads();
        if ((e & 63) == 0) red[e >> 6] = ss;
        __syncthreads();
        ss = red[0] + red[1];
        const float rs = rsqrtf(ss * (1.f / 128.f) + EPS);
        const float gate = bf2f(kind == 0 ? pr[1536 + h * 128 + e] : pr[3072 + h * 128 + e]);
        const float val = o * rs * gate;
        if (o_f32) o_f32[((size_t)b * Tn + t) * D + kind * 512 + h * 128 + e] = val;
        if (ob) { const float other = __shfl_xor(val, 1); if ((e & 1) == 0) *(unsigned*)(ob + row * D + kind * 512 + h * 128 + e) = pk_bf16(val, other); }
    }
    float* so = kind == 0 ? sout_ret : sout_hg;
#pragma unroll
    for (int d = 0; d < 128; ++d) { const int dor = kind == 0 ? ((d & 1) ? 64 + (d >> 1) : (d >> 1)) : d; so[((size_t)bh * 128 + dor) * 128 + e] = S[d]; }
}
__global__ void __launch_bounds__(256) xattn_naive2(const bf16_t* __restrict__ q, const bf16_t* __restrict__ Kb, const bf16_t* __restrict__ Vb, const float* __restrict__ Kf, const float* __restrict__ Vf,
                                                    bf16_t* __restrict__ out, int row0, int tpb) {
    __shared__ float qs[256], ps[256], red[4];
    const int r = blockIdx.x, head = blockIdx.y, b = r / tpb, tid = threadIdx.x; const size_t row = (size_t)row0 + r;
    qs[tid] = bf2f(q[row * D + head * XHD + tid]);
    __syncthreads();
    const size_t kro = (((size_t)b * NMEM + tid) * XH + head) * XHD;
    float s = 0.f;
    for (int d = 0; d < XHD; ++d) s += qs[d] * (Kf ? Kf[kro + d] : bf2f(Kb[kro + d]));
    for (int o = 32; o > 0; o >>= 1) {}
    float mx = s;
    for (int o = 32; o > 0; o >>= 1) mx = fmaxf(mx, __shfl_xor(mx, o));
    if ((tid & 63) == 0) red[tid >> 6] = mx;
    __syncthreads();
    mx = fmaxf(fmaxf(red[0], red[1]), fmaxf(red[2], red[3]));
    __syncthreads();
    const float p = expf(s - mx);
    float sum = p;
    for (int o = 32; o > 0; o >>= 1) sum += __shfl_xor(sum, o);
    if ((tid & 63) == 0) red[tid >> 6] = sum;
    __syncthreads();
    sum = (red[0] + red[1]) + (red[2] + red[3]);
    ps[tid] = p / sum;
    __syncthreads();
    float o = 0.f;
    for (int m = 0; m < NMEM; ++m) { const size_t vo = (((size_t)b * NMEM + m) * XH + head) * XHD + tid; o += ps[m] * (Vf ? Vf[vo] : bf2f(Vb[vo])); }
    const float other = __shfl_xor(o, 1);
    if ((tid & 1) == 0) *(unsigned*)(out + row * D + head * XHD + tid) = pk_bf16(o, other);
}
}
namespace nv {
constexpr int D = 1024, T = 2048, NB = 8, MP = NB * T, SB = 128, ST = 4, MS = SB * ST;
constexpr int INW = 4096, NMEM = 256, XH = 4, XHD = 256, DFF = 2816, PAST = 16384;
constexpr float EPS = 1e-6f;

struct RopeTab { float inv_freq[64]; };

__device__ __forceinline__ void sincos_d(double x, double& s, double& c) {
    const double two_over_pi = 0.63661977236758134308;
    const double pio2_hi = 1.57079632673412561417e+00, pio2_lo = 6.07710050650619224932e-11, pio2_lo2 = 2.02226624879595063154e-21;
    double qd = rint(x * two_over_pi);
    double r = x - qd * pio2_hi; r -= qd * pio2_lo; r -= qd * pio2_lo2;
    long long q = (long long)qd;
    double r2 = r * r;
    double sp = r * (1.0 + r2 * (-1.0 / 6 + r2 * (1.0 / 120 + r2 * (-1.0 / 5040 + r2 * (1.0 / 362880 + r2 * (-1.0 / 39916800 + r2 * (1.0 / 6227020800.0 + r2 * (-1.0 / 1307674368000.0))))))));
    double cp = 1.0 + r2 * (-0.5 + r2 * (1.0 / 24 + r2 * (-1.0 / 720 + r2 * (1.0 / 40320 + r2 * (-1.0 / 3628800 + r2 * (1.0 / 479001600.0 + r2 * (-1.0 / 87178291200.0 + r2 * (1.0 / 20922789888000.0))))))));
    switch (q & 3) {
        case 0: s = sp; c = cp; break;
        case 1: s = cp; c = -sp; break;
        case 2: s = -sp; c = -cp; break;
        default: s = -cp; c = sp; break;
    }
}

__device__ __forceinline__ float silu_f(float x) { return x / (1.f + expf(-x)); }
__device__ __forceinline__ float sigmoid_f(float x) { return 1.f / (1.f + expf(-x)); }

__device__ __forceinline__ float block_sum_256(float v, float* red) {
    for (int o = 32; o > 0; o >>= 1) v += __shfl_xor(v, o);
    const int w = threadIdx.x >> 6;
    __syncthreads();
    if ((threadIdx.x & 63) == 0) red[w] = v;
    __syncthreads();
    float s = 0.f;
    for (int i = 0; i < (int)(blockDim.x >> 6); ++i) s += red[i];
    return s;
}
__device__ __forceinline__ float block_max_256(float v, float* red) {
    for (int o = 32; o > 0; o >>= 1) v = fmaxf(v, __shfl_xor(v, o));
    const int w = threadIdx.x >> 6;
    __syncthreads();
    if ((threadIdx.x & 63) == 0) red[w] = v;
    __syncthreads();
    float s = red[0];
    for (int i = 1; i < (int)(blockDim.x >> 6); ++i) s = fmaxf(s, red[i]);
    return s;
}

__global__ void __launch_bounds__(256) rmsnorm_k(const float* x, const float* __restrict__ g, float* y) {
    __shared__ float red[4];
    const size_t row = blockIdx.x;
    const float4 v = ((const float4*)(x + row * D))[threadIdx.x];
    float ss = v.x * v.x + v.y * v.y + v.z * v.z + v.w * v.w;
    ss = block_sum_256(ss, red);
    const float rs = rsqrtf(ss * (1.f / D) + EPS);
    const float4 gg = ((const float4*)g)[threadIdx.x];
    float4 o; o.x = v.x * rs * gg.x; o.y = v.y * rs * gg.y; o.z = v.z * rs * gg.z; o.w = v.w * rs * gg.w;
    ((float4*)(y + row * D))[threadIdx.x] = o;
}

template <int MODE>
__global__ void __launch_bounds__(256) gemm_naive(const float* __restrict__ A, const float* __restrict__ B, const float* __restrict__ B2,
                                                  const float* R, float* C, int M, int N, int K) {
    __shared__ float As[16][64 + 4];
    __shared__ float Bs[16][64 + 4];
    __shared__ float Bs2[MODE == 2 ? 16 : 1][64 + 4];
    const int tx = threadIdx.x & 15, ty = threadIdx.x >> 4;
    const int m0 = blockIdx.y * 64, n0 = blockIdx.x * 64;
    float acc[4][4] = {}, acc2[4][4] = {};
    for (int k0 = 0; k0 < K; k0 += 16) {
        {
            const int r = threadIdx.x >> 2, c4 = (threadIdx.x & 3) * 4;
            const float4 v = *(const float4*)(A + (size_t)(m0 + r) * K + k0 + c4);
            As[c4 + 0][r] = v.x; As[c4 + 1][r] = v.y; As[c4 + 2][r] = v.z; As[c4 + 3][r] = v.w;
            const int kr = threadIdx.x >> 4, c = (threadIdx.x & 15) * 4;
            const float4 w = *(const float4*)(B + (size_t)(k0 + kr) * N + n0 + c);
            Bs[kr][c] = w.x; Bs[kr][c + 1] = w.y; Bs[kr][c + 2] = w.z; Bs[kr][c + 3] = w.w;
            if (MODE == 2) {
                const float4 w2 = *(const float4*)(B2 + (size_t)(k0 + kr) * N + n0 + c);
                Bs2[kr][c] = w2.x; Bs2[kr][c + 1] = w2.y; Bs2[kr][c + 2] = w2.z; Bs2[kr][c + 3] = w2.w;
            }
        }
        __syncthreads();
#pragma unroll
        for (int kk = 0; kk < 16; ++kk) {
            float a[4], b[4], b2[4];
#pragma unroll
            for (int i = 0; i < 4; ++i) a[i] = As[kk][ty * 4 + i];
#pragma unroll
            for (int j = 0; j < 4; ++j) { b[j] = Bs[kk][tx * 4 + j]; b2[j] = (MODE == 2) ? Bs2[kk][tx * 4 + j] : 0.f; }
#pragma unroll
            for (int i = 0; i < 4; ++i)
#pragma unroll
                for (int j = 0; j < 4; ++j) { acc[i][j] += a[i] * b[j]; if (MODE == 2) acc2[i][j] += a[i] * b2[j]; }
        }
        __syncthreads();
    }
#pragma unroll
    for (int i = 0; i < 4; ++i) {
        const size_t off = (size_t)(m0 + ty * 4 + i) * N + n0 + tx * 4;
        float4 o;
        if (MODE == 0) { o.x = acc[i][0]; o.y = acc[i][1]; o.z = acc[i][2]; o.w = acc[i][3]; }
        else if (MODE == 1) { const float4 r = *(const float4*)(R + off); o.x = r.x + acc[i][0]; o.y = r.y + acc[i][1]; o.z = r.z + acc[i][2]; o.w = r.w + acc[i][3]; }
        else { o.x = silu_f(acc[i][0]) * acc2[i][0]; o.y = silu_f(acc[i][1]) * acc2[i][1]; o.z = silu_f(acc[i][2]) * acc2[i][2]; o.w = silu_f(acc[i][3]) * acc2[i][3]; }
        *(float4*)(C + off) = o;
    }
}

__global__ void __launch_bounds__(128) mixer_naive(const float* __restrict__ proj, const float* __restrict__ s0_ret, const float* __restrict__ s0_hg,
                                                   float* __restrict__ sout_ret, float* __restrict__ sout_hg, float* __restrict__ o_out,
                                                   const float* __restrict__ ret_gain, const float* __restrict__ hg_gain, const float* __restrict__ hg_lb,
                                                   int Tn, int pos0, RopeTab rt) {
    __shared__ float qs[128], ks[128], fs[128], red[2];
    const int bh = blockIdx.x, b = bh >> 2, h = bh & 3, e = threadIdx.x, kind = blockIdx.y;
    float S[128];
    const float* s0 = kind == 0 ? s0_ret : s0_hg;
#pragma unroll
    for (int d = 0; d < 128; ++d) S[d] = s0 ? s0[((size_t)bh * 128 + d) * 128 + e] : 0.f;
    const float gamma = 1.f - exp2f(-5.f - (float)h);
    float lower = 0.f;
    if (kind == 1) { const float a = hg_lb[h * 128 + e], c = hg_lb[512 + h * 128 + e]; const float m = fmaxf(a, c); const float ea = expf(a - m), ec = expf(c - m); lower = ea / (ea + ec); }
    for (int t = 0; t < Tn; ++t) {
        const float* pr = proj + (size_t)(b * Tn + t) * INW;
        __syncthreads();
        if (kind == 0) {
            if (e < 64) {
                const float ang = (float)(pos0 + t) * rt.inv_freq[e];
                double sd, cd; sincos_d((double)ang, sd, cd);
                const float cs = (float)cd, sn = (float)sd;
                const float q1 = pr[h * 128 + e], q2 = pr[h * 128 + e + 64];
                qs[e] = q1 * cs - q2 * sn; qs[e + 64] = q1 * sn + q2 * cs;
                const float k1 = pr[512 + h * 128 + e], k2 = pr[512 + h * 128 + e + 64];
                const float sc = 0.08838834764831845f;
                ks[e] = (k1 * cs - k2 * sn) * sc; ks[e + 64] = (k1 * sn + k2 * cs) * sc;
            }
            fs[e] = gamma;
        } else {
            const float f = lower + (1.f - lower) * sigmoid_f(pr[2560 + h * 128 + e]);
            fs[e] = f; ks[e] = 1.f - f; qs[e] = silu_f(pr[2048 + h * 128 + e]);
        }
        __syncthreads();
        const float v = kind == 0 ? pr[1024 + h * 128 + e] : pr[3072 + h * 128 + e];
        float o = 0.f;
#pragma unroll
        for (int d = 0; d < 128; ++d) { S[d] = fs[d] * S[d] + ks[d] * v; o += qs[d] * S[d]; }
        float ss = o * o;
        for (int of = 32; of > 0; of >>= 1) ss += __shfl_xor(ss, of);
        __syncthreads();
        if ((e & 63) == 0) red[e >> 6] = ss;
        __syncthreads();
        ss = red[0] + red[1];
        const float rs = rsqrtf(ss * (1.f / 128.f) + EPS);
        const float gate = kind == 0 ? pr[1536 + h * 128 + e] : pr[3584 + h * 128 + e];
        const float gn = kind == 0 ? ret_gain[h * 128 + e] : hg_gain[h * 128 + e];
        o_out[(size_t)(b * Tn + t) * D + kind * 512 + h * 128 + e] = o * rs * gn * silu_f(gate);
    }
    float* so = kind == 0 ? sout_ret : sout_hg;
#pragma unroll
    for (int d = 0; d < 128; ++d) so[((size_t)bh * 128 + d) * 128 + e] = S[d];
}

__global__ void __launch_bounds__(256) xattn_naive(const float* __restrict__ q, const float* __restrict__ K, const float* __restrict__ V, float* __restrict__ out, int tpb) {
    __shared__ float qs[256], ps[256], red[4];
    const int row = blockIdx.x, head = blockIdx.y, b = row / tpb, tid = threadIdx.x;
    qs[tid] = q[(size_t)row * D + head * XHD + tid];
    __syncthreads();
    const float* kr = K + (((size_t)b * NMEM + tid) * XH + head) * XHD;
    float s = 0.f;
    for (int d = 0; d < XHD; d += 4) { const float4 kv = *(const float4*)(kr + d); s += qs[d] * kv.x + qs[d + 1] * kv.y + qs[d + 2] * kv.z + qs[d + 3] * kv.w; }
    s *= 0.0625f;
    const float mx = block_max_256(s, red);
    const float p = expf(s - mx);
    const float sum = block_sum_256(p, red);
    ps[tid] = p / sum;
    __syncthreads();
    float o = 0.f;
    for (int m = 0; m < NMEM; ++m) o += ps[m] * V[(((size_t)b * NMEM + m) * XH + head) * XHD + tid];
    out[(size_t)row * D + head * XHD + tid] = o;
}
}
extern "C" void kernel_launch(void* const* d_in, const int* in_sizes, int n_in, void* d_out, int out_size, void* d_ws, size_t ws_size, hipStream_t stream) {
    using namespace mk;
    static int grid = 0;
    if (grid == 0) {
        int dev = 0, cus = 0;
        if (hipGetDevice(&dev) != hipSuccess || hipDeviceGetAttribute(&cus, hipDeviceAttributeMultiprocessorCount, dev) != hipSuccess) { fprintf(stderr, "kernel_launch: device query failed\n"); grid = -1; return; }
        if (hipFuncSetAttribute((const void*)mega, hipFuncAttributeMaxDynamicSharedMemorySize, LDS_BYTES) != hipSuccess) { fprintf(stderr, "kernel_launch: hipFuncSetAttribute failed\n"); grid = -1; return; }
        (void)hipGetLastError();
        grid = cus;
    }
    if (grid < 0) return;
    hipMemsetAsync((char*)d_ws + WS_CTL, 0, CTL_ZERO_BYTES, stream);
    Args a{};
    for (int i = 0; i < 24; ++i) a.in[i] = (const float*)d_in[i];
    a.out = (float*)d_out; a.ws = (unsigned char*)d_ws;
    for (int i = 0; i < 64; ++i) a.inv_freq[i] = (float)std::pow(10000.0, -(double)i / 64.0);
    int li_next = 0;
    auto run = [&](int lo, int hi) { a.ph_lo = lo; a.ph_hi = hi; a.li = li_next++; hipLaunchKernelGGL(mega, dim3(grid), dim3(NWAVES * 64), LDS_BYTES, stream, a); };
    unsigned char* ws = (unsigned char*)d_ws; float* out = (float*)d_out;
#if STEP >= 7
#ifdef PROBE_SPLIT
    run(PH_PREP, PROBE_SPLIT + 1);
#ifdef PROBE_MASK
    a.pad = PROBE_MASK;
#endif
    run(PROBE_SPLIT, PROBE_SPLIT + 1);
    a.pad = 0;
    run(PROBE_SPLIT + 1, PH_FINAL + 1);
#else
    run(PH_PREP, PH_FINAL + 1);
#endif
#else
    run(PH_PREP, PH_PREP + 1);
    run(PH_INPROJ, PH_INPROJ + 1);
#if STEP == 2
    float* bufAp = (float*)(ws + 280 * MiB);
    float* bufAs = (float*)(ws + 344 * MiB);
    float* bufB = (float*)(ws + 91 * MiB);
    for (int pass = 0; pass < 2; ++pass) {
        const int nb = pass == 0 ? NB : SB, Tn = pass == 0 ? T : ST;
        mixer_naive2<<<dim3(nb * 4, 2), 128, 0, stream>>>((const bf16_t*)(ws + WS_PB), (const float*)(ws + WS_LF), pass == 0 ? nullptr : (const float*)d_in[3], pass == 0 ? nullptr : (const float*)d_in[4],
                                                          out + (pass == 0 ? O_RETP : O_RETS), out + (pass == 0 ? O_HGP : O_HGS), pass == 0 ? bufAp : bufAs, nullptr, Tn, pass == 0 ? 0 : MP, pass == 0);
    }
    for (int pass = 0; pass < 2; ++pass) {
        const int M = pass == 0 ? MP : MS, Tn = pass == 0 ? T : ST;
        float* bufA = pass == 0 ? bufAp : bufAs;
        const float* x = (const float*)d_in[pass == 0 ? 0 : 1];
        float* y = out + O_Y + (pass == 0 ? 0 : (size_t)MP * D);
        const float* mkp = pass == 0 ? out + O_MEMK : (const float*)d_in[5]; const float* mvp = pass == 0 ? out + O_MEMV : (const float*)d_in[6];
        nv::gemm_naive<1><<<dim3(D / 64, M / 64), 256, 0, stream>>>(bufA, (const float*)d_in[12], nullptr, x, y, M, D, D);
        nv::rmsnorm_k<<<M, 256, 0, stream>>>(y, (const float*)d_in[13], bufA);
        float* qb = bufB; float* ob = bufB + (size_t)MP * D;
        nv::gemm_naive<0><<<dim3(D / 64, M / 64), 256, 0, stream>>>(bufA, (const float*)d_in[15], nullptr, nullptr, qb, M, D, D);
        nv::xattn_naive<<<dim3(M, XH), 256, 0, stream>>>(qb, mkp, mvp, ob, Tn);
        nv::gemm_naive<1><<<dim3(D / 64, M / 64), 256, 0, stream>>>(ob, (const float*)d_in[18], nullptr, y, y, M, D, D);
        nv::rmsnorm_k<<<M, 256, 0, stream>>>(y, (const float*)d_in[19], bufA);
        nv::gemm_naive<2><<<dim3(DFF / 64, M / 64), 256, 0, stream>>>(bufA, (const float*)d_in[20], (const float*)d_in[21], nullptr, bufB, M, DFF, D);
        nv::gemm_naive<1><<<dim3(D / 64, M / 64), 256, 0, stream>>>(bufB, (const float*)d_in[22], nullptr, y, y, M, D, DFF);
        nv::rmsnorm_k<<<M, 256, 0, stream>>>(y, (const float*)d_in[23], y);
    }
#else
#if STEP >= 4
    run(PH_REC, PH_REC + 1);
#else
    for (int pass = 0; pass < 2; ++pass) {
        const int nb = pass == 0 ? NB : SB, Tn = pass == 0 ? T : ST;
        mixer_naive2<<<dim3(nb * 4, 2), 128, 0, stream>>>((const bf16_t*)(ws + WS_PB), (const float*)(ws + WS_LF), pass == 0 ? nullptr : (const float*)d_in[3], pass == 0 ? nullptr : (const float*)d_in[4],
                                                          out + (pass == 0 ? O_RETP : O_RETS), out + (pass == 0 ? O_HGP : O_HGS), nullptr, (bf16_t*)(ws + WS_OB), Tn, pass == 0 ? 0 : MP, pass == 0);
    }
#endif
    run(PH_OUTPROJ, PH_OUTPROJ + 1);
    run(PH_XQ, PH_XQ + 1);
#if STEP >= 6
    run(PH_ATTN, PH_ATTN + 1);
#else
    xattn_naive2<<<dim3(MP, XH), 256, 0, stream>>>((const bf16_t*)(ws + WS_Q), (const bf16_t*)(ws + WS_MK), (const bf16_t*)(ws + WS_MV), nullptr, nullptr, (bf16_t*)(ws + WS_OB), 0, T);
    xattn_naive2<<<dim3(MS, XH), 256, 0, stream>>>((const bf16_t*)(ws + WS_Q), nullptr, nullptr, (const float*)d_in[5], (const float*)d_in[6], (bf16_t*)(ws + WS_OB), MP, ST);
#endif
    run(PH_XO, PH_XO + 1);
    run(PH_GU, PH_GU + 1);
    run(PH_DOWN, PH_DOWN + 1);
    run(PH_FINAL, PH_FINAL + 1);
#endif
#endif
}
```

```cpp
#include <hip/hip_runtime.h>
#include <cmath>
#include <cstdio>
#include <cstdint>

#define STEP 7
#define DUP_PHASE (-1)
namespace pg8 {
#define PG8_LAS __attribute__((address_space(3)))
typedef unsigned short bf16_t;
typedef short bf16x8 __attribute__((ext_vector_type(8)));
typedef float f32x4 __attribute__((ext_vector_type(4)));
typedef unsigned u32x4 __attribute__((ext_vector_type(4)));
constexpr int BM = 256, BK = 64, HALF = 128, HTB = HALF * BK * 2  , STAGE_BYTES = 8 * HTB, NXCD = 8, WGM = 8;

__host__ __device__ __forceinline__ int lds_byte(int r, int c) { const int st = (r >> 4) * 2 + (c >> 5), rr = r & 15, cc = c & 31, ob = rr * 64 + cc * 2; return st * 1024 + (ob ^ (((ob >> 9) & 1) << 5)); }
__host__ __device__ __forceinline__ void stage_rc(int b, int& R, int& C) { const int st = b / 1024, sb = b % 1024, swz = sb ^ (((sb >> 9) & 1) << 5); R = (st >> 1) * 16 + swz / 64; C = (st & 1) * 32 + (swz % 64) / 2; }
__host__ __device__ __forceinline__ int perm32(int rho) { const int n = rho >> 4, i = rho & 15; return 8 * (i >> 2) + 4 * n + (i & 3); }

struct Unit { int pm, pn; };
struct Gemm { const bf16_t* A; const bf16_t* Bt; int M, N, K; };

struct StaticOrder {
    int nM, nN, nwg, G, c;
    __host__ __device__ void init(int M, int N, int G_, int c_) { nM = M / BM; nN = N / BM; nwg = nM * nN; G = G_; c = c_; }
    __host__ __device__ bool next(int i, Unit& u) const {
        const long L = (long)i * G + c; if (L >= nwg) return false;
        int wgid = (int)L; { const int q = nwg / NXCD, r = nwg % NXCD, xcd = wgid % NXCD, off = wgid / NXCD; wgid = (xcd < r ? xcd * (q + 1) : r * (q + 1) + (xcd - r) * q) + off; }
        const int nig = WGM * nN, gid = wgid / nig, fm = gid * WGM, gsz = (nM - fm) < WGM ? (nM - fm) : WGM;
        u.pm = fm + ((wgid % nig) % gsz); u.pn = (wgid % nig) / gsz; return true;
    }
    __device__ __forceinline__ void a_ready(const Unit&) const {}
    __device__ __forceinline__ void done(const Unit&) const {}
};

template <class Epi, class Sched, bool ALIGN_EPI = false, bool SP2 = false>
__device__ __forceinline__ void gemm_phase(PG8_LAS unsigned char* lds, const Gemm g, const Sched& S, const Epi& E, int wid_in) {
    const int lane = (int)__builtin_amdgcn_mbcnt_hi(~0u, __builtin_amdgcn_mbcnt_lo(~0u, 0u)), wid = __builtin_amdgcn_readfirstlane(wid_in), tid = wid * 64 + lane, wr = wid >> 2, wc = wid & 3, fr = lane & 15, fq = lane >> 4;
    const int K = g.K, nt = K / BK;
    unsigned voffA[2], voffB[2];
#pragma unroll
    for (int i = 0; i < 2; ++i) { int R, C; stage_rc(tid * 16 + i * 8192, R, C); const int Rb = Epi::PERM ? ((R & ~31) + perm32(R & 31)) : R;
        voffA[i] = (unsigned)(R * K + C) * 2u; voffB[i] = (unsigned)(Rb * K + C) * 2u; }
    const size_t kstep = (size_t)(BK * 2);
    const size_t hstep = (size_t)HALF * K * 2;
    const size_t tstep = 2 * hstep;
    const unsigned ldsw = (unsigned)wid * 1024u;
    const int aoff = lds_byte(wr * 64 + fr, fq * 8), boff = lds_byte(wc * 32 + fr, fq * 8);
#define PG8_SA(b, h) (((b) * 2 + (h)) * HTB)
#define PG8_SB(b, h) ((4 + (b) * 2 + (h)) * HTB)
#define PG8_STAGE(bufoff, gbase, voff) do { _Pragma("unroll") for (int _i = 0; _i < 2; ++_i) \
        __builtin_amdgcn_global_load_lds((const unsigned*)((const char*)(gbase) + (voff)[_i]), (PG8_LAS unsigned*)(lds + (bufoff) + ldsw + _i * 8192), 16, 0, 0); } while (0)
#define PG8_LDA(dst, b, h) do { _Pragma("unroll") for (int m = 0; m < 4; ++m) _Pragma("unroll") for (int k = 0; k < 2; ++k) dst[m][k] = *(const PG8_LAS bf16x8*)(lds + PG8_SA(b, h) + aoff + m * 2048 + k * 1024); } while (0)
#define PG8_LDB(dst, b, h) do { _Pragma("unroll") for (int n = 0; n < 2; ++n) _Pragma("unroll") for (int k = 0; k < 2; ++k) dst[n][k] = *(const PG8_LAS bf16x8*)(lds + PG8_SB(b, h) + boff + n * 2048 + k * 1024); } while (0)
#define PG8_MMA(ai, bj, At, Bt) do { __builtin_amdgcn_s_setprio(1); _Pragma("unroll") for (int m = 0; m < 4; ++m) _Pragma("unroll") for (int n = 0; n < 2; ++n) _Pragma("unroll") for (int k = 0; k < 2; ++k) \
        acc[ai][bj][m][n] = __builtin_amdgcn_mfma_f32_16x16x32_bf16(Bt[n][k], At[m][k], acc[ai][bj][m][n], 0, 0, 0); __builtin_amdgcn_s_setprio(0); } while (0)
#define PG8_WAIT_V(n) asm volatile("s_waitcnt vmcnt(" #n ")" ::: "memory")
#define PG8_WAIT_L(n) asm volatile("s_waitcnt lgkmcnt(" #n ")" ::: "memory")
#define PG8_BAR __builtin_amdgcn_s_barrier()
#define PG8_SCHED __builtin_amdgcn_sched_barrier(0)
    Unit cur, nxt; int ui = 0;
    if (!S.next(0, cur)) return;
    f32x4 acc[2][2][4][2];
#pragma unroll
    for (int a = 0; a < 2; ++a)
#pragma unroll
        for (int b = 0; b < 2; ++b)
#pragma unroll
            for (int m = 0; m < 4; ++m)
#pragma unroll
                for (int n = 0; n < 2; ++n) acc[a][b][m][n] = (f32x4){0.f, 0.f, 0.f, 0.f};
    bf16x8 At[4][2], B0[2][2], B1[2][2];
    const char* cA = (const char*)g.A + (size_t)cur.pm * tstep; const char* cB = (const char*)g.Bt + (size_t)cur.pn * tstep;
    S.a_ready(cur);
    if constexpr (SP2) {
        PG8_STAGE(PG8_SB(0, 0), cB, voffB); PG8_STAGE(PG8_SB(0, 1), cB + hstep, voffB); PG8_STAGE(PG8_SA(0, 0), cA, voffA); PG8_STAGE(PG8_SA(0, 1), cA + hstep, voffA);
        if (wr == 1) PG8_BAR;
        PG8_WAIT_V(2); PG8_BAR;
        PG8_STAGE(PG8_SB(1, 0), cB + kstep, voffB); PG8_STAGE(PG8_SA(1, 0), cA + kstep, voffA); PG8_STAGE(PG8_SB(1, 1), cB + hstep + kstep, voffB);
        PG8_WAIT_V(6); PG8_BAR;
    } else {
        PG8_STAGE(PG8_SB(0, 0), cB, voffB); PG8_STAGE(PG8_SA(0, 0), cA, voffA); PG8_STAGE(PG8_SB(0, 1), cB + hstep, voffB); PG8_STAGE(PG8_SA(0, 1), cA + hstep, voffA);
        if (wr == 1) PG8_BAR;
        PG8_WAIT_V(4); PG8_BAR;
        PG8_STAGE(PG8_SB(1, 0), cB + kstep, voffB); PG8_STAGE(PG8_SA(1, 0), cA + kstep, voffA); PG8_STAGE(PG8_SB(1, 1), cB + hstep + kstep, voffB);
        PG8_WAIT_V(6); PG8_BAR;
    }
    for (;;) {
        const bool has_next = S.next(ui + 1, nxt);
        const char* nA = has_next ? (const char*)g.A + (size_t)nxt.pm * tstep : cA; const char* nB = has_next ? (const char*)g.Bt + (size_t)nxt.pn * tstep : cB;
        for (int t = 0; t < nt; t += 2) {
            const bool last = (t == nt - 2);
            const char* a1 = cA + (size_t)(t + 1) * kstep;
            const char* a2 = last ? nA : cA + (size_t)(t + 2) * kstep; const char* b2 = last ? nB : cB + (size_t)(t + 2) * kstep;
            const char* a3 = a2 + kstep; const char* b3 = b2 + kstep;
            if (last && has_next) S.a_ready(nxt);
            if constexpr (SP2) {
            PG8_LDB(B0, 0, 0); PG8_LDB(B1, 0, 1); PG8_SCHED; PG8_LDA(At, 0, 0); PG8_STAGE(PG8_SA(1, 1), a1 + hstep, voffA);
            PG8_WAIT_V(8); PG8_WAIT_L(0); PG8_BAR; PG8_MMA(0, 0, At, B0); PG8_MMA(0, 1, At, B1); PG8_BAR; PG8_SCHED;
            PG8_LDA(At, 0, 1); PG8_STAGE(PG8_SB(0, 0), b2, voffB); PG8_STAGE(PG8_SB(0, 1), b2 + hstep, voffB); PG8_STAGE(PG8_SA(0, 0), a2, voffA);
            PG8_WAIT_V(8); PG8_WAIT_L(0); PG8_BAR; PG8_MMA(1, 0, At, B0); PG8_MMA(1, 1, At, B1); PG8_BAR; PG8_SCHED;
            PG8_LDB(B0, 1, 0); PG8_LDB(B1, 1, 1); PG8_SCHED; PG8_LDA(At, 1, 0); PG8_STAGE(PG8_SA(0, 1), a2 + hstep, voffA);
            PG8_WAIT_V(8); PG8_WAIT_L(0); PG8_BAR; PG8_MMA(0, 0, At, B0); PG8_MMA(0, 1, At, B1); PG8_BAR; PG8_SCHED;
            PG8_LDA(At, 1, 1); PG8_STAGE(PG8_SB(1, 0), b3, voffB); PG8_STAGE(PG8_SB(1, 1), b3 + hstep, voffB); PG8_STAGE(PG8_SA(1, 0), a3, voffA);
            PG8_WAIT_V(8); PG8_WAIT_L(0); PG8_BAR; PG8_MMA(1, 0, At, B0); PG8_MMA(1, 1, At, B1); PG8_BAR; PG8_SCHED;
            } else {
            PG8_LDB(B0, 0, 0); PG8_SCHED; PG8_LDA(At, 0, 0); PG8_STAGE(PG8_SA(1, 1), a1 + hstep, voffA);
            PG8_WAIT_L(8); PG8_BAR; PG8_WAIT_L(0); PG8_MMA(0, 0, At, B0); PG8_BAR; PG8_SCHED;
            PG8_LDB(B1, 0, 1); PG8_STAGE(PG8_SB(0, 0), b2, voffB);
            PG8_BAR; PG8_WAIT_L(0); PG8_MMA(0, 1, At, B1); PG8_BAR;
            PG8_LDA(At, 0, 1); PG8_STAGE(PG8_SA(0, 0), a2, voffA);
            PG8_BAR; PG8_WAIT_L(0); PG8_MMA(1, 0, At, B0); PG8_BAR; PG8_SCHED;
            PG8_STAGE(PG8_SB(0, 1), b2 + hstep, voffB);
            PG8_WAIT_V(6); PG8_BAR; PG8_MMA(1, 1, At, B1); PG8_BAR;
            PG8_LDB(B0, 1, 0); PG8_SCHED; PG8_LDA(At, 1, 0); PG8_STAGE(PG8_SA(0, 1), a2 + hstep, voffA);
            PG8_WAIT_L(8); PG8_BAR; PG8_WAIT_L(0); PG8_MMA(0, 0, At, B0); PG8_BAR; PG8_SCHED;
            PG8_LDB(B1, 1, 1); PG8_STAGE(PG8_SB(1, 0), b3, voffB);
            PG8_BAR; PG8_WAIT_L(0); PG8_MMA(0, 1, At, B1); PG8_BAR;
            PG8_LDA(At, 1, 1); PG8_STAGE(PG8_SA(1, 0), a3, voffA);
            PG8_BAR; PG8_WAIT_L(0); PG8_MMA(1, 0, At, B0); PG8_BAR; PG8_SCHED;
            PG8_STAGE(PG8_SB(1, 1), b3 + hstep, voffB);
            PG8_WAIT_V(6); PG8_BAR; PG8_MMA(1, 1, At, B1); PG8_BAR;
            }
        }
        if constexpr (ALIGN_EPI) { if (wr == 0) PG8_BAR; }
        if constexpr (!Epi::AFTER_DRAIN) { E(acc, cur, wr, wc, fr, fq); S.done(cur); }
        if (!has_next) break;
#pragma unroll
        for (int a = 0; a < 2; ++a)
#pragma unroll
            for (int b = 0; b < 2; ++b)
#pragma unroll
                for (int m = 0; m < 4; ++m)
#pragma unroll
                    for (int n = 0; n < 2; ++n) acc[a][b][m][n] = (f32x4){0.f, 0.f, 0.f, 0.f};
        cur = nxt; cA = nA; cB = nB; ++ui;
        if constexpr (ALIGN_EPI) { if (wr == 1) PG8_BAR; }
    }
    PG8_WAIT_V(0);
    if constexpr (!ALIGN_EPI) { if (wr == 0) PG8_BAR; }
    PG8_BAR;
    if constexpr (Epi::AFTER_DRAIN) { E.fused(acc, cur, wr, wc, fr, fq, lds, wid, lane); S.done(cur); }
#undef PG8_SA
#undef PG8_SB
#undef PG8_STAGE
#undef PG8_LDA
#undef PG8_LDB
#undef PG8_MMA
#undef PG8_WAIT_V
#undef PG8_WAIT_L
#undef PG8_BAR
#undef PG8_SCHED
}
}
#ifndef PG8_SP2
#define PG8_SP2 true
#endif
#ifndef PG8_ALIGN
#define PG8_ALIGN true
#endif

namespace mk {
using pg8::bf16_t; using pg8::f32x4; using pg8::u32x4; using pg8::Unit;
#define GAS __attribute__((address_space(1)))
#define LAS __attribute__((address_space(3)))
typedef GAS unsigned gu32;
#define RLX_AGENT __ATOMIC_RELAXED, __HIP_MEMORY_SCOPE_AGENT
#define LDS_WAIT() asm volatile("s_waitcnt lgkmcnt(0)" ::: "memory")
#define VM_WAIT() asm volatile("s_waitcnt vmcnt(0)" ::: "memory")

constexpr int D = 1024, T = 2048, NB = 8, MP = NB * T, SB = 128, ST = 4, MS = SB * ST, MT = MP + MS;
constexpr int INW = 4096, NMEM = 256, XH = 4, XHD = 256, DFF = 2816, PAST = 16384, MMEM = NB * NMEM;
constexpr int PBW = 4096;
constexpr float EPS = 1e-6f;
constexpr int NWAVES = 8;

constexpr size_t MiB = 1u << 20;
constexpr size_t WS_CTL = 0, CTL_ZERO_BYTES = 1 * MiB;
constexpr size_t WS_W_IN = 1 * MiB, WS_W_OUT = 9 * MiB, WS_W_XQ = 11 * MiB, WS_W_KV = 13 * MiB, WS_W_XO = 17 * MiB, WS_W_GU = 19 * MiB, WS_W_DN = 30 * MiB;
constexpr size_t WS_CS = 36 * MiB, WS_LOW = 38 * MiB, WS_RS0 = 39 * MiB, WS_RSM = WS_RS0 + 256 * 1024, WS_ST1 = 40 * MiB, WS_ST2 = 42 * MiB, WS_ST3 = 44 * MiB;
constexpr size_t WS_MB = 46 * MiB, WS_MK = 50 * MiB, WS_MV = 54 * MiB, WS_XB0 = 58 * MiB, WS_PB = 91 * MiB, WS_LF = 223 * MiB, WS_OB = 256 * MiB;
constexpr size_t WS_XB1 = 289 * MiB, WS_Q = 322 * MiB, WS_XB2 = 355 * MiB, WS_ACT = 388 * MiB, WS_END = 479 * MiB;
static_assert(WS_PB + (size_t)MT * PBW * 2 <= WS_LF && WS_LF + (size_t)MT * 512 * 4 <= WS_OB && WS_ACT + (size_t)MT * DFF * 2 <= WS_END, "ws map");
constexpr size_t WS_Y2 = WS_PB, WS_Y3 = WS_LF;
static_assert(WS_Y3 + (size_t)MT * D * 4 <= WS_XB1, "Y3 fits LF|OB");
constexpr size_t WS_SLOC = 479 * MiB, WS_DSEG = 491 * MiB;
constexpr int CW_BAR = 4096;

constexpr int RING_OFF = 0, RING_BYTES = 155648, LDSCTL_OFF = RING_BYTES, MISC_OFF = LDSCTL_OFF + 320, LDS_BYTES = 163840;

typedef float f32x2_t __attribute__((ext_vector_type(2)));
typedef __bf16 bf16x2_t __attribute__((ext_vector_type(2)));
__device__ __forceinline__ unsigned pk_bf16(float lo, float hi) { f32x2_t v = {lo, hi}; bf16x2_t b = __builtin_convertvector(v, bf16x2_t); return __builtin_bit_cast(unsigned, b); }
__device__ __forceinline__ float bf2f(unsigned short h) { return __uint_as_float((unsigned)h << 16); }
__device__ __forceinline__ float silu_f(float x) { return x / (1.f + __expf(-x)); }
__device__ __forceinline__ float sigmoid_f(float x) { return 1.f / (1.f + __expf(-x)); }

__device__ __forceinline__ void sincos_d(double x, double& s, double& c) {
    const double two_over_pi = 0.63661977236758134308;
    const double pio2_hi = 1.57079632673412561417e+00, pio2_lo = 6.07710050650619224932e-11;
    double qd = rint(x * two_over_pi);
    double r = x - qd * pio2_hi; r -= qd * pio2_lo;
    long long q = (long long)qd;
    double r2 = r * r;
    double sp = r * (1.0 + r2 * (-1.0 / 6 + r2 * (1.0 / 120 + r2 * (-1.0 / 5040 + r2 * (1.0 / 362880 + r2 * (-1.0 / 39916800 + r2 * (1.0 / 6227020800.0 + r2 * (-1.0 / 1307674368000.0))))))));
    double cp = 1.0 + r2 * (-0.5 + r2 * (1.0 / 24 + r2 * (-1.0 / 720 + r2 * (1.0 / 40320 + r2 * (-1.0 / 3628800 + r2 * (1.0 / 479001600.0 + r2 * (-1.0 / 87178291200.0 + r2 * (1.0 / 20922789888000.0))))))));
    switch (q & 3) {
        case 0: s = sp; c = cp; break;
        case 1: s = cp; c = -sp; break;
        case 2: s = -sp; c = -cp; break;
        default: s = -cp; c = sp; break;
    }
}
__device__ __forceinline__ float wave_sum(float v) {
#pragma unroll
    for (int o = 1; o < 64; o <<= 1) v += __shfl_xor(v, o);
    return v;
}
#define XB_TMO      128
#define XB_XCNT(j)  (256  + 64 * (j))
#define XB_XSUB(j)  (1280 + 64 * (j))
#define XB_XGEN(j)  (2304 + 64 * (j))
#define XB_TOP      3328
#define XB_TOPGEN   3392
#define XCD_BAR_WORDS 3456
#define XB_SPIN_CAP (1u << 18)

__device__ __forceinline__ unsigned xb_ld(unsigned* p)              { return __hip_atomic_load(p, __ATOMIC_RELAXED, __HIP_MEMORY_SCOPE_AGENT); }
__device__ __forceinline__ unsigned xb_add(unsigned* p, unsigned v) { return __hip_atomic_fetch_add(p, v, __ATOMIC_RELAXED, __HIP_MEMORY_SCOPE_AGENT); }
__device__ __forceinline__ unsigned xb_xcc_id() { return (unsigned)__builtin_amdgcn_s_getreg((3 << 11) | 20) & 0xFu; }
#define XB_SPIN(cond, bar) do { unsigned _sp = 0; while (cond) { __builtin_amdgcn_s_sleep(1); \
    if ((++_sp & 255u) == 0u) { if (xb_ld(&(bar)[XB_TMO])) break; if (_sp > XB_SPIN_CAP) { atomicAdd(&(bar)[XB_TMO], 1u); break; } } } } while (0)

struct XcdBarrier {
    unsigned* bar; unsigned x;
    volatile LAS unsigned* st;
    int wave;
};
__device__ __forceinline__ bool xb_leader(int wave) { return wave == 0 && __builtin_amdgcn_mbcnt_hi(~0u, __builtin_amdgcn_mbcnt_lo(~0u, 0u)) == 0u; }

__device__ __forceinline__ XcdBarrier xcd_barrier_post(unsigned* bar, volatile LAS unsigned* st, int wave) {
    XcdBarrier b; b.bar = bar; b.x = xb_xcc_id(); b.st = st; b.wave = wave;
    if (xb_leader(wave)) (void)xb_add(&bar[XB_XCNT(b.x)], 1u);
    return b;
}
__device__ __forceinline__ void xcd_barrier_complete(unsigned* bar, unsigned x, unsigned& nloc, unsigned& nx) {
    const unsigned G = gridDim.x * gridDim.y * gridDim.z;
    unsigned sum, cnt, mine, sp = 0u;
    for (;;) {
        sum = 0u; cnt = 0u; mine = 0u;
#pragma unroll
        for (unsigned j = 0; j < 16; ++j) { const unsigned c = xb_ld(&bar[XB_XCNT(j)]); sum += c; cnt += (c > 0u) ? 1u : 0u; mine = (j == x) ? c : mine; }
        if (sum == G) break;
        __builtin_amdgcn_s_sleep(1);
        if ((++sp & 255u) == 0u) { if (xb_ld(&bar[XB_TMO])) break; if (sp > XB_SPIN_CAP) { atomicAdd(&bar[XB_TMO], 1u); break; } }
    }
    nloc = mine > 0u ? mine : 1u; nx = cnt > 0u ? cnt : 1u;
}

__device__ __forceinline__ void xcd_barrier(const XcdBarrier& b) {
    asm volatile("s_waitcnt vmcnt(0)" ::: "memory");
    __syncthreads();
    if (xb_leader(b.wave)) {
        unsigned* bar = b.bar;
        __builtin_amdgcn_s_waitcnt(0);
        unsigned nloc = b.st[0], nx = b.st[1];
        if (nloc == 0u) { xcd_barrier_complete(bar, b.x, nloc, nx); b.st[0] = nloc; b.st[1] = nx; }
        const unsigned old = xb_add(&bar[XB_XSUB(b.x)], 1u);
        const unsigned gen = old / nloc;
        if (old + 1u == (gen + 1u) * nloc) {
            __builtin_amdgcn_fence(__ATOMIC_RELEASE, "agent");
            asm volatile("s_waitcnt vmcnt(0)" ::: "memory");
            const unsigned og = xb_add(&bar[XB_TOP], 1u);
            const unsigned tg = og / nx;
            if (og + 1u == (tg + 1u) * nx) xb_add(&bar[XB_TOPGEN], 1u);
            else XB_SPIN(xb_ld(&bar[XB_TOPGEN]) == tg, bar);
            __builtin_amdgcn_fence(__ATOMIC_ACQUIRE, "agent");
            xb_add(&bar[XB_XGEN(b.x)], 1u);
            asm volatile("s_waitcnt vmcnt(0)" ::: "memory");
        } else {
            XB_SPIN(xb_ld(&bar[XB_XGEN(b.x)]) == gen, bar);
            __builtin_amdgcn_fence(__ATOMIC_ACQUIRE, "agent");
            asm volatile("s_waitcnt vmcnt(0)" ::: "memory");
        }
    }
    __syncthreads();
}
struct Args { const float* in[24]; float* out; unsigned char* ws; float inv_freq[64]; int ph_lo, ph_hi, li, pad; };
enum { I_XP = 0, I_XS, I_MEM, I_SRET, I_SHG, I_CK, I_CV, I_GMIX, I_WIN, I_RGAIN, I_HGAIN, I_HGLB, I_WOUT, I_GXA, I_GMEM, I_WXQ, I_WXK, I_WXV, I_WXO, I_GFFN, I_WGATE, I_WUP, I_WDOWN, I_GFINAL };
constexpr size_t O_Y = 0, O_RETP = (size_t)MT * D, O_HGP = O_RETP + (size_t)NB * 4 * 16384, O_MEMK = O_HGP + (size_t)NB * 4 * 16384, O_MEMV = O_MEMK + (size_t)MMEM * D,
                 O_RETS = O_MEMV + (size_t)MMEM * D, O_HGS = O_RETS + (size_t)SB * 4 * 16384;

struct Frame {
    LAS unsigned char* lds; volatile LAS unsigned* MISC; gu32* ctl;
    int wave, vcu, G;
};
__device__ __forceinline__ int lane_id() { return (int)__builtin_amdgcn_mbcnt_hi(~0u, __builtin_amdgcn_mbcnt_lo(~0u, 0u)); }

__device__ __forceinline__ const float* wsrc(int mode, const float* s0, const float* s1, int n) {
    if (mode == 1) { if (n < 1024) { const int blk = n >> 9, h = (n & 511) >> 7, j = n & 127; return s0 + blk * 512 + h * 128 + (j >> 1) + 64 * (j & 1); } return s0 + n; }
    if (mode == 2) return n < 1024 ? s0 + n : s1 + (n - 1024);
    if (mode == 3) { const int jj = (n >> 3) * 4 + (n & 3); return (n & 4) ? s1 + jj : s0 + jj; }
    return s0 + n;
}
__device__ __forceinline__ void transpose_item(int mode, const float* s0, const float* s1, int ldw, const float* g, int K, int nblk, bf16_t* WT, LAS float* scr, int item, int lane) {
    const int kb = item / nblk, nb = item % nblk, k0 = 64 * kb, n0 = 32 * nb;
    const float* colp = wsrc(mode, s0, s1, n0 + (lane & 31));
#pragma unroll 8
    for (int i = 0; i < 32; ++i) { const int kk = 2 * i + (lane >> 5); float v = colp[(size_t)(k0 + kk) * ldw]; if (g) v *= g[k0 + kk]; scr[kk * 33 + (lane & 31)] = v; }
    LDS_WAIT(); asm volatile("" ::: "memory");
    const int c = lane & 7;
#pragma unroll
    for (int j = 0; j < 4; ++j) { const int n = (lane >> 3) + 8 * j; const LAS float* s = scr + (8 * c) * 33 + n;
        u32x4 o; o.x = pk_bf16(s[0 * 33], s[1 * 33]); o.y = pk_bf16(s[2 * 33], s[3 * 33]); o.z = pk_bf16(s[4 * 33], s[5 * 33]); o.w = pk_bf16(s[6 * 33], s[7 * 33]);
        *(GAS u32x4*)(WT + (size_t)(n0 + n) * K + k0 + 8 * c) = o; }
    LDS_WAIT(); asm volatile("" ::: "memory");
}
__device__ __forceinline__ void row_to_bf16(const float* xrow, bf16_t* orow, float* rs, int lane) {
    const GAS f32x4* xr = (const GAS f32x4*)xrow + lane;
    f32x4 v[4]; float s = 0.f;
#pragma unroll
    for (int j = 0; j < 4; ++j) { v[j] = xr[64 * j]; s += (v[j].x * v[j].x + v[j].y * v[j].y) + (v[j].z * v[j].z + v[j].w * v[j].w); }
    s = wave_sum(s);
    if (lane == 0) *rs = rsqrtf(s * (1.f / D) + EPS);
    GAS unsigned long long* o8 = (GAS unsigned long long*)orow + lane;
#pragma unroll
    for (int j = 0; j < 4; ++j) o8[64 * j] = (unsigned long long)pk_bf16(v[j].x, v[j].y) | ((unsigned long long)pk_bf16(v[j].z, v[j].w) << 32);
}
__device__ __forceinline__ void phase_prep(Frame& F, const Args& a) {
    unsigned char* ws = a.ws; const int lane = lane_id(), tid = F.wave * 64 + lane;
    LAS float* scr = (LAS float*)(F.lds + RING_OFF + F.wave * 16384);
    const int gw = F.vcu * NWAVES + F.wave, NGW = F.G * NWAVES;
    constexpr int I0 = (D / 64) * (INW / 32), I1 = (D / 64) * (D / 32), I3 = (D / 64) * (2 * D / 32), I5 = (D / 64) * (2 * DFF / 32), I6 = (DFF / 64) * (D / 32);
    constexpr int NITEMS = I0 + I1 + I1 + I3 + I1 + I5 + I6;
    for (int it = gw; it < NITEMS; it += NGW) {
        int r = it;
        if (r < I0) { transpose_item(1, a.in[I_WIN], nullptr, INW, a.in[I_GMIX], D, INW / 32, (bf16_t*)(ws + WS_W_IN), scr, r, lane); continue; } r -= I0;
        if (r < I1) { transpose_item(0, a.in[I_WOUT], nullptr, D, nullptr, D, D / 32, (bf16_t*)(ws + WS_W_OUT), scr, r, lane); continue; } r -= I1;
        if (r < I1) { transpose_item(0, a.in[I_WXQ], nullptr, D, a.in[I_GXA], D, D / 32, (bf16_t*)(ws + WS_W_XQ), scr, r, lane); continue; } r -= I1;
        if (r < I3) { transpose_item(2, a.in[I_WXK], a.in[I_WXV], D, a.in[I_GMEM], D, 2 * D / 32, (bf16_t*)(ws + WS_W_KV), scr, r, lane); continue; } r -= I3;
        if (r < I1) { transpose_item(0, a.in[I_WXO], nullptr, D, nullptr, D, D / 32, (bf16_t*)(ws + WS_W_XO), scr, r, lane); continue; } r -= I1;
        if (r < I5) { transpose_item(3, a.in[I_WGATE], a.in[I_WUP], DFF, a.in[I_GFFN], D, 2 * DFF / 32, (bf16_t*)(ws + WS_W_GU), scr, r, lane); continue; } r -= I5;
        transpose_item(0, a.in[I_WDOWN], nullptr, D, nullptr, DFF, D / 32, (bf16_t*)(ws + WS_W_DN), scr, r, lane);
    }
    for (int m = gw; m < MT + MMEM; m += NGW) {
        if (m < MP) row_to_bf16(a.in[I_XP] + (size_t)m * D, (bf16_t*)(ws + WS_XB0) + (size_t)m * D, (float*)(ws + WS_RS0) + m, lane);
        else if (m < MT) row_to_bf16(a.in[I_XS] + (size_t)(m - MP) * D, (bf16_t*)(ws + WS_XB0) + (size_t)m * D, (float*)(ws + WS_RS0) + m, lane);
        else row_to_bf16(a.in[I_MEM] + (size_t)(m - MT) * D, (bf16_t*)(ws + WS_MB) + (size_t)(m - MT) * D, (float*)(ws + WS_RSM) + (m - MT), lane);
    }
    float* cs = (float*)(ws + WS_CS);
    for (int e = F.vcu * 512 + tid; e < (T + ST) * 64; e += F.G * 512) {
        const int p = e >> 6, i = e & 63; const int pos = p < T ? p : PAST + (p - T);
        const float ang = (float)pos * a.inv_freq[i];
        double sd, cd; sincos_d((double)ang, sd, cd);
        cs[2 * e] = (float)cd; cs[2 * e + 1] = (float)sd;
    }
    if (F.vcu == 0) {
        const float* lb = a.in[I_HGLB]; float* low = (float*)(ws + WS_LOW);
        const int c = tid; const float x0 = lb[c], x1 = lb[512 + c]; const float m = fmaxf(x0, x1); const float e0 = expf(x0 - m), e1 = expf(x1 - m); low[c] = e0 / (e0 + e1);
    }
}
struct EpiMemKV {
    static constexpr bool PERM = true, AFTER_DRAIN = false;
    const float* rsm; float* outk; float* outv; bf16_t* mk; bf16_t* mv;
    __device__ __forceinline__ void operator()(const f32x4 (&acc)[2][2][4][2], const Unit& u, int wr, int wc, int fr, int fq) const {
        const bool isv = u.pn >= 4; float* of = isv ? outv : outk; bf16_t* ob = isv ? mv : mk;
        const int cn = (u.pn & 3) * 256 + wc * 32 + 8 * fq;
#pragma unroll
        for (int ai = 0; ai < 2; ++ai)
#pragma unroll
            for (int m = 0; m < 4; ++m) { const int row = u.pm * 256 + ai * 128 + wr * 64 + m * 16 + fr; const float rs = rsm[row];
#pragma unroll
                for (int bj = 0; bj < 2; ++bj) { const size_t off = (size_t)row * D + cn + bj * 128;
                    const f32x4 v0 = acc[ai][bj][m][0] * rs, v1 = acc[ai][bj][m][1] * rs;
                    *(f32x4*)(of + off) = v0; *(f32x4*)(of + off + 4) = v1;
                    u32x4 w; w.x = pk_bf16(v0[0], v0[1]); w.y = pk_bf16(v0[2], v0[3]); w.z = pk_bf16(v1[0], v1[1]); w.w = pk_bf16(v1[2], v1[3]);
                    *(u32x4*)(ob + off) = w; } }
    }
};
__device__ __forceinline__ u32x4 pk8(const f32x4& a, const f32x4& b) { u32x4 w; w.x = pk_bf16(a[0], a[1]); w.y = pk_bf16(a[2], a[3]); w.z = pk_bf16(b[0], b[1]); w.w = pk_bf16(b[2], b[3]); return w; }
__device__ __forceinline__ f32x4 silu4(const f32x4& v) { return (f32x4){silu_f(v[0]), silu_f(v[1]), silu_f(v[2]), silu_f(v[3])}; }
__device__ __forceinline__ float row_rs(const float* st, int row) {
    const f32x4* p = (const f32x4*)(st + (size_t)row * 16); const f32x4 a = p[0], b = p[1], c = p[2], d = p[3];
    const float s = ((a[0] + a[1]) + (a[2] + a[3])) + ((b[0] + b[1]) + (b[2] + b[3])) + ((c[0] + c[1]) + (c[2] + c[3])) + ((d[0] + d[1]) + (d[2] + d[3]));
    return rsqrtf(s * (1.f / D) + EPS);
}
__device__ __forceinline__ float scan16(float x) {
    x += __builtin_bit_cast(float, __builtin_amdgcn_update_dpp(0, __builtin_bit_cast(int, x), 0x111, 0xf, 0xf, true));
    x += __builtin_bit_cast(float, __builtin_amdgcn_update_dpp(0, __builtin_bit_cast(int, x), 0x112, 0xf, 0xf, true));
    x += __builtin_bit_cast(float, __builtin_amdgcn_update_dpp(0, __builtin_bit_cast(int, x), 0x114, 0xf, 0xf, true));
    x += __builtin_bit_cast(float, __builtin_amdgcn_update_dpp(0, __builtin_bit_cast(int, x), 0x118, 0xf, 0xf, true));
    return x;
}
struct EpiInProj {
    static constexpr bool PERM = true, AFTER_DRAIN = false;
    const float* rs0; const float* cs; const float* low; const float* rgain; const float* hgain; bf16_t* pb; float* lf;
    __device__ __forceinline__ void operator()(const f32x4 (&acc)[2][2][4][2], const Unit& u, int wr, int wc, int fr, int fq) const {
        const int kind = u.pn >> 1; const int colt = u.pn * 256 + wc * 32 + 8 * fq;
        f32x4 carry[2][2];
#pragma unroll
        for (int x = 0; x < 2; ++x) { carry[x][0] = (f32x4){0.f, 0.f, 0.f, 0.f}; carry[x][1] = (f32x4){0.f, 0.f, 0.f, 0.f}; }
#pragma unroll
        for (int ai = 0; ai < 2; ++ai)
#pragma unroll
            for (int m = 0; m < 4; ++m) {
                const int row = u.pm * 256 + ai * 128 + wr * 64 + m * 16 + fr; const float rs = rs0[row];
                const bool samp = row >= MP; const int t = row & (T - 1); const int pidx = samp ? T + ((row - MP) & 3) : t;
#pragma unroll
                for (int bj = 0; bj < 2; ++bj) {
                    const int c0 = colt + bj * 128;
                    f32x4 v0 = acc[ai][bj][m][0] * rs, v1 = acc[ai][bj][m][1] * rs;
                    if (kind <= 1) {
                        const int h = (c0 & 511) >> 7, i0 = (c0 & 127) >> 1;
                        const f32x4* tp = (const f32x4*)(cs + ((size_t)pidx * 64 + i0) * 2); const f32x4 t0 = tp[0], t1 = tp[1];
                        const float lg = __log2f(1.f - exp2f(-5.f - (float)h)); const float e = (float)((t & 31) + 1);
                        float sc = kind == 0 ? 1.f : 0.08838834764831845f;
                        if (!samp) sc *= exp2f(kind == 0 ? e * lg : -e * lg);
                        f32x4 o0, o1;
                        o0[0] = (v0[0] * t0[0] - v0[1] * t0[1]) * sc; o0[1] = (v0[0] * t0[1] + v0[1] * t0[0]) * sc;
                        o0[2] = (v0[2] * t0[2] - v0[3] * t0[3]) * sc; o0[3] = (v0[2] * t0[3] + v0[3] * t0[2]) * sc;
                        o1[0] = (v1[0] * t1[0] - v1[1] * t1[1]) * sc; o1[1] = (v1[0] * t1[1] + v1[1] * t1[0]) * sc;
                        o1[2] = (v1[2] * t1[2] - v1[3] * t1[3]) * sc; o1[3] = (v1[2] * t1[3] + v1[3] * t1[2]) * sc;
                        *(u32x4*)(pb + (size_t)row * PBW + c0) = pk8(o0, o1);
                    } else if (kind == 2) {
                        *(u32x4*)(pb + (size_t)row * PBW + c0) = pk8(v0, v1);
                    } else if (kind == 3) {
                        const f32x4* gp = (const f32x4*)(rgain + (c0 - 1536));
                        *(u32x4*)(pb + (size_t)row * PBW + c0) = pk8(silu4(v0) * gp[0], silu4(v1) * gp[1]);
                    } else if (kind == 4) {
                        *(u32x4*)(pb + (size_t)row * PBW + c0) = pk8(silu4(v0), silu4(v1));
                    } else if (kind == 5) {
                        const f32x4* lp = (const f32x4*)(low + (c0 - 2560)); const f32x4 l0 = lp[0], l1 = lp[1];
                        f32x4 o0, o1, k0, k1;
#pragma unroll
                        for (int e = 0; e < 4; ++e) { const float s0 = sigmoid_f(v0[e]), s1 = sigmoid_f(v1[e]);
                            o0[e] = __logf(l0[e] + (1.f - l0[e]) * s0); o1[e] = __logf(l1[e] + (1.f - l1[e]) * s1);
                            k0[e] = (1.f - l0[e]) * (1.f - s0); k1[e] = (1.f - l1[e]) * (1.f - s1); }
                        *(u32x4*)(pb + (size_t)row * PBW + 3584 + (c0 - 2560)) = pk8(k0, k1);
                        if (!samp) {
#pragma unroll
                            for (int e = 0; e < 4; ++e) { o0[e] = scan16(o0[e]); o1[e] = scan16(o1[e]); }
                            if (m & 1) { o0 = o0 + carry[bj][0]; o1 = o1 + carry[bj][1]; }
                            else {
#pragma unroll
                                for (int e = 0; e < 4; ++e) { carry[bj][0][e] = __shfl(o0[e], (fq << 4) | 15); carry[bj][1][e] = __shfl(o1[e], (fq << 4) | 15); } }
                        }
                        float* lp2 = lf + (size_t)row * 512 + (c0 - 2560);
                        *(f32x4*)lp2 = o0; *(f32x4*)(lp2 + 4) = o1;
                    } else if (kind == 6) {
                        *(u32x4*)(pb + (size_t)row * PBW + c0 - 512) = pk8(v0, v1);
                    } else {
                        const f32x4* gp = (const f32x4*)(hgain + (c0 - 3584));
                        *(u32x4*)(pb + (size_t)row * PBW + c0 - 512) = pk8(silu4(v0) * gp[0], silu4(v1) * gp[1]);
                    }
                }
            }
    }
};
struct EpiResid {
    static constexpr bool PERM = true, AFTER_DRAIN = false;
    const float* xold_p; const float* xold_s; float* y; bf16_t* xb; float* st;
    __device__ __forceinline__ void operator()(const f32x4 (&acc)[2][2][4][2], const Unit& u, int wr, int wc, int fr, int fq) const {
        const int cn = u.pn * 256 + wc * 32 + 8 * fq;
#pragma unroll
        for (int ai = 0; ai < 2; ++ai)
#pragma unroll
            for (int m = 0; m < 4; ++m) {
                const int row = u.pm * 256 + ai * 128 + wr * 64 + m * 16 + fr;
                const float* xo = row < MP ? xold_p + (size_t)row * D : xold_s + (size_t)(row - MP) * D;
                float ss = 0.f;
#pragma unroll
                for (int bj = 0; bj < 2; ++bj) { const int c = cn + bj * 128;
                    const f32x4 v0 = *(const f32x4*)(xo + c) + acc[ai][bj][m][0], v1 = *(const f32x4*)(xo + c + 4) + acc[ai][bj][m][1];
                    ss += (v0[0] * v0[0] + v0[1] * v0[1]) + (v0[2] * v0[2] + v0[3] * v0[3]) + (v1[0] * v1[0] + v1[1] * v1[1]) + (v1[2] * v1[2] + v1[3] * v1[3]);
                    *(f32x4*)(y + (size_t)row * D + c) = v0; *(f32x4*)(y + (size_t)row * D + c + 4) = v1;
                    *(u32x4*)(xb + (size_t)row * D + c) = pk8(v0, v1); }
                ss += __shfl_xor(ss, 16); ss += __shfl_xor(ss, 32);
                if (fq == 0) st[(size_t)row * 16 + u.pn * 4 + wc] = ss;
            }
    }
};
struct EpiScaleBf16 {
    static constexpr bool PERM = true, AFTER_DRAIN = false;
    const float* st; bf16_t* o; float scale;
    __device__ __forceinline__ void operator()(const f32x4 (&acc)[2][2][4][2], const Unit& u, int wr, int wc, int fr, int fq) const {
        const int cn = u.pn * 256 + wc * 32 + 8 * fq;
#pragma unroll
        for (int ai = 0; ai < 2; ++ai)
#pragma unroll
            for (int m = 0; m < 4; ++m) { const int row = u.pm * 256 + ai * 128 + wr * 64 + m * 16 + fr; const float rs = row_rs(st, row) * scale;
#pragma unroll
                for (int bj = 0; bj < 2; ++bj) *(u32x4*)(o + (size_t)row * D + cn + bj * 128) = pk8(acc[ai][bj][m][0] * rs, acc[ai][bj][m][1] * rs); }
    }
};
struct EpiGateUp {
    static constexpr bool PERM = true, AFTER_DRAIN = false;
    const float* st; bf16_t* act;
    __device__ __forceinline__ void operator()(const f32x4 (&acc)[2][2][4][2], const Unit& u, int wr, int wc, int fr, int fq) const {
        const int jn = u.pn * 128 + wc * 16 + 4 * fq;
#pragma unroll
        for (int ai = 0; ai < 2; ++ai)
#pragma unroll
            for (int m = 0; m < 4; ++m) { const int row = u.pm * 256 + ai * 128 + wr * 64 + m * 16 + fr; const float rs = row_rs(st, row);
#pragma unroll
                for (int bj = 0; bj < 2; ++bj) { const f32x4 g = silu4(acc[ai][bj][m][0] * rs), up = acc[ai][bj][m][1] * rs; const f32x4 a = g * up;
                    unsigned long long w = (unsigned long long)pk_bf16(a[0], a[1]) | ((unsigned long long)pk_bf16(a[2], a[3]) << 32);
                    *(unsigned long long*)(act + (size_t)row * DFF + jn + bj * 64) = w; } }
    }
};
__device__ __forceinline__ void phase_final(Frame& F, const Args& a) {
    const int gw = F.vcu * NWAVES + F.wave, NGW = F.G * NWAVES, lane = lane_id();
    const float* st = (const float*)(a.ws + WS_ST3); const GAS f32x4* g4 = (const GAS f32x4*)a.in[I_GFINAL] + lane;
    for (int m = gw; m < MT; m += NGW) { const float rs = row_rs(st, m); GAS f32x4* yr = (GAS f32x4*)(a.out + O_Y + (size_t)m * D) + lane;
        const GAS f32x4* xr = (const GAS f32x4*)((const float*)(a.ws + WS_Y3) + (size_t)m * D) + lane;
#pragma unroll
        for (int j = 0; j < 4; ++j) yr[64 * j] = xr[64 * j] * rs * g4[64 * j]; }
}
typedef short bf16x8v __attribute__((ext_vector_type(8)));
typedef short s16x4v __attribute__((ext_vector_type(4)));
typedef float f32x16v __attribute__((ext_vector_type(16)));
constexpr int RC_RS = 272;
constexpr int RC_TILE = 32 * RC_RS, RC_BUF = 3 * RC_TILE;
constexpr int RC_ORS = 528, RC_OSZ = 32 * RC_ORS;
constexpr int RC_OOFF = 2 * RC_BUF, RC_EOFF = RC_OOFF + 2 * RC_OSZ, RC_END = RC_EOFF + 2 * 512;
static_assert(RC_END <= RING_BYTES, "recurrence LDS");
__device__ __forceinline__ int crow(int r, int h) { return (r & 3) + 8 * (r >> 2) + 4 * h; }
__device__ __forceinline__ s16x4v tr16(const LAS unsigned char* p) { typedef short v4i16_t __attribute__((ext_vector_type(4))); return __builtin_bit_cast(s16x4v, __builtin_amdgcn_ds_read_tr16_b64_v4i16((LAS v4i16_t*)p)); }
__device__ __forceinline__ bf16x8v cat8(s16x4v lo, s16x4v hi) { return (bf16x8v){lo[0], lo[1], lo[2], lo[3], hi[0], hi[1], hi[2], hi[3]}; }
__device__ __forceinline__ bf16x8v pack_step(const f32x16v& x, int s) {
    u32x4 p; p.x = pk_bf16(x[8 * s], x[8 * s + 1]); p.y = pk_bf16(x[8 * s + 2], x[8 * s + 3]); p.z = pk_bf16(x[8 * s + 4], x[8 * s + 5]); p.w = pk_bf16(x[8 * s + 6], x[8 * s + 7]);
    return __builtin_bit_cast(bf16x8v, p);
}
#define MFMA32(a, b, c) __builtin_amdgcn_mfma_f32_32x32x16_bf16((a), (b), (c), 0, 0, 0)

#define RC_LDS_BARRIER() do { asm volatile("s_waitcnt lgkmcnt(0)" ::: "memory"); __builtin_amdgcn_s_barrier(); asm volatile("" ::: "memory"); } while (0)

__device__ __forceinline__ void st_store_plain(const f32x16v (&S)[4], float* base  ) {
    float* p = base;
#pragma unroll
    for (int dt = 0; dt < 4; ++dt)
#pragma unroll
        for (int gq = 0; gq < 4; ++gq) { asm volatile("" : "+v"(p));
#pragma unroll
            for (int e = 0; e < 4; ++e) p[e * 128] = S[dt][4 * gq + e];
            p += 8 * 128; }
}
__device__ __forceinline__ void st_store_deint(const f32x16v (&S)[4], float* base  ) {
    float* p = base;
#pragma unroll
    for (int dt = 0; dt < 4; ++dt)
#pragma unroll
        for (int gq = 0; gq < 4; ++gq) { asm volatile("" : "+v"(p));
            p[0] = S[dt][4 * gq]; p[64 * 128] = S[dt][4 * gq + 1]; p[128] = S[dt][4 * gq + 2]; p[64 * 128 + 128] = S[dt][4 * gq + 3];
            p += 4 * 128; }
}
__device__ __forceinline__ void st_fold(f32x16v (&S)[4], const float* base  , const float* dg  , float dret) {
    const float* p = base; const float* q = dg;
#pragma unroll
    for (int dt = 0; dt < 4; ++dt)
#pragma unroll
        for (int gq = 0; gq < 4; ++gq) { asm volatile("" : "+v"(p));
            f32x4 dv = (f32x4){dret, dret, dret, dret};
            if (dg) { asm volatile("" : "+v"(q)); dv = *(const f32x4*)q; q += 8; }
#pragma unroll
            for (int e = 0; e < 4; ++e) S[dt][4 * gq + e] = dv[e] * S[dt][4 * gq + e] + p[e * 128];
            p += 8 * 128; }
}
constexpr int NSEG = 4, SEGC = (T / 32) / NSEG;
__device__ __forceinline__ void rec_prompt_unit(Frame& F, const Args& a, int unit, int seg) {
    const int kind = unit >> 5, b = (unit >> 2) & 7, h = unit & 3; const int c0 = seg * SEGC, c1 = c0 + SEGC;
    unsigned char* ws = a.ws;
    const bf16_t* pb = (const bf16_t*)(ws + WS_PB); const float* lf = (const float*)(ws + WS_LF); bf16_t* ob = (bf16_t*)(ws + WS_OB);
    LAS unsigned char* L = F.lds + RING_OFF;
    const int lane = lane_id(), r32 = lane & 31, hh = lane >> 5, g = (lane >> 4) & 1, q4 = (lane & 15) >> 2, p4 = lane & 3;
    const int row_base = b * T;
    const int qcol = kind == 0 ? h * 128 : 2048 + h * 128, kcol = 512 + h * 128, vcol = kind == 0 ? 1024 + h * 128 : 2560 + h * 128, gcol = kind == 0 ? 1536 + h * 128 : 3072 + h * 128;
    const float Eret = exp2f(32.f * __log2f(1.f - exp2f(-5.f - (float)h)));
    const int pt = F.wave * 64 + lane - 256;

    u32x4 pre[6]; f32x4 preb[4]; u32x4 gpre[2];
    const int prow = pt >> 4, pch = pt & 15;
    const bf16_t* pbase = pb + (size_t)(row_base + prow) * PBW + pch * 8;
    const float* lbase = lf + (size_t)(row_base + prow) * 512 + h * 128 + pch * 8;
    const int lofs = prow * RC_RS + pch * 16;
    auto stage_load = [&](int c) {
        const bf16_t* p = pbase + (size_t)32 * c * PBW; asm volatile("" : "+v"(p));
        if (kind == 0) {
#pragma unroll
            for (int j = 0; j < 2; ++j) { pre[j] = *(const u32x4*)(p + (size_t)16 * j * PBW + qcol); pre[2 + j] = *(const u32x4*)(p + (size_t)16 * j * PBW + kcol); pre[4 + j] = *(const u32x4*)(p + (size_t)16 * j * PBW + vcol); }
        } else {
            const float* lp = lbase + (size_t)32 * c * 512; asm volatile("" : "+v"(lp));
#pragma unroll
            for (int j = 0; j < 2; ++j) { pre[j] = *(const u32x4*)(p + (size_t)16 * j * PBW + qcol); pre[2 + j] = *(const u32x4*)(p + (size_t)16 * j * PBW + 3584 + h * 128); pre[4 + j] = *(const u32x4*)(p + (size_t)16 * j * PBW + vcol);
                preb[2 * j] = *(const f32x4*)(lp + (size_t)16 * j * 512); preb[2 * j + 1] = *(const f32x4*)(lp + (size_t)16 * j * 512 + 4); }
        }
    };
    auto stage_write = [&](int c) {
        LAS unsigned char* B = L + (c & 1) * RC_BUF + lofs; asm volatile("" : "+v"(B));
        if (kind == 0) {
#pragma unroll
            for (int j = 0; j < 2; ++j) { *(LAS u32x4*)(B + 16 * j * RC_RS) = pre[j]; *(LAS u32x4*)(B + RC_TILE + 16 * j * RC_RS) = pre[2 + j]; *(LAS u32x4*)(B + 2 * RC_TILE + 16 * j * RC_RS) = pre[4 + j]; }
        } else {
#pragma unroll
            for (int j = 0; j < 2; ++j) {
                u32x4 qo, ko; f32x4 eb[2];
#pragma unroll
                for (int x = 0; x < 2; ++x)
#pragma unroll
                    for (int e = 0; e < 4; ++e) eb[x][e] = exp2f(preb[2 * j + x][e] * 1.4426950408889634f);
#pragma unroll
                for (int e = 0; e < 4; ++e) { const unsigned qw = pre[j][e], kw = pre[2 + j][e];
                    const float e0 = eb[e >> 1][2 * (e & 1)], e1 = eb[e >> 1][2 * (e & 1) + 1];
                    qo[e] = pk_bf16(__uint_as_float(qw << 16) * e0, __uint_as_float(qw & 0xffff0000u) * e1);
                    ko[e] = pk_bf16(__uint_as_float(kw << 16) * __builtin_amdgcn_rcpf(e0), __uint_as_float(kw & 0xffff0000u) * __builtin_amdgcn_rcpf(e1)); }
                *(LAS u32x4*)(B + 16 * j * RC_RS) = qo; *(LAS u32x4*)(B + RC_TILE + 16 * j * RC_RS) = ko; *(LAS u32x4*)(B + 2 * RC_TILE + 16 * j * RC_RS) = pre[4 + j];
                if (j == 1 && prow == 15) { LAS float* Ep = (LAS float*)(L + RC_EOFF + (c & 1) * 512) + pch * 8; *(LAS f32x4*)Ep = eb[0]; *(LAS f32x4*)(Ep + 4) = eb[1]; }
            }
        }
    };
    const int et = pt >> 3, ecg = pt & 7;
    auto gate_load = [&](int c) { const u32x4* gp = (const u32x4*)(pb + (size_t)(row_base + 32 * c + et) * PBW + gcol + ecg * 16); gpre[0] = gp[0]; gpre[1] = gp[1]; };
    auto epilogue = [&](int c) {
        const int row = row_base + 32 * c + et;
        const LAS f32x4* op = (const LAS f32x4*)(L + RC_OOFF + (c & 1) * RC_OSZ + et * RC_ORS + ecg * 64);
        f32x4 o[4]; float ss = 0.f;
#pragma unroll
        for (int j = 0; j < 4; ++j) { o[j] = op[j]; ss += (o[j][0] * o[j][0] + o[j][1] * o[j][1]) + (o[j][2] * o[j][2] + o[j][3] * o[j][3]); }
        ss += __shfl_xor(ss, 1); ss += __shfl_xor(ss, 2); ss += __shfl_xor(ss, 4);
        const float rs = rsqrtf(ss * (1.f / 128.f) + EPS);
        u32x4* dp = (u32x4*)(ob + (size_t)row * D + kind * 512 + h * 128 + ecg * 16);
#pragma unroll
        for (int j = 0; j < 2; ++j) { const u32x4 gw = gpre[j]; u32x4 w;
#pragma unroll
            for (int e = 0; e < 4; ++e) { const float g0 = __uint_as_float(gw[e] << 16), g1 = __uint_as_float(gw[e] & 0xffff0000u);
                const float o0 = o[2 * j + (e >> 1)][2 * (e & 1)], o1 = o[2 * j + (e >> 1)][2 * (e & 1) + 1];
                w[e] = pk_bf16(o0 * rs * g0, o1 * rs * g1); }
            dp[j] = w; }
    };

    if (F.wave >= 4) {
        stage_load(c0); stage_write(c0); stage_load(c0 + 1);
        RC_LDS_BARRIER();
        for (int c = c0; c < c1; ++c) {
            if (c + 1 < c1) { stage_write(c + 1); if (c + 2 < c1) stage_load(c + 2); }
            if (c > c0) epilogue(c - 1);
            gate_load(c);
            RC_LDS_BARRIER();
        }
        epilogue(c1 - 1);
    } else {
        f32x16v S[4];
#pragma unroll
        for (int dt = 0; dt < 4; ++dt)
#pragma unroll
            for (int i = 0; i < 16; ++i) S[dt][i] = 0.f;
        { const float dret = exp2f(512.f * __log2f(1.f - exp2f(-5.f - (float)h)));
          for (int j = 0; j < seg; ++j) {
            const float* sl = (const float*)(ws + WS_SLOC) + (size_t)(unit * 3 + j) * 16384 + (size_t)(4 * hh) * 128 + 32 * F.wave + r32;
            const float* dg = kind == 0 ? nullptr : (const float*)(ws + WS_DSEG) + (size_t)(unit * 3 + j) * 128 + 4 * hh;
            st_fold(S, sl, dg, dret); } }
        RC_LDS_BARRIER();
        for (int c = c0; c < c1; ++c) {
        const int w = F.wave;
        const LAS unsigned char* B = L + (c & 1) * RC_BUF;
        const LAS unsigned char* QE = B; const LAS unsigned char* KE = B + RC_TILE; const LAS unsigned char* V = B + 2 * RC_TILE;
        f32x16v X;
#pragma unroll
        for (int i = 0; i < 16; ++i) X[i] = 0.f;
#pragma unroll
        for (int kk = 0; kk < 8; ++kk) { const bf16x8v ka = *(const LAS bf16x8v*)(KE + r32 * RC_RS + kk * 32 + hh * 16), qb = *(const LAS bf16x8v*)(QE + r32 * RC_RS + kk * 32 + hh * 16);
            X = MFMA32(ka, qb, X); }
#pragma unroll
        for (int i = 0; i < 16; ++i) if (crow(i, hh) > r32) X[i] = 0.f;
        bf16x8v vf[2];
#pragma unroll
        for (int kk = 0; kk < 2; ++kk) { const LAS unsigned char* vp = V + (16 * kk + 4 * hh + q4) * RC_RS + (32 * w + 16 * g + 4 * p4) * 2; vf[kk] = cat8(tr16(vp), tr16(vp + 8 * RC_RS)); }
        f32x16v o;
#pragma unroll
        for (int i = 0; i < 16; ++i) o[i] = 0.f;
#pragma unroll
        for (int kk = 0; kk < 2; ++kk) o = MFMA32(pack_step(X, kk), vf[kk], o);
#pragma unroll
        for (int dt = 0; dt < 4; ++dt)
#pragma unroll
            for (int kk = 0; kk < 2; ++kk) { const LAS unsigned char* qp = QE + r32 * RC_RS + (32 * dt + 16 * kk + 4 * hh) * 2;
                const bf16x8v qa = cat8(*(const LAS s16x4v*)qp, *(const LAS s16x4v*)(qp + 16));
                o = MFMA32(qa, pack_step(S[dt], kk), o); }
        { LAS unsigned char* OB = L + RC_OOFF + (c & 1) * RC_OSZ;
#pragma unroll
          for (int i = 0; i < 16; ++i) *(LAS float*)(OB + crow(i, hh) * RC_ORS + (32 * w + r32) * 4) = o[i]; }
#pragma unroll
        for (int dt = 0; dt < 4; ++dt)
#pragma unroll
            for (int kk = 0; kk < 2; ++kk) { const LAS unsigned char* kp = KE + (16 * kk + 4 * hh + q4) * RC_RS + (32 * dt + 16 * g + 4 * p4) * 2;
                S[dt] = MFMA32(cat8(tr16(kp), tr16(kp + 8 * RC_RS)), vf[kk], S[dt]); }
        if (kind == 0) {
#pragma unroll
            for (int dt = 0; dt < 4; ++dt) S[dt] = S[dt] * Eret;
        } else {
            const LAS unsigned char* EB = L + RC_EOFF + (c & 1) * 512;
#pragma unroll
            for (int dt = 0; dt < 4; ++dt)
#pragma unroll
                for (int gq = 0; gq < 4; ++gq) { const f32x4 e4 = *(const LAS f32x4*)(EB + (32 * dt + 8 * gq + 4 * hh) * 4);
#pragma unroll
                    for (int e = 0; e < 4; ++e) S[dt][4 * gq + e] *= e4[e]; }
        }
            RC_LDS_BARRIER();
        }
        if (seg == NSEG - 1) {
            float* so = a.out + (kind == 0 ? O_RETP : O_HGP) + (size_t)(b * 4 + h) * 16384 + 32 * F.wave + r32;
            if (kind == 0) st_store_deint(S, so + (size_t)(2 * hh) * 128); else st_store_plain(S, so + (size_t)(4 * hh) * 128);
        }
    }
    __syncthreads();
}

__device__ __forceinline__ void rec_state_unit(Frame& F, const Args& a, int unit, int seg) {
    const int kind = unit >> 5, b = (unit >> 2) & 7, h = unit & 3; const int c0 = seg * SEGC, c1 = c0 + SEGC;
    unsigned char* ws = a.ws;
    const bf16_t* pb = (const bf16_t*)(ws + WS_PB); const float* lf = (const float*)(ws + WS_LF);
    LAS unsigned char* L = F.lds + RING_OFF;
    const int lane = lane_id(), r32 = lane & 31, hh = lane >> 5, g = (lane >> 4) & 1, q4 = (lane & 15) >> 2, p4 = lane & 3;
    const int row_base = b * T;
    const int kcol = kind == 0 ? 512 + h * 128 : 3584 + h * 128, vcol = kind == 0 ? 1024 + h * 128 : 2560 + h * 128;
    const float Eret = exp2f(32.f * __log2f(1.f - exp2f(-5.f - (float)h)));
    const int pt = F.wave * 64 + lane - 256;
    if (F.wave >= 4) {
        u32x4 pre[4]; f32x4 preb[4]; f32x4 dacc[2] = {(f32x4){1.f, 1.f, 1.f, 1.f}, (f32x4){1.f, 1.f, 1.f, 1.f}};
        const int prow = pt >> 4, pch = pt & 15;
        const bf16_t* pbase = pb + (size_t)(row_base + prow) * PBW + pch * 8;
        const float* lbase = lf + (size_t)(row_base + prow) * 512 + h * 128 + pch * 8;
        const int lofs = prow * RC_RS + pch * 16;
        auto stage_load = [&](int c) {
            const bf16_t* p = pbase + (size_t)32 * c * PBW; asm volatile("" : "+v"(p));
#pragma unroll
            for (int j = 0; j < 2; ++j) { pre[j] = *(const u32x4*)(p + (size_t)16 * j * PBW + kcol); pre[2 + j] = *(const u32x4*)(p + (size_t)16 * j * PBW + vcol); }
            if (kind == 1) { const float* lp = lbase + (size_t)32 * c * 512; asm volatile("" : "+v"(lp));
#pragma unroll
                for (int j = 0; j < 2; ++j) { preb[2 * j] = *(const f32x4*)(lp + (size_t)16 * j * 512); preb[2 * j + 1] = *(const f32x4*)(lp + (size_t)16 * j * 512 + 4); } }
        };
        auto stage_write = [&](int c) {
            LAS unsigned char* B = L + (c & 1) * RC_BUF + lofs; asm volatile("" : "+v"(B));
#pragma unroll
            for (int j = 0; j < 2; ++j) {
                u32x4 ko = pre[j];
                if (kind == 1) { f32x4 eb[2];
#pragma unroll
                    for (int x = 0; x < 2; ++x)
#pragma unroll
                        for (int e = 0; e < 4; ++e) eb[x][e] = exp2f(preb[2 * j + x][e] * 1.4426950408889634f);
#pragma unroll
                    for (int e = 0; e < 4; ++e) { const unsigned kw = pre[j][e]; const float e0 = eb[e >> 1][2 * (e & 1)], e1 = eb[e >> 1][2 * (e & 1) + 1];
                        ko[e] = pk_bf16(__uint_as_float(kw << 16) * __builtin_amdgcn_rcpf(e0), __uint_as_float(kw & 0xffff0000u) * __builtin_amdgcn_rcpf(e1)); }
                    if (j == 1 && prow == 15) { LAS float* Ep = (LAS float*)(L + RC_EOFF + (c & 1) * 512) + pch * 8; *(LAS f32x4*)Ep = eb[0]; *(LAS f32x4*)(Ep + 4) = eb[1]; dacc[0] = dacc[0] * eb[0]; dacc[1] = dacc[1] * eb[1]; }
                }
                *(LAS u32x4*)(B + RC_TILE + 16 * j * RC_RS) = ko; *(LAS u32x4*)(B + 2 * RC_TILE + 16 * j * RC_RS) = pre[2 + j];
            }
        };
        stage_load(c0); stage_write(c0); stage_load(c0 + 1);
        RC_LDS_BARRIER();
        for (int c = c0; c < c1; ++c) {
            if (c + 1 < c1) { stage_write(c + 1); if (c + 2 < c1) stage_load(c + 2); }
            RC_LDS_BARRIER();
        }
        if (kind == 1 && prow == 15) { float* dg = (float*)(ws + WS_DSEG) + (size_t)(unit * 3 + seg) * 128 + pch * 8; *(f32x4*)dg = dacc[0]; *(f32x4*)(dg + 4) = dacc[1]; }
    } else {
        f32x16v S[4];
#pragma unroll
        for (int dt = 0; dt < 4; ++dt)
#pragma unroll
            for (int i = 0; i < 16; ++i) S[dt][i] = 0.f;
        RC_LDS_BARRIER();
        const int w = F.wave;
        for (int c = c0; c < c1; ++c) {
            const LAS unsigned char* B = L + (c & 1) * RC_BUF;
            const LAS unsigned char* KE = B + RC_TILE; const LAS unsigned char* V = B + 2 * RC_TILE;
            bf16x8v vf[2];
#pragma unroll
            for (int kk = 0; kk < 2; ++kk) { const LAS unsigned char* vp = V + (16 * kk + 4 * hh + q4) * RC_RS + (32 * w + 16 * g + 4 * p4) * 2; vf[kk] = cat8(tr16(vp), tr16(vp + 8 * RC_RS)); }
#pragma unroll
            for (int dt = 0; dt < 4; ++dt)
#pragma unroll
                for (int kk = 0; kk < 2; ++kk) { const LAS unsigned char* kp = KE + (16 * kk + 4 * hh + q4) * RC_RS + (32 * dt + 16 * g + 4 * p4) * 2;
                    S[dt] = MFMA32(cat8(tr16(kp), tr16(kp + 8 * RC_RS)), vf[kk], S[dt]); }
            if (kind == 0) {
#pragma unroll
                for (int dt = 0; dt < 4; ++dt) S[dt] = S[dt] * Eret;
            } else {
                const LAS unsigned char* EB = L + RC_EOFF + (c & 1) * 512;
#pragma unroll
                for (int dt = 0; dt < 4; ++dt)
#pragma unroll
                    for (int gq = 0; gq < 4; ++gq) { const f32x4 e4 = *(const LAS f32x4*)(EB + (32 * dt + 8 * gq + 4 * hh) * 4);
#pragma unroll
                        for (int e = 0; e < 4; ++e) S[dt][4 * gq + e] *= e4[e]; }
            }
            RC_LDS_BARRIER();
        }
        st_store_plain(S, (float*)(ws + WS_SLOC) + (size_t)(unit * 3 + seg) * 16384 + (size_t)(4 * hh) * 128 + 32 * w + r32);
    }
    __syncthreads();
}
constexpr int SR_DQK = 0, SR_OPART = 8192, SR_RED = SR_OPART + 16384, SR_END = SR_RED + 64;
__device__ __forceinline__ void rec_sample_item(Frame& F, const Args& a, int item) {
    const int kind = item >> 9, bh = item & 511, b = bh >> 2, h = bh & 3;
    unsigned char* ws = a.ws;
    const bf16_t* pb = (const bf16_t*)(ws + WS_PB); const float* lf = (const float*)(ws + WS_LF); bf16_t* ob = (bf16_t*)(ws + WS_OB);
    LAS unsigned char* L = F.lds + RING_OFF;
    LAS float* DEC = (LAS float*)(L + SR_DQK); LAS float* KK = DEC + 512; LAS float* QQ = KK + 512;
    const int lane = lane_id(), w = F.wave, rp = lane >> 5, e4 = (lane & 31) * 4, tid_ = w * 64 + lane;
    const int vcol = kind == 0 ? 1024 + h * 128 : 2560 + h * 128, gcol = kind == 0 ? 1536 + h * 128 : 3072 + h * 128;
    const float* s0 = a.in[kind == 0 ? I_SRET : I_SHG] + (size_t)bh * 16384;
    float* so = a.out + (kind == 0 ? O_RETS : O_HGS) + (size_t)bh * 16384;
    f32x4 S[8];
#pragma unroll
    for (int i = 0; i < 8; ++i) S[i] = *(const f32x4*)(s0 + (size_t)(16 * w + 2 * i + rp) * 128 + e4);
    const int tt = tid_ >> 7, d = tid_ & 127; const size_t rowt = (size_t)MP + b * 4 + tt;
    {
        float dec, k, q;
        if (kind == 0) { const int dp = d < 64 ? 2 * d : 2 * (d - 64) + 1; q = bf2f(pb[rowt * PBW + h * 128 + dp]); k = bf2f(pb[rowt * PBW + 512 + h * 128 + dp]); dec = 1.f - exp2f(-5.f - (float)h); }
        else { const float f = __expf(lf[rowt * 512 + h * 128 + d]); dec = f; k = 1.f - f; q = bf2f(pb[rowt * PBW + 2048 + h * 128 + d]); }
        DEC[tt * 128 + d] = dec; KK[tt * 128 + d] = k; QQ[tt * 128 + d] = q;
    }
    f32x4 v4[4];
#pragma unroll
    for (int t = 0; t < 4; ++t) { const unsigned long long u = *(const unsigned long long*)(pb + ((size_t)MP + b * 4 + t) * PBW + vcol + e4);
        v4[t] = (f32x4){__uint_as_float((unsigned)u << 16), __uint_as_float((unsigned)u & 0xffff0000u), __uint_as_float((unsigned)(u >> 32) << 16), __uint_as_float((unsigned)(u >> 32) & 0xffff0000u)}; }
    __syncthreads();
#pragma unroll
    for (int t = 0; t < 4; ++t) {
        f32x4 o = {0.f, 0.f, 0.f, 0.f};
#pragma unroll
        for (int i = 0; i < 8; ++i) { const int dd = t * 128 + 16 * w + 2 * i + rp; const float dec = DEC[dd], k = KK[dd], q = QQ[dd];
            S[i] = S[i] * dec + v4[t] * k; o += S[i] * q; }
#pragma unroll
        for (int e = 0; e < 4; ++e) o[e] += __shfl_xor(o[e], 32);
        if (rp == 0) *(LAS f32x4*)(L + SR_OPART + ((w * 4 + t) * 128 + e4) * 4) = o;
    }
#pragma unroll
    for (int i = 0; i < 8; ++i) *(f32x4*)(so + (size_t)(16 * w + 2 * i + rp) * 128 + e4) = S[i];
    __syncthreads();
    {
        const int e = d; float o = 0.f;
#pragma unroll
        for (int ww = 0; ww < 8; ++ww) o += *(const LAS float*)(L + SR_OPART + ((ww * 4 + tt) * 128 + e) * 4);
        float ss = wave_sum(o * o);
        LAS float* RED = (LAS float*)(L + SR_RED);
        if (lane == 0) RED[w] = ss;
        __syncthreads();
        ss = RED[w & ~1] + RED[w | 1];
        const float rs = rsqrtf(ss * (1.f / 128.f) + EPS);
        const float val = o * rs * bf2f(pb[rowt * PBW + gcol + e]);
        const float other = __shfl_xor(val, 1);
        if ((e & 1) == 0) *(unsigned*)(ob + rowt * D + kind * 512 + h * 128 + e) = pk_bf16(val, other);
    }
    __syncthreads();
}
constexpr int AT_KRS = 528, AT_VRS = 272, AT_STAGE = 69632, AT_SCR = 2 * AT_STAGE, AT_END = AT_SCR + 1024;
static_assert(128 * AT_KRS <= AT_STAGE && 256 * AT_VRS <= AT_STAGE && AT_END <= RING_BYTES, "attention LDS");
template <int N> struct IC { static constexpr int value = N; };

__device__ __forceinline__ void attn_prompt_unit(Frame& F, const Args& a, int unit) {
    const int b = unit >> 5, head = (unit >> 3) & 3, qb = unit & 7;
    unsigned char* ws = a.ws;
    const bf16_t* Q = (const bf16_t*)(ws + WS_Q); const bf16_t* MK = (const bf16_t*)(ws + WS_MK); const bf16_t* MV = (const bf16_t*)(ws + WS_MV); bf16_t* O = (bf16_t*)(ws + WS_OB);
    LAS unsigned char* L = F.lds + RING_OFF;
    const int lane = lane_id(), w = F.wave, r32 = lane & 31, hh = lane >> 5, g = (lane >> 4) & 1, q4 = (lane & 15) >> 2, p4 = lane & 3, tid = w * 64 + lane;
    const int qrow0 = b * T + qb * 256 + w * 32;
    const bf16_t* qp = Q + (size_t)(qrow0 + r32) * D + head * XHD + 8 * hh;
    u32x4 ld[8];
    const bf16_t* kg = MK + (size_t)(b * NMEM + (tid >> 5)) * D + head * XHD + (tid & 31) * 8;
    const bf16_t* vg = MV + (size_t)(b * NMEM + (tid >> 4)) * D + head * XHD + (tid & 15) * 8;
    const int kl = (tid >> 5) * AT_KRS + (tid & 31) * 16, vl = (tid >> 4) * AT_VRS + (tid & 15) * 16;
    auto load_k = [&](int kh) { const bf16_t* p = kg + (size_t)kh * 128 * D; asm volatile("" : "+v"(p));
#pragma unroll
        for (int j = 0; j < 8; ++j) ld[j] = *(const u32x4*)(p + (size_t)j * 16 * D); };
    auto write_k = [&](int buf) { LAS unsigned char* p = L + buf * AT_STAGE + kl; asm volatile("" : "+v"(p));
#pragma unroll
        for (int j = 0; j < 8; ++j) *(LAS u32x4*)(p + j * 16 * AT_KRS) = ld[j]; };
    auto load_v = [&](int eh) { const bf16_t* p = vg + eh * 128; asm volatile("" : "+v"(p));
#pragma unroll
        for (int j = 0; j < 8; ++j) ld[j] = *(const u32x4*)(p + (size_t)j * 32 * D); };
    auto write_v = [&](int buf) { LAS unsigned char* p = L + buf * AT_STAGE + vl; asm volatile("" : "+v"(p));
#pragma unroll
        for (int j = 0; j < 8; ++j) *(LAS u32x4*)(p + j * 32 * AT_VRS) = ld[j]; };
    f32x16v Sc[8];
#pragma unroll
    for (int m = 0; m < 8; ++m)
#pragma unroll
        for (int i = 0; i < 16; ++i) Sc[m][i] = 0.f;
    auto pass1 = [&](auto KH, int buf) {
        constexpr int kh = decltype(KH)::value;
        const LAS unsigned char* B = L + buf * AT_STAGE + r32 * AT_KRS + 16 * hh;
#pragma unroll
        for (int kb = 0; kb < 4; ++kb) {
            bf16x8v qf[4];
#pragma unroll
            for (int k8 = 0; k8 < 4; ++k8) qf[k8] = *(const bf16x8v*)(qp + 16 * (4 * kb + k8));
#pragma unroll
            for (int k8 = 0; k8 < 4; ++k8)
#pragma unroll
                for (int mt = 0; mt < 4; ++mt) { const bf16x8v kf = *(const LAS bf16x8v*)(B + 32 * mt * AT_KRS + 32 * (4 * kb + k8));
                    Sc[4 * kh + mt] = MFMA32(kf, qf[k8], Sc[4 * kh + mt]); }
        }
    };
    load_k(0); write_k(0); __syncthreads();
    load_k(1); pass1(IC<0>{}, 0); write_k(1); __syncthreads();
    pass1(IC<1>{}, 1);
    load_v(0);
    float mx = Sc[0][0];
#pragma unroll
    for (int m = 0; m < 8; ++m)
#pragma unroll
        for (int i = 0; i < 16; ++i) mx = fmaxf(mx, Sc[m][i]);
    mx = fmaxf(mx, __shfl_xor(mx, 32));
    const float ml = mx * 1.4426950408889634f; float sum = 0.f;
    bf16x8v Pp[8][2];
#pragma unroll
    for (int m = 0; m < 8; ++m) {
#pragma unroll
        for (int i = 0; i < 16; ++i) { const float p = exp2f(Sc[m][i] * 1.4426950408889634f - ml); Sc[m][i] = p; sum += p; }
        Pp[m][0] = pack_step(Sc[m], 0); Pp[m][1] = pack_step(Sc[m], 1);
        asm volatile("" : "+v"(Pp[m][0]), "+v"(Pp[m][1]));
    }
    sum += __shfl_xor(sum, 32);
    LAS float* scr = (LAS float*)(L + AT_SCR) + w * 32;
    if (hh == 0) scr[r32] = 1.f / sum;
    write_v(0); __syncthreads();
    auto pass2 = [&](int eh, int buf) {
        f32x16v Oa[4];
#pragma unroll
        for (int et = 0; et < 4; ++et)
#pragma unroll
            for (int i = 0; i < 16; ++i) Oa[et][i] = 0.f;
        const LAS unsigned char* B = L + buf * AT_STAGE + (4 * hh + q4) * AT_VRS + (16 * g + 4 * p4) * 2;
#pragma unroll
        for (int mt = 0; mt < 8; ++mt)
#pragma unroll
            for (int kk = 0; kk < 2; ++kk)
#pragma unroll
                for (int et = 0; et < 4; ++et) { const LAS unsigned char* vp = B + (32 * mt + 16 * kk) * AT_VRS + 64 * et;
                    Oa[et] = MFMA32(Pp[mt][kk], cat8(tr16(vp), tr16(vp + 8 * AT_VRS)), Oa[et]); }
        f32x4 inv[4];
#pragma unroll
        for (int gq = 0; gq < 4; ++gq) inv[gq] = *(const LAS f32x4*)(scr + 8 * gq + 4 * hh);
#pragma unroll
        for (int et = 0; et < 4; ++et)
#pragma unroll
            for (int i = 0; i < 16; ++i) { const float val = Oa[et][i] * inv[i >> 2][i & 3]; const float other = __shfl_xor(val, 1);
                if (((lane ^ i) & 1) == 0) { const int row = qrow0 + crow(i, hh), col = head * XHD + 128 * eh + 32 * et + (r32 & ~1);
                    *(unsigned*)(O + (size_t)row * D + col) = (lane & 1) ? pk_bf16(other, val) : pk_bf16(val, other); } }
    };
    load_v(1); pass2(0, 0); write_v(1); __syncthreads();
    pass2(1, 1);
    __syncthreads();
}

constexpr int AS_SC = 0, AS_PL = 4096, AS_OPART = 8192, AS_END = AS_OPART + 32768;
__device__ __forceinline__ f32x4 bf4_to_f32(unsigned long long u) {
    return (f32x4){__uint_as_float((unsigned)u << 16), __uint_as_float((unsigned)u & 0xffff0000u), __uint_as_float((unsigned)(u >> 32) << 16), __uint_as_float((unsigned)(u >> 32) & 0xffff0000u)};
}
__device__ __forceinline__ void attn_sample_item(Frame& F, const Args& a, int item) {
    const int b = item >> 2, head = item & 3;
    unsigned char* ws = a.ws;
    const bf16_t* Q = (const bf16_t*)(ws + WS_Q); bf16_t* O = (bf16_t*)(ws + WS_OB);
    const float* Kf = a.in[I_CK] + ((size_t)b * NMEM * XH + head) * XHD; const float* Vf = a.in[I_CV] + ((size_t)b * NMEM * XH + head) * XHD;
    LAS unsigned char* L = F.lds + RING_OFF;
    const int lane = lane_id(), w = F.wave, tid = w * 64 + lane;
    f32x4 q4v[4];
#pragma unroll
    for (int t = 0; t < 4; ++t) q4v[t] = bf4_to_f32(*(const unsigned long long*)(Q + ((size_t)MP + 4 * b + t) * D + head * XHD + 4 * lane));
    float r64[64], r32v[32], r16[16], r8[8], r4[4], r2[2];
#pragma unroll
    for (int pr = 0; pr < 2; ++pr) {
        float pa[32], pbv[32];
#pragma unroll
        for (int half = 0; half < 2; ++half) {
            f32x4 k4[8];
#pragma unroll
            for (int jj = 0; jj < 8; ++jj) k4[jj] = *(const f32x4*)(Kf + (size_t)(32 * w + 16 * half + 8 * pr + jj) * (XH * XHD) + 4 * lane);
#pragma unroll
            for (int jj = 0; jj < 8; ++jj)
#pragma unroll
                for (int t = 0; t < 4; ++t) { const float dv = (q4v[t][0] * k4[jj][0] + q4v[t][1] * k4[jj][1]) + (q4v[t][2] * k4[jj][2] + q4v[t][3] * k4[jj][3]);
                    if (half == 0) pa[jj * 4 + t] = dv; else pbv[jj * 4 + t] = dv; }
        }
        const bool bit = lane & 32;
#pragma unroll
        for (int i = 0; i < 32; ++i) { const float keep = bit ? pbv[i] : pa[i], send = bit ? pa[i] : pbv[i]; r64[32 * pr + i] = keep + __shfl_xor(send, 32); }
    }
    { const bool bit = lane & 16;
#pragma unroll
      for (int i = 0; i < 32; ++i) { const float keep = bit ? r64[i + 32] : r64[i], send = bit ? r64[i] : r64[i + 32]; r32v[i] = keep + __shfl_xor(send, 16); } }
    { const bool bit = lane & 8;
#pragma unroll
      for (int i = 0; i < 16; ++i) { const float keep = bit ? r32v[i + 16] : r32v[i], send = bit ? r32v[i] : r32v[i + 16]; r16[i] = keep + __shfl_xor(send, 8); } }
    { const bool bit = lane & 4;
#pragma unroll
      for (int i = 0; i < 8; ++i) { const float keep = bit ? r16[i + 8] : r16[i], send = bit ? r16[i] : r16[i + 8]; r8[i] = keep + __shfl_xor(send, 4); } }
    { const bool bit = lane & 2;
#pragma unroll
      for (int i = 0; i < 4; ++i) { const float keep = bit ? r8[i + 4] : r8[i], send = bit ? r8[i] : r8[i + 4]; r4[i] = keep + __shfl_xor(send, 2); } }
    { const bool bit = lane & 1;
#pragma unroll
      for (int i = 0; i < 2; ++i) { const float keep = bit ? r4[i + 2] : r4[i], send = bit ? r4[i] : r4[i + 2]; r2[i] = keep + __shfl_xor(send, 1); } }
    { LAS float* SC = (LAS float*)(L + AS_SC); const int m = 32 * w + (lane >> 1), t0 = 2 * (lane & 1); SC[t0 * 256 + m] = r2[0]; SC[(t0 + 1) * 256 + m] = r2[1]; }
    __syncthreads();
    if (w < 4) {
        const f32x4 s4 = *(const LAS f32x4*)(L + AS_SC + (w * 256 + 4 * lane) * 4);
        float mx = fmaxf(fmaxf(s4[0], s4[1]), fmaxf(s4[2], s4[3]));
#pragma unroll
        for (int o = 1; o < 64; o <<= 1) mx = fmaxf(mx, __shfl_xor(mx, o));
        f32x4 p; float sum = 0.f;
#pragma unroll
        for (int e = 0; e < 4; ++e) { p[e] = __expf(s4[e] - mx); sum += p[e]; }
        sum = wave_sum(sum); const float inv = 1.f / sum;
        LAS float* PL = (LAS float*)(L + AS_PL);
#pragma unroll
        for (int e = 0; e < 4; ++e) PL[(4 * lane + e) * 4 + w] = p[e] * inv;
    }
    __syncthreads();
    f32x4 acc[4];
#pragma unroll
    for (int t = 0; t < 4; ++t) acc[t] = (f32x4){0.f, 0.f, 0.f, 0.f};
#pragma unroll
    for (int grp = 0; grp < 4; ++grp) {
        f32x4 v4[8];
#pragma unroll
        for (int jj = 0; jj < 8; ++jj) v4[jj] = *(const f32x4*)(Vf + (size_t)(32 * w + 8 * grp + jj) * (XH * XHD) + 4 * lane);
#pragma unroll
        for (int jj = 0; jj < 8; ++jj) { const f32x4 p4v = *(const LAS f32x4*)(L + AS_PL + (32 * w + 8 * grp + jj) * 16);
#pragma unroll
            for (int t = 0; t < 4; ++t) acc[t] += v4[jj] * p4v[t]; }
    }
#pragma unroll
    for (int t = 0; t < 4; ++t) *(LAS f32x4*)(L + AS_OPART + ((w * 4 + t) * 256 + 4 * lane) * 4) = acc[t];
    __syncthreads();
    { const int t = tid >> 7, c2 = (tid & 127) * 2; float o0 = 0.f, o1 = 0.f;
#pragma unroll
      for (int ww = 0; ww < 8; ++ww) { const f32x2_t v = *(const LAS f32x2_t*)(L + AS_OPART + ((ww * 4 + t) * 256 + c2) * 4); o0 += v[0]; o1 += v[1]; }
      *(unsigned*)(O + ((size_t)MP + 4 * b + t) * D + head * XHD + c2) = pk_bf16(o0, o1); }
    __syncthreads();
}
constexpr int MU_SLAB = 32 * 64 * 4;
template <class G>
__device__ __forceinline__ void mini_unit(Frame& F, const bf16_t* __restrict__ A, const bf16_t* __restrict__ Wt, int K, int unit, const G& gran) {
    const int rb = unit >> 4, cb = unit & 15;
    const int lane = lane_id(), w = F.wave, r32 = lane & 31, hh = lane >> 5, ct = w & 1, ks = w >> 1;
    LAS unsigned char* L = F.lds + RING_OFF;
    const int kq = K >> 2;
    const bf16_t* ap = A + (size_t)(MP + 32 * rb + r32) * K + ks * kq + 8 * hh;
    const bf16_t* wp = Wt + (size_t)(64 * cb + 32 * ct + r32) * K + ks * kq + 8 * hh;
    f32x16v acc;
#pragma unroll
    for (int i = 0; i < 16; ++i) acc[i] = 0.f;
    for (int k0 = 0; k0 < kq; k0 += 128) {
        bf16x8v af[8], wf[8];
#pragma unroll
        for (int j = 0; j < 8; ++j) { const int k = k0 + 16 * j; if (k < kq) { af[j] = *(const bf16x8v*)(ap + k); wf[j] = *(const bf16x8v*)(wp + k); } }
#pragma unroll
        for (int j = 0; j < 8; ++j) { const int k = k0 + 16 * j; if (k < kq) acc = MFMA32(wf[j], af[j], acc); }
    }
    { LAS float* C = (LAS float*)(L + ks * MU_SLAB) + r32 * 64 + 32 * ct;
#pragma unroll
      for (int gq = 0; gq < 4; ++gq) *(LAS f32x4*)(C + 8 * gq + 4 * hh) = (f32x4){acc[4 * gq], acc[4 * gq + 1], acc[4 * gq + 2], acc[4 * gq + 3]}; }
    __syncthreads();
    { const int tid = w * 64 + lane, m = tid >> 4, g = tid & 15;
      const LAS f32x4* C = (const LAS f32x4*)(L + (m * 64 + 4 * g) * 4);
      const f32x4 v = (C[0] + C[MU_SLAB / 16]) + (C[2 * MU_SLAB / 16] + C[3 * MU_SLAB / 16]);
      gran(MP + 32 * rb + m, 64 * cb + 4 * g, v, cb, g); }
    __syncthreads();
}
struct GranResid {
    const float* xold_s; float* y; bf16_t* xb; float* st;
    __device__ __forceinline__ void operator()(int row, int col, const f32x4& acc, int cb, int g) const {
        const f32x4 v = *(const f32x4*)(xold_s + (size_t)(row - MP) * D + col) + acc;
        *(f32x4*)(y + (size_t)row * D + col) = v;
        *(unsigned long long*)(xb + (size_t)row * D + col) = (unsigned long long)pk_bf16(v[0], v[1]) | ((unsigned long long)pk_bf16(v[2], v[3]) << 32);
        float ss = (v[0] * v[0] + v[1] * v[1]) + (v[2] * v[2] + v[3] * v[3]);
        ss += __shfl_xor(ss, 1); ss += __shfl_xor(ss, 2); ss += __shfl_xor(ss, 4); ss += __shfl_xor(ss, 8);
        if (g == 0) st[(size_t)row * 16 + cb] = ss;
    }
};
struct GranScale {
    const float* st; bf16_t* o; float scale;
    __device__ __forceinline__ void operator()(int row, int col, const f32x4& acc, int, int) const {
        const float rs = row_rs(st, row) * scale;
        *(unsigned long long*)(o + (size_t)row * D + col) = (unsigned long long)pk_bf16(acc[0] * rs, acc[1] * rs) | ((unsigned long long)pk_bf16(acc[2] * rs, acc[3] * rs) << 32);
    }
};
#define IN_REC(lo, hi) ((lo) <= 2 && 2 < (hi))
#ifndef DUP_PHASE
#define DUP_PHASE (-1)
#endif
enum { PH_PREP = 0, PH_INPROJ = 1, PH_REC = 2, PH_OUTPROJ = 3, PH_XQ = 4, PH_ATTN = 5, PH_XO = 6, PH_GU = 7, PH_DOWN = 8, PH_FINAL = 9, PH_MEMKV = 10, PH_COUNT = 11 };

__global__ void __launch_bounds__(NWAVES * 64, 2) mega(Args args) {
    extern __shared__ __attribute__((aligned(16))) unsigned char lds[];
    Frame F;
    F.lds = (LAS unsigned char*)lds; F.MISC = (volatile LAS unsigned*)(F.lds + MISC_OFF);
    F.wave = __builtin_amdgcn_readfirstlane((int)threadIdx.x >> 6);
    F.G = gridDim.x; { const int bx = blockIdx.x; F.vcu = (F.G % 8 == 0) ? (bx % 8) * (F.G / 8) + bx / 8 : bx; }
    unsigned char* ws = args.ws;
    F.ctl = (gu32*)(ws + WS_CTL);
    for (int u = (int)threadIdx.x; u < (LDS_BYTES - LDSCTL_OFF) / 4; u += NWAVES * 64) ((LAS unsigned*)(F.lds + LDSCTL_OFF))[u] = 0u;
    __syncthreads();
    const int lo = args.ph_lo, hi = args.ph_hi;
    XcdBarrier bar; bar.bar = (unsigned*)(F.ctl + CW_BAR) + args.li * XCD_BAR_WORDS; bar.x = 0; bar.st = nullptr; bar.wave = F.wave;
    if (hi - lo > 1 || IN_REC(lo, hi)) bar = xcd_barrier_post((unsigned*)(F.ctl + CW_BAR) + args.li * XCD_BAR_WORDS, F.MISC + 8, F.wave);
#define IN(k) (lo <= (k) && (k) < hi)
#define BOTH(k) (IN(k) && IN((k) + 1))
    if (IN(PH_PREP)) for (int rep = 0; rep < (DUP_PHASE == PH_PREP ? 2 : 1); ++rep) { phase_prep(F, args); if (BOTH(PH_PREP) || rep + 1 < (DUP_PHASE == PH_PREP ? 2 : 1)) xcd_barrier(bar); }
    if (IN(PH_INPROJ)) for (int rep = 0; rep < (DUP_PHASE == PH_INPROJ ? 2 : 1); ++rep) {
        pg8::Gemm g{(const bf16_t*)(ws + WS_XB0), (const bf16_t*)(ws + WS_W_IN), MT, INW, D};
        pg8::StaticOrder S; S.init(MT, INW, F.G, (int)blockIdx.x);
        EpiInProj E{(const float*)(ws + WS_RS0), (const float*)(ws + WS_CS), (const float*)(ws + WS_LOW), args.in[I_RGAIN], args.in[I_HGAIN], (bf16_t*)(ws + WS_PB), (float*)(ws + WS_LF)};
        pg8::gemm_phase<EpiInProj, pg8::StaticOrder, PG8_ALIGN, PG8_SP2>(F.lds + RING_OFF, g, S, E, F.wave);
        {
            pg8::Gemm g2{(const bf16_t*)(ws + WS_MB), (const bf16_t*)(ws + WS_W_KV), MMEM, 2 * D, D};
            pg8::StaticOrder S2; S2.init(MMEM, 2 * D, F.G, F.G - 1 - (int)blockIdx.x);
            EpiMemKV E2{(const float*)(ws + WS_RSM), args.out + O_MEMK, args.out + O_MEMV, (bf16_t*)(ws + WS_MK), (bf16_t*)(ws + WS_MV)};
            pg8::gemm_phase<EpiMemKV, pg8::StaticOrder, PG8_ALIGN, PG8_SP2>(F.lds + RING_OFF, g2, S2, E2, F.wave);
        }
        if (BOTH(PH_INPROJ) || rep + 1 < (DUP_PHASE == PH_INPROJ ? 2 : 1)) xcd_barrier(bar);
    }
    if (IN(PH_REC)) for (int rep = 0; rep < (DUP_PHASE == PH_REC ? 2 : 1); ++rep) {
        { const int bid = (int)blockIdx.x;
          for (int u = bid; u < 192; u += F.G) rec_state_unit(F, args, u / 3, u % 3);
          for (int it = bid; it < 1024; it += F.G) rec_sample_item(F, args, it);
          xcd_barrier(bar);
          for (int u = bid; u < 256; u += F.G) rec_prompt_unit(F, args, u >> 2, u & 3); }
        if (BOTH(PH_REC) || rep + 1 < (DUP_PHASE == PH_REC ? 2 : 1)) xcd_barrier(bar);
    }
    if (IN(PH_OUTPROJ)) for (int rep = 0; rep < (DUP_PHASE == PH_OUTPROJ ? 2 : 1); ++rep) {
        pg8::Gemm g{(const bf16_t*)(ws + WS_OB), (const bf16_t*)(ws + WS_W_OUT), MP, D, D};
        pg8::StaticOrder S; S.init(MP, D, F.G, (int)blockIdx.x);
        EpiResid E{args.in[I_XP], args.in[I_XS], args.out + O_Y, (bf16_t*)(ws + WS_XB1), (float*)(ws + WS_ST1)};
        pg8::gemm_phase<EpiResid, pg8::StaticOrder, PG8_ALIGN, PG8_SP2>(F.lds + RING_OFF, g, S, E, F.wave);
        { GranResid Gm{args.in[I_XS], args.out + O_Y, (bf16_t*)(ws + WS_XB1), (float*)(ws + WS_ST1)};
          for (int u = (int)blockIdx.x; u < 256; u += F.G) mini_unit(F, (const bf16_t*)(ws + WS_OB), (const bf16_t*)(ws + WS_W_OUT), D, u, Gm); }
        if (BOTH(PH_OUTPROJ) || rep + 1 < (DUP_PHASE == PH_OUTPROJ ? 2 : 1)) xcd_barrier(bar);
    }
    if (IN(PH_XQ)) for (int rep = 0; rep < (DUP_PHASE == PH_XQ ? 2 : 1); ++rep) {
        pg8::Gemm g{(const bf16_t*)(ws + WS_XB1), (const bf16_t*)(ws + WS_W_XQ), MP, D, D};
        pg8::StaticOrder S; S.init(MP, D, F.G, (int)blockIdx.x);
        EpiScaleBf16 E{(const float*)(ws + WS_ST1), (bf16_t*)(ws + WS_Q), 0.0625f};
        pg8::gemm_phase<EpiScaleBf16, pg8::StaticOrder, PG8_ALIGN, PG8_SP2>(F.lds + RING_OFF, g, S, E, F.wave);
        { GranScale Gm{(const float*)(ws + WS_ST1), (bf16_t*)(ws + WS_Q), 0.0625f};
          for (int u = (int)blockIdx.x; u < 256; u += F.G) mini_unit(F, (const bf16_t*)(ws + WS_XB1), (const bf16_t*)(ws + WS_W_XQ), D, u, Gm); }
        if (BOTH(PH_XQ) || rep + 1 < (DUP_PHASE == PH_XQ ? 2 : 1)) xcd_barrier(bar);
    }
    if (IN(PH_ATTN)) for (int rep = 0; rep < (DUP_PHASE == PH_ATTN ? 2 : 1); ++rep) {
        for (int u = (int)blockIdx.x; u < 256; u += F.G) attn_prompt_unit(F, args, u);
        for (int it = (int)blockIdx.x; it < 512; it += F.G) attn_sample_item(F, args, it);
        if (BOTH(PH_ATTN) || rep + 1 < (DUP_PHASE == PH_ATTN ? 2 : 1)) xcd_barrier(bar);
    }
    if (IN(PH_XO)) for (int rep = 0; rep < (DUP_PHASE == PH_XO ? 2 : 1); ++rep) {
        pg8::Gemm g{(const bf16_t*)(ws + WS_OB), (const bf16_t*)(ws + WS_W_XO), MP, D, D};
        pg8::StaticOrder S; S.init(MP, D, F.G, (int)blockIdx.x);
        EpiResid E{args.out + O_Y, args.out + O_Y + (size_t)MP * D, (float*)(ws + WS_Y2), (bf16_t*)(ws + WS_XB2), (float*)(ws + WS_ST2)};
        pg8::gemm_phase<EpiResid, pg8::StaticOrder, PG8_ALIGN, PG8_SP2>(F.lds + RING_OFF, g, S, E, F.wave);
        { GranResid Gm{args.out + O_Y + (size_t)MP * D, (float*)(ws + WS_Y2), (bf16_t*)(ws + WS_XB2), (float*)(ws + WS_ST2)};
          for (int u = (int)blockIdx.x; u < 256; u += F.G) mini_unit(F, (const bf16_t*)(ws + WS_OB), (const bf16_t*)(ws + WS_W_XO), D, u, Gm); }
        if (BOTH(PH_XO) || rep + 1 < (DUP_PHASE == PH_XO ? 2 : 1)) xcd_barrier(bar);
    }
    if (IN(PH_GU)) for (int rep = 0; rep < (DUP_PHASE == PH_GU ? 2 : 1); ++rep) {
        pg8::Gemm g{(const bf16_t*)(ws + WS_XB2), (const bf16_t*)(ws + WS_W_GU), MT, 2 * DFF, D};
        pg8::StaticOrder S; S.init(MT, 2 * DFF, F.G, (int)blockIdx.x);
        EpiGateUp E{(const float*)(ws + WS_ST2), (bf16_t*)(ws + WS_ACT)};
        pg8::gemm_phase<EpiGateUp, pg8::StaticOrder, PG8_ALIGN, PG8_SP2>(F.lds + RING_OFF, g, S, E, F.wave);
        if (BOTH(PH_GU) || rep + 1 < (DUP_PHASE == PH_GU ? 2 : 1)) xcd_barrier(bar);
    }
    if (IN(PH_DOWN)) for (int rep = 0; rep < (DUP_PHASE == PH_DOWN ? 2 : 1); ++rep) {
        pg8::Gemm g{(const bf16_t*)(ws + WS_ACT), (const bf16_t*)(ws + WS_W_DN), MP, D, DFF};
        pg8::StaticOrder S; S.init(MP, D, F.G, (int)blockIdx.x);
        EpiResid E{(const float*)(ws + WS_Y2), (const float*)(ws + WS_Y2) + (size_t)MP * D, (float*)(ws + WS_Y3), (bf16_t*)(ws + WS_XB1), (float*)(ws + WS_ST3)};
        pg8::gemm_phase<EpiResid, pg8::StaticOrder, PG8_ALIGN, PG8_SP2>(F.lds + RING_OFF, g, S, E, F.wave);
        { GranResid Gm{(const float*)(ws + WS_Y2) + (size_t)MP * D, (float*)(ws + WS_Y3), (bf16_t*)(ws + WS_XB1), (float*)(ws + WS_ST3)};
          for (int u = (int)blockIdx.x; u < 256; u += F.G) mini_unit(F, (const bf16_t*)(ws + WS_ACT), (const bf16_t*)(ws + WS_W_DN), DFF, u, Gm); }
        if (BOTH(PH_DOWN) || rep + 1 < (DUP_PHASE == PH_DOWN ? 2 : 1)) xcd_barrier(bar);
    }
    if (IN(PH_FINAL)) for (int rep = 0; rep < (DUP_PHASE == PH_FINAL ? 2 : 1); ++rep) { phase_final(F, args); if (rep + 1 < (DUP_PHASE == PH_FINAL ? 2 : 1)) xcd_barrier(bar); }
#undef IN
#undef BOTH
}

__global__ void __launch_bounds__(128) mixer_naive2(const bf16_t* __restrict__ pb, const float* __restrict__ lf, const float* __restrict__ s0_ret, const float* __restrict__ s0_hg,
                                                    float* __restrict__ sout_ret, float* __restrict__ sout_hg, float* o_f32, bf16_t* ob, int Tn, int row0, int prompt) {
    __shared__ float qs[128], ks[128], fs[128], red[2];
    const int bh = blockIdx.x, b = bh >> 2, h = bh & 3, e = threadIdx.x, kind = blockIdx.y;
    float S[128];
    const float* s0 = kind == 0 ? s0_ret : s0_hg;
#pragma unroll
    for (int d = 0; d < 128; ++d) { const int dor = kind == 0 ? ((d & 1) ? 64 + (d >> 1) : (d >> 1)) : d; S[d] = s0 ? s0[((size_t)bh * 128 + dor) * 128 + e] : 0.f; }
    const float gamma = 1.f - exp2f(-5.f - (float)h);
    for (int t = 0; t < Tn; ++t) {
        const size_t row = (size_t)row0 + (size_t)b * Tn + t;
        const bf16_t* pr = pb + row * PBW;
        __syncthreads();
        if (kind == 0) {
            float q = bf2f(pr[h * 128 + e]), k = bf2f(pr[512 + h * 128 + e]);
            if (prompt) { const float n = (float)((t & 31) + 1); q *= powf(gamma, -n); k *= powf(gamma, n); }
            qs[e] = q; ks[e] = k; fs[e] = gamma;
        } else {
            const float f = expf(lf[row * 512 + h * 128 + e]);
            fs[e] = f; ks[e] = 1.f - f; qs[e] = bf2f(pr[2048 + h * 128 + e]);
        }
        __syncthreads();
        const float v = bf2f(kind == 0 ? pr[1024 + h * 128 + e] : pr[2560 + h * 128 + e]);
        float o = 0.f;
#pragma unroll
        for (int d = 0; d < 128; ++d) { S[d] = fs[d] * S[d] + ks[d] * v; o += qs[d] * S[d]; }
        float ss = o * o;
        for (int of = 32; of > 0; of >>= 1) ss += __shfl_xor(ss, of);
        __syncthreads();
        if ((e & 63) == 0) red[e >> 6] = ss;
        __syncthreads();
        ss = red[0] + red[1];
        const float rs = rsqrtf(ss * (1.f / 128.f) + EPS);
        const float gate = bf2f(kind == 0 ? pr[1536 + h * 128 + e] : pr[3072 + h * 128 + e]);
        const float val = o * rs * gate;
        if (o_f32) o_f32[((size_t)b * Tn + t) * D + kind * 512 + h * 128 + e] = val;
        if (ob) { const float other = __shfl_xor(val, 1); if ((e & 1) == 0) *(unsigned*)(ob + row * D + kind * 512 + h * 128 + e) = pk_bf16(val, other); }
    }
    float* so = kind == 0 ? sout_ret : sout_hg;
#pragma unroll
    for (int d = 0; d < 128; ++d) { const int dor = kind == 0 ? ((d & 1) ? 64 + (d >> 1) : (d >> 1)) : d; so[((size_t)bh * 128 + dor) * 128 + e] = S[d]; }
}
__global__ void __launch_bounds__(256) xattn_naive2(const bf16_t* __restrict__ q, const bf16_t* __restrict__ Kb, const bf16_t* __restrict__ Vb, const float* __restrict__ Kf, const float* __restrict__ Vf,
                                                    bf16_t* __restrict__ out, int row0, int tpb) {
    __shared__ float qs[256], ps[256], red[4];
    const int r = blockIdx.x, head = blockIdx.y, b = r / tpb, tid = threadIdx.x; const size_t row = (size_t)row0 + r;
    qs[tid] = bf2f(q[row * D + head * XHD + tid]);
    __syncthreads();
    const size_t kro = (((size_t)b * NMEM + tid) * XH + head) * XHD;
    float s = 0.f;
    for (int d = 0; d < XHD; ++d) s += qs[d] * (Kf ? Kf[kro + d] : bf2f(Kb[kro + d]));
    for (int o = 32; o > 0; o >>= 1) {}
    float mx = s;
    for (int o = 32; o > 0; o >>= 1) mx = fmaxf(mx, __shfl_xor(mx, o));
    if ((tid & 63) == 0) red[tid >> 6] = mx;
    __syncthreads();
    mx = fmaxf(fmaxf(red[0], red[1]), fmaxf(red[2], red[3]));
    __syncthreads();
    const float p = expf(s - mx);
    float sum = p;
    for (int o = 32; o > 0; o >>= 1) sum += __shfl_xor(sum, o);
    if ((tid & 63) == 0) red[tid >> 6] = sum;
    __syncthreads();
    sum = (red[0] + red[1]) + (red[2] + red[3]);
    ps[tid] = p / sum;
    __syncthreads();
    float o = 0.f;
    for (int m = 0; m < NMEM; ++m) { const size_t vo = (((size_t)b * NMEM + m) * XH + head) * XHD + tid; o += ps[m] * (Vf ? Vf[vo] : bf2f(Vb[vo])); }
    const float other = __shfl_xor(o, 1);
    if ((tid & 1) == 0) *(unsigned*)(out + row * D + head * XHD + tid) = pk_bf16(o, other);
}
}
namespace nv {
constexpr int D = 1024, T = 2048, NB = 8, MP = NB * T, SB = 128, ST = 4, MS = SB * ST;
constexpr int INW = 4096, NMEM = 256, XH = 4, XHD = 256, DFF = 2816, PAST = 16384;
constexpr float EPS = 1e-6f;

struct RopeTab { float inv_freq[64]; };

__device__ __forceinline__ void sincos_d(double x, double& s, double& c) {
    const double two_over_pi = 0.63661977236758134308;
    const double pio2_hi = 1.57079632673412561417e+00, pio2_lo = 6.07710050650619224932e-11, pio2_lo2 = 2.02226624879595063154e-21;
    double qd = rint(x * two_over_pi);
    double r = x - qd * pio2_hi; r -= qd * pio2_lo; r -= qd * pio2_lo2;
    long long q = (long long)qd;
    double r2 = r * r;
    double sp = r * (1.0 + r2 * (-1.0 / 6 + r2 * (1.0 / 120 + r2 * (-1.0 / 5040 + r2 * (1.0 / 362880 + r2 * (-1.0 / 39916800 + r2 * (1.0 / 6227020800.0 + r2 * (-1.0 / 1307674368000.0))))))));
    double cp = 1.0 + r2 * (-0.5 + r2 * (1.0 / 24 + r2 * (-1.0 / 720 + r2 * (1.0 / 40320 + r2 * (-1.0 / 3628800 + r2 * (1.0 / 479001600.0 + r2 * (-1.0 / 87178291200.0 + r2 * (1.0 / 20922789888000.0))))))));
    switch (q & 3) {
        case 0: s = sp; c = cp; break;
        case 1: s = cp; c = -sp; break;
        case 2: s = -sp; c = -cp; break;
        default: s = -cp; c = sp; break;
    }
}

__device__ __forceinline__ float silu_f(float x) { return x / (1.f + expf(-x)); }
__device__ __forceinline__ float sigmoid_f(float x) { return 1.f / (1.f + expf(-x)); }

__device__ __forceinline__ float block_sum_256(float v, float* red) {
    for (int o = 32; o > 0; o >>= 1) v += __shfl_xor(v, o);
    const int w = threadIdx.x >> 6;
    __syncthreads();
    if ((threadIdx.x & 63) == 0) red[w] = v;
    __syncthreads();
    float s = 0.f;
    for (int i = 0; i < (int)(blockDim.x >> 6); ++i) s += red[i];
    return s;
}
__device__ __forceinline__ float block_max_256(float v, float* red) {
    for (int o = 32; o > 0; o >>= 1) v = fmaxf(v, __shfl_xor(v, o));
    const int w = threadIdx.x >> 6;
    __syncthreads();
    if ((threadIdx.x & 63) == 0) red[w] = v;
    __syncthreads();
    float s = red[0];
    for (int i = 1; i < (int)(blockDim.x >> 6); ++i) s = fmaxf(s, red[i]);
    return s;
}

__global__ void __launch_bounds__(256) rmsnorm_k(const float* x, const float* __restrict__ g, float* y) {
    __shared__ float red[4];
    const size_t row = blockIdx.x;
    const float4 v = ((const float4*)(x + row * D))[threadIdx.x];
    float ss = v.x * v.x + v.y * v.y + v.z * v.z + v.w * v.w;
    ss = block_sum_256(ss, red);
    const float rs = rsqrtf(ss * (1.f / D) + EPS);
    const float4 gg = ((const float4*)g)[threadIdx.x];
    float4 o; o.x = v.x * rs * gg.x; o.y = v.y * rs * gg.y; o.z = v.z * rs * gg.z; o.w = v.w * rs * gg.w;
    ((float4*)(y + row * D))[threadIdx.x] = o;
}

template <int MODE>
__global__ void __launch_bounds__(256) gemm_naive(const float* __restrict__ A, const float* __restrict__ B, const float* __restrict__ B2,
                                                  const float* R, float* C, int M, int N, int K) {
    __shared__ float As[16][64 + 4];
    __shared__ float Bs[16][64 + 4];
    __shared__ float Bs2[MODE == 2 ? 16 : 1][64 + 4];
    const int tx = threadIdx.x & 15, ty = threadIdx.x >> 4;
    const int m0 = blockIdx.y * 64, n0 = blockIdx.x * 64;
    float acc[4][4] = {}, acc2[4][4] = {};
    for (int k0 = 0; k0 < K; k0 += 16) {
        {
            const int r = threadIdx.x >> 2, c4 = (threadIdx.x & 3) * 4;
            const float4 v = *(const float4*)(A + (size_t)(m0 + r) * K + k0 + c4);
            As[c4 + 0][r] = v.x; As[c4 + 1][r] = v.y; As[c4 + 2][r] = v.z; As[c4 + 3][r] = v.w;
            const int kr = threadIdx.x >> 4, c = (threadIdx.x & 15) * 4;
            const float4 w = *(const float4*)(B + (size_t)(k0 + kr) * N + n0 + c);
            Bs[kr][c] = w.x; Bs[kr][c + 1] = w.y; Bs[kr][c + 2] = w.z; Bs[kr][c + 3] = w.w;
            if (MODE == 2) {
                const float4 w2 = *(const float4*)(B2 + (size_t)(k0 + kr) * N + n0 + c);
                Bs2[kr][c] = w2.x; Bs2[kr][c + 1] = w2.y; Bs2[kr][c + 2] = w2.z; Bs2[kr][c + 3] = w2.w;
            }
        }
        __syncthreads();
#pragma unroll
        for (int kk = 0; kk < 16; ++kk) {
            float a[4], b[4], b2[4];
#pragma unroll
            for (int i = 0; i < 4; ++i) a[i] = As[kk][ty * 4 + i];
#pragma unroll
            for (int j = 0; j < 4; ++j) { b[j] = Bs[kk][tx * 4 + j]; b2[j] = (MODE == 2) ? Bs2[kk][tx * 4 + j] : 0.f; }
#pragma unroll
            for (int i = 0; i < 4; ++i)
#pragma unroll
                for (int j = 0; j < 4; ++j) { acc[i][j] += a[i] * b[j]; if (MODE == 2) acc2[i][j] += a[i] * b2[j]; }
        }
        __syncthreads();
    }
#pragma unroll
    for (int i = 0; i < 4; ++i) {
        const size_t off = (size_t)(m0 + ty * 4 + i) * N + n0 + tx * 4;
        float4 o;
        if (MODE == 0) { o.x = acc[i][0]; o.y = acc[i][1]; o.z = acc[i][2]; o.w = acc[i][3]; }
        else if (MODE == 1) { const float4 r = *(const float4*)(R + off); o.x = r.x + acc[i][0]; o.y = r.y + acc[i][1]; o.z = r.z + acc[i][2]; o.w = r.w + acc[i][3]; }
        else { o.x = silu_f(acc[i][0]) * acc2[i][0]; o.y = silu_f(acc[i][1]) * acc2[i][1]; o.z = silu_f(acc[i][2]) * acc2[i][2]; o.w = silu_f(acc[i][3]) * acc2[i][3]; }
        *(float4*)(C + off) = o;
    }
}

__global__ void __launch_bounds__(128) mixer_naive(const float* __restrict__ proj, const float* __restrict__ s0_ret, const float* __restrict__ s0_hg,
                                                   float* __restrict__ sout_ret, float* __restrict__ sout_hg, float* __restrict__ o_out,
                                                   const float* __restrict__ ret_gain, const float* __restrict__ hg_gain, const float* __restrict__ hg_lb,
                                                   int Tn, int pos0, RopeTab rt) {
    __shared__ float qs[128], ks[128], fs[128], red[2];
    const int bh = blockIdx.x, b = bh >> 2, h = bh & 3, e = threadIdx.x, kind = blockIdx.y;
    float S[128];
    const float* s0 = kind == 0 ? s0_ret : s0_hg;
#pragma unroll
    for (int d = 0; d < 128; ++d) S[d] = s0 ? s0[((size_t)bh * 128 + d) * 128 + e] : 0.f;
    const float gamma = 1.f - exp2f(-5.f - (float)h);
    float lower = 0.f;
    if (kind == 1) { const float a = hg_lb[h * 128 + e], c = hg_lb[512 + h * 128 + e]; const float m = fmaxf(a, c); const float ea = expf(a - m), ec = expf(c - m); lower = ea / (ea + ec); }
    for (int t = 0; t < Tn; ++t) {
        const float* pr = proj + (size_t)(b * Tn + t) * INW;
        __syncthreads();
        if (kind == 0) {
            if (e < 64) {
                const float ang = (float)(pos0 + t) * rt.inv_freq[e];
                double sd, cd; sincos_d((double)ang, sd, cd);
                const float cs = (float)cd, sn = (float)sd;
                const float q1 = pr[h * 128 + e], q2 = pr[h * 128 + e + 64];
                qs[e] = q1 * cs - q2 * sn; qs[e + 64] = q1 * sn + q2 * cs;
                const float k1 = pr[512 + h * 128 + e], k2 = pr[512 + h * 128 + e + 64];
                const float sc = 0.08838834764831845f;
                ks[e] = (k1 * cs - k2 * sn) * sc; ks[e + 64] = (k1 * sn + k2 * cs) * sc;
            }
            fs[e] = gamma;
        } else {
            const float f = lower + (1.f - lower) * sigmoid_f(pr[2560 + h * 128 + e]);
            fs[e] = f; ks[e] = 1.f - f; qs[e] = silu_f(pr[2048 + h * 128 + e]);
        }
        __syncthreads();
        const float v = kind == 0 ? pr[1024 + h * 128 + e] : pr[3072 + h * 128 + e];
        float o = 0.f;
#pragma unroll
        for (int d = 0; d < 128; ++d) { S[d] = fs[d] * S[d] + ks[d] * v; o += qs[d] * S[d]; }
        float ss = o * o;
        for (int of = 32; of > 0; of >>= 1) ss += __shfl_xor(ss, of);
        __syncthreads();
        if ((e & 63) == 0) red[e >> 6] = ss;
        __syncthreads();
        ss = red[0] + red[1];
        const float rs = rsqrtf(ss * (1.f / 128.f) + EPS);
        const float gate = kind == 0 ? pr[1536 + h * 128 + e] : pr[3584 + h * 128 + e];
        const float gn = kind == 0 ? ret_gain[h * 128 + e] : hg_gain[h * 128 + e];
        o_out[(size_t)(b * Tn + t) * D + kind * 512 + h * 128 + e] = o * rs * gn * silu_f(gate);
    }
    float* so = kind == 0 ? sout_ret : sout_hg;
#pragma unroll
    for (int d = 0; d < 128; ++d) so[((size_t)bh * 128 + d) * 128 + e] = S[d];
}

__global__ void __launch_bounds__(256) xattn_naive(const float* __restrict__ q, const float* __restrict__ K, const float* __restrict__ V, float* __restrict__ out, int tpb) {
    __shared__ float qs[256], ps[256], red[4];
    const int row = blockIdx.x, head = blockIdx.y, b = row / tpb, tid = threadIdx.x;
    qs[tid] = q[(size_t)row * D + head * XHD + tid];
    __syncthreads();
    const float* kr = K + (((size_t)b * NMEM + tid) * XH + head) * XHD;
    float s = 0.f;
    for (int d = 0; d < XHD; d += 4) { const float4 kv = *(const float4*)(kr + d); s += qs[d] * kv.x + qs[d + 1] * kv.y + qs[d + 2] * kv.z + qs[d + 3] * kv.w; }
    s *= 0.0625f;
    const float mx = block_max_256(s, red);
    const float p = expf(s - mx);
    const float sum = block_sum_256(p, red);
    ps[tid] = p / sum;
    __syncthreads();
    float o = 0.f;
    for (int m = 0; m < NMEM; ++m) o += ps[m] * V[(((size_t)b * NMEM + m) * XH + head) * XHD + tid];
    out[(size_t)row * D + head * XHD + tid] = o;
}
}
extern "C" void kernel_launch(void* const* d_in, const int* in_sizes, int n_in, void* d_out, int out_size, void* d_ws, size_t ws_size, hipStream_t stream) {
    using namespace mk;
    static int grid = 0;
    if (grid == 0) {
        int dev = 0, cus = 0;
        if (hipGetDevice(&dev) != hipSuccess || hipDeviceGetAttribute(&cus, hipDeviceAttributeMultiprocessorCount, dev) != hipSuccess) { fprintf(stderr, "kernel_launch: device query failed\n"); grid = -1; return; }
        if (hipFuncSetAttribute((const void*)mega, hipFuncAttributeMaxDynamicSharedMemorySize, LDS_BYTES) != hipSuccess) { fprintf(stderr, "kernel_launch: hipFuncSetAttribute failed\n"); grid = -1; return; }
        (void)hipGetLastError();
        grid = cus;
    }
    if (grid < 0) return;
    hipMemsetAsync((char*)d_ws + WS_CTL, 0, CTL_ZERO_BYTES, stream);
    Args a{};
    for (int i = 0; i < 24; ++i) a.in[i] = (const float*)d_in[i];
    a.out = (float*)d_out; a.ws = (unsigned char*)d_ws;
    for (int i = 0; i < 64; ++i) a.inv_freq[i] = (float)std::pow(10000.0, -(double)i / 64.0);
    int li_next = 0;
    auto run = [&](int lo, int hi) { a.ph_lo = lo; a.ph_hi = hi; a.li = li_next++; hipLaunchKernelGGL(mega, dim3(grid), dim3(NWAVES * 64), LDS_BYTES, stream, a); };
    unsigned char* ws = (unsigned char*)d_ws; float* out = (float*)d_out;
#if STEP >= 7
#ifdef PROBE_SPLIT
    run(PH_PREP, PROBE_SPLIT + 1);
#ifdef PROBE_MASK
    a.pad = PROBE_MASK;
#endif
    run(PROBE_SPLIT, PROBE_SPLIT + 1);
    a.pad = 0;
    run(PROBE_SPLIT + 1, PH_FINAL + 1);
#else
    run(PH_PREP, PH_FINAL + 1);
#endif
#else
    run(PH_PREP, PH_PREP + 1);
    run(PH_INPROJ, PH_INPROJ + 1);
#if STEP == 2
    float* bufAp = (float*)(ws + 280 * MiB);
    float* bufAs = (float*)(ws + 344 * MiB);
    float* bufB = (float*)(ws + 91 * MiB);
    for (int pass = 0; pass < 2; ++pass) {
        const int nb = pass == 0 ? NB : SB, Tn = pass == 0 ? T : ST;
        mixer_naive2<<<dim3(nb * 4, 2), 128, 0, stream>>>((const bf16_t*)(ws + WS_PB), (const float*)(ws + WS_LF), pass == 0 ? nullptr : (const float*)d_in[3], pass == 0 ? nullptr : (const float*)d_in[4],
                                                          out + (pass == 0 ? O_RETP : O_RETS), out + (pass == 0 ? O_HGP : O_HGS), pass == 0 ? bufAp : bufAs, nullptr, Tn, pass == 0 ? 0 : MP, pass == 0);
    }
    for (int pass = 0; pass < 2; ++pass) {
        const int M = pass == 0 ? MP : MS, Tn = pass == 0 ? T : ST;
        float* bufA = pass == 0 ? bufAp : bufAs;
        const float* x = (const float*)d_in[pass == 0 ? 0 : 1];
        float* y = out + O_Y + (pass == 0 ? 0 : (size_t)MP * D);
        const float* mkp = pass == 0 ? out + O_MEMK : (const float*)d_in[5]; const float* mvp = pass == 0 ? out + O_MEMV : (const float*)d_in[6];
        nv::gemm_naive<1><<<dim3(D / 64, M / 64), 256, 0, stream>>>(bufA, (const float*)d_in[12], nullptr, x, y, M, D, D);
        nv::rmsnorm_k<<<M, 256, 0, stream>>>(y, (const float*)d_in[13], bufA);
        float* qb = bufB; float* ob = bufB + (size_t)MP * D;
        nv::gemm_naive<0><<<dim3(D / 64, M / 64), 256, 0, stream>>>(bufA, (const float*)d_in[15], nullptr, nullptr, qb, M, D, D);
        nv::xattn_naive<<<dim3(M, XH), 256, 0, stream>>>(qb, mkp, mvp, ob, Tn);
        nv::gemm_naive<1><<<dim3(D / 64, M / 64), 256, 0, stream>>>(ob, (const float*)d_in[18], nullptr, y, y, M, D, D);
        nv::rmsnorm_k<<<M, 256, 0, stream>>>(y, (const float*)d_in[19], bufA);
        nv::gemm_naive<2><<<dim3(DFF / 64, M / 64), 256, 0, stream>>>(bufA, (const float*)d_in[20], (const float*)d_in[21], nullptr, bufB, M, DFF, D);
        nv::gemm_naive<1><<<dim3(D / 64, M / 64), 256, 0, stream>>>(bufB, (const float*)d_in[22], nullptr, y, y, M, D, DFF);
        nv::rmsnorm_k<<<M, 256, 0, stream>>>(y, (const float*)d_in[23], y);
    }
#else
#if STEP >= 4
    run(PH_REC, PH_REC + 1);
#else
    for (int pass = 0; pass < 2; ++pass) {
        const int nb = pass == 0 ? NB : SB, Tn = pass == 0 ? T : ST;
        mixer_naive2<<<dim3(nb * 4, 2), 128, 0, stream>>>((const bf16_t*)(ws + WS_PB), (const float*)(ws + WS_LF), pass == 0 ? nullptr : (const float*)d_in[3], pass == 0 ? nullptr : (const float*)d_in[4],
                                                          out + (pass == 0 ? O_RETP : O_RETS), out + (pass == 0 ? O_HGP : O_HGS), nullptr, (bf16_t*)(ws + WS_OB), Tn, pass == 0 ? 0 : MP, pass == 0);
    }
#endif
    run(PH_OUTPROJ, PH_OUTPROJ + 1);
    run(PH_XQ, PH_XQ + 1);
#if STEP >= 6
    run(PH_ATTN, PH_ATTN + 1);
#else
    xattn_naive2<<<dim3(MP, XH), 256, 0, stream>>>((const bf16_t*)(ws + WS_Q), (const bf16_t*)(ws + WS_MK), (const bf16_t*)(ws + WS_MV), nullptr, nullptr, (bf16_t*)(ws + WS_OB), 0, T);
    xattn_naive2<<<dim3(MS, XH), 256, 0, stream>>>((const bf16_t*)(ws + WS_Q), nullptr, nullptr, (const float*)d_in[5], (const float*)d_in[6], (bf16_t*)(ws + WS_OB), MP, ST);
#endif
    run(PH_XO, PH_XO + 1);
    run(PH_GU, PH_GU + 1);
    run(PH_DOWN, PH_DOWN + 1);
    run(PH_FINAL, PH_FINAL + 1);
#endif
#endif
}
```

```cpp
#include <hip/hip_runtime.h>
#include <cmath>
#include <cstdio>
#include <cstdint>

#define STEP 7
#define DUP_PHASE (-1)
namespace pg8 {
#define PG8_LAS __attribute__((address_space(3)))
typedef unsigned short bf16_t;
typedef short bf16x8 __attribute__((ext_vector_type(8)));
typedef float f32x4 __attribute__((ext_vector_type(4)));
typedef unsigned u32x4 __attribute__((ext_vector_type(4)));
constexpr int BM = 256, BK = 64, HALF = 128, HTB = HALF * BK * 2  , STAGE_BYTES = 8 * HTB, NXCD = 8, WGM = 8;

__host__ __device__ __forceinline__ int lds_byte(int r, int c) { const int st = (r >> 4) * 2 + (c >> 5), rr = r & 15, cc = c & 31, ob = rr * 64 + cc * 2; return st * 1024 + (ob ^ (((ob >> 9) & 1) << 5)); }
__host__ __device__ __forceinline__ void stage_rc(int b, int& R, int& C) { const int st = b / 1024, sb = b % 1024, swz = sb ^ (((sb >> 9) & 1) << 5); R = (st >> 1) * 16 + swz / 64; C = (st & 1) * 32 + (swz % 64) / 2; }
__host__ __device__ __forceinline__ int perm32(int rho) { const int n = rho >> 4, i = rho & 15; return 8 * (i >> 2) + 4 * n + (i & 3); }

struct Unit { int pm, pn; };
struct Gemm { const bf16_t* A; const bf16_t* Bt; int M, N, K; };

struct StaticOrder {
    int nM, nN, nwg, G, c;
    __host__ __device__ void init(int M, int N, int G_, int c_) { nM = M / BM; nN = N / BM; nwg = nM * nN; G = G_; c = c_; }
    __host__ __device__ bool next(int i, Unit& u) const {
        const long L = (long)i * G + c; if (L >= nwg) return false;
        int wgid = (int)L; { const int q = nwg / NXCD, r = nwg % NXCD, xcd = wgid % NXCD, off = wgid / NXCD; wgid = (xcd < r ? xcd * (q + 1) : r * (q + 1) + (xcd - r) * q) + off; }
        const int nig = WGM * nN, gid = wgid / nig, fm = gid * WGM, gsz = (nM - fm) < WGM ? (nM - fm) : WGM;
        u.pm = fm + ((wgid % nig) % gsz); u.pn = (wgid % nig) / gsz; return true;
    }
    __device__ __forceinline__ void a_ready(const Unit&) const {}
    __device__ __forceinline__ void done(const Unit&) const {}
};

template <class Epi, class Sched, bool ALIGN_EPI = false, bool SP2 = false>
__device__ __forceinline__ void gemm_phase(PG8_LAS unsigned char* lds, const Gemm g, const Sched& S, const Epi& E, int wid_in) {
    const int lane = (int)__builtin_amdgcn_mbcnt_hi(~0u, __builtin_amdgcn_mbcnt_lo(~0u, 0u)), wid = __builtin_amdgcn_readfirstlane(wid_in), tid = wid * 64 + lane, wr = wid >> 2, wc = wid & 3, fr = lane & 15, fq = lane >> 4;
    const int K = g.K, nt = K / BK;
    unsigned voffA[2], voffB[2];
#pragma unroll
    for (int i = 0; i < 2; ++i) { int R, C; stage_rc(tid * 16 + i * 8192, R, C); const int Rb = Epi::PERM ? ((R & ~31) + perm32(R & 31)) : R;
        voffA[i] = (unsigned)(R * K + C) * 2u; voffB[i] = (unsigned)(Rb * K + C) * 2u; }
    const size_t kstep = (size_t)(BK * 2);
    const size_t hstep = (size_t)HALF * K * 2;
    const size_t tstep = 2 * hstep;
    const unsigned ldsw = (unsigned)wid * 1024u;
    const int aoff = lds_byte(wr * 64 + fr, fq * 8), boff = lds_byte(wc * 32 + fr, fq * 8);
#define PG8_SA(b, h) (((b) * 2 + (h)) * HTB)
#define PG8_SB(b, h) ((4 + (b) * 2 + (h)) * HTB)
#define PG8_STAGE(bufoff, gbase, voff) do { _Pragma("unroll") for (int _i = 0; _i < 2; ++_i) \
        __builtin_amdgcn_global_load_lds((const unsigned*)((const char*)(gbase) + (voff)[_i]), (PG8_LAS unsigned*)(lds + (bufoff) + ldsw + _i * 8192), 16, 0, 0); } while (0)
#define PG8_LDA(dst, b, h) do { _Pragma("unroll") for (int m = 0; m < 4; ++m) _Pragma("unroll") for (int k = 0; k < 2; ++k) dst[m][k] = *(const PG8_LAS bf16x8*)(lds + PG8_SA(b, h) + aoff + m * 2048 + k * 1024); } while (0)
#define PG8_LDB(dst, b, h) do { _Pragma("unroll") for (int n = 0; n < 2; ++n) _Pragma("unroll") for (int k = 0; k < 2; ++k) dst[n][k] = *(const PG8_LAS bf16x8*)(lds + PG8_SB(b, h) + boff + n * 2048 + k * 1024); } while (0)
#define PG8_MMA(ai, bj, At, Bt) do { __builtin_amdgcn_s_setprio(1); _Pragma("unroll") for (int m = 0; m < 4; ++m) _Pragma("unroll") for (int n = 0; n < 2; ++n) _Pragma("unroll") for (int k = 0; k < 2; ++k) \
        acc[ai][bj][m][n] = __builtin_amdgcn_mfma_f32_16x16x32_bf16(Bt[n][k], At[m][k], acc[ai][bj][m][n], 0, 0, 0); __builtin_amdgcn_s_setprio(0); } while (0)
#define PG8_WAIT_V(n) asm volatile("s_waitcnt vmcnt(" #n ")" ::: "memory")
#define PG8_WAIT_L(n) asm volatile("s_waitcnt lgkmcnt(" #n ")" ::: "memory")
#define PG8_BAR __builtin_amdgcn_s_barrier()
#define PG8_SCHED __builtin_amdgcn_sched_barrier(0)
    Unit cur, nxt; int ui = 0;
    if (!S.next(0, cur)) return;
    f32x4 acc[2][2][4][2];
#pragma unroll
    for (int a = 0; a < 2; ++a)
#pragma unroll
        for (int b = 0; b < 2; ++b)
#pragma unroll
            for (int m = 0; m < 4; ++m)
#pragma unroll
                for (int n = 0; n < 2; ++n) acc[a][b][m][n] = (f32x4){0.f, 0.f, 0.f, 0.f};
    bf16x8 At[4][2], B0[2][2], B1[2][2];
    const char* cA = (const char*)g.A + (size_t)cur.pm * tstep; const char* cB = (const char*)g.Bt + (size_t)cur.pn * tstep;
    S.a_ready(cur);
    if constexpr (SP2) {
        PG8_STAGE(PG8_SB(0, 0), cB, voffB); PG8_STAGE(PG8_SB(0, 1), cB + hstep, voffB); PG8_STAGE(PG8_SA(0, 0), cA, voffA); PG8_STAGE(PG8_SA(0, 1), cA + hstep, voffA);
        if (wr == 1) PG8_BAR;
        PG8_WAIT_V(2); PG8_BAR;
        PG8_STAGE(PG8_SB(1, 0), cB + kstep, voffB); PG8_STAGE(PG8_SA(1, 0), cA + kstep, voffA); PG8_STAGE(PG8_SB(1, 1), cB + hstep + kstep, voffB);
        PG8_WAIT_V(6); PG8_BAR;
    } else {
        PG8_STAGE(PG8_SB(0, 0), cB, voffB); PG8_STAGE(PG8_SA(0, 0), cA, voffA); PG8_STAGE(PG8_SB(0, 1), cB + hstep, voffB); PG8_STAGE(PG8_SA(0, 1), cA + hstep, voffA);
        if (wr == 1) PG8_BAR;
        PG8_WAIT_V(4); PG8_BAR;
        PG8_STAGE(PG8_SB(1, 0), cB + kstep, voffB); PG8_STAGE(PG8_SA(1, 0), cA + kstep, voffA); PG8_STAGE(PG8_SB(1, 1), cB + hstep + kstep, voffB);
        PG8_WAIT_V(6); PG8_BAR;
    }
    for (;;) {
        const bool has_next = S.next(ui + 1, nxt);
        const char* nA = has_next ? (const char*)g.A + (size_t)nxt.pm * tstep : cA; const char* nB = has_next ? (const char*)g.Bt + (size_t)nxt.pn * tstep : cB;
        for (int t = 0; t < nt; t += 2) {
            const bool last = (t == nt - 2);
            const char* a1 = cA + (size_t)(t + 1) * kstep;
            const char* a2 = last ? nA : cA + (size_t)(t + 2) * kstep; const char* b2 = last ? nB : cB + (size_t)(t + 2) * kstep;
            const char* a3 = a2 + kstep; const char* b3 = b2 + kstep;
            if (last && has_next) S.a_ready(nxt);
            if constexpr (SP2) {
            PG8_LDB(B0, 0, 0); PG8_LDB(B1, 0, 1); PG8_SCHED; PG8_LDA(At, 0, 0); PG8_STAGE(PG8_SA(1, 1), a1 + hstep, voffA);
            PG8_WAIT_V(8); PG8_WAIT_L(0); PG8_BAR; PG8_MMA(0, 0, At, B0); PG8_MMA(0, 1, At, B1); PG8_BAR; PG8_SCHED;
            PG8_LDA(At, 0, 1); PG8_STAGE(PG8_SB(0, 0), b2, voffB); PG8_STAGE(PG8_SB(0, 1), b2 + hstep, voffB); PG8_STAGE(PG8_SA(0, 0), a2, voffA);
            PG8_WAIT_V(8); PG8_WAIT_L(0); PG8_BAR; PG8_MMA(1, 0, At, B0); PG8_MMA(1, 1, At, B1); PG8_BAR; PG8_SCHED;
            PG8_LDB(B0, 1, 0); PG8_LDB(B1, 1, 1); PG8_SCHED; PG8_LDA(At, 1, 0); PG8_STAGE(PG8_SA(0, 1), a2 + hstep, voffA);
            PG8_WAIT_V(8); PG8_WAIT_L(0); PG8_BAR; PG8_MMA(0, 0, At, B0); PG8_MMA(0, 1, At, B1); PG8_BAR; PG8_SCHED;
            PG8_LDA(At, 1, 1); PG8_STAGE(PG8_SB(1, 0), b3, voffB); PG8_STAGE(PG8_SB(1, 1), b3 + hstep, voffB); PG8_STAGE(PG8_SA(1, 0), a3, voffA);
            PG8_WAIT_V(8); PG8_WAIT_L(0); PG8_BAR; PG8_MMA(1, 0, At, B0); PG8_MMA(1, 1, At, B1); PG8_BAR; PG8_SCHED;
            } else {
            PG8_LDB(B0, 0, 0); PG8_SCHED; PG8_LDA(At, 0, 0); PG8_STAGE(PG8_SA(1, 1), a1 + hstep, voffA);
            PG8_WAIT_L(8); PG8_BAR; PG8_WAIT_L(0); PG8_MMA(0, 0, At, B0); PG8_BAR; PG8_SCHED;
            PG8_LDB(B1, 0, 1); PG8_STAGE(PG8_SB(0, 0), b2, voffB);
            PG8_BAR; PG8_WAIT_L(0); PG8_MMA(0, 1, At, B1); PG8_BAR;
            PG8_LDA(At, 0, 1); PG8_STAGE(PG8_SA(0, 0), a2, voffA);
            PG8_BAR; PG8_WAIT_L(0); PG8_MMA(1, 0, At, B0); PG8_BAR; PG8_SCHED;
            PG8_STAGE(PG8_SB(0, 1), b2 + hstep, voffB);
            PG8_WAIT_V(6); PG8_BAR; PG8_MMA(1, 1, At, B1); PG8_BAR;
            PG8_LDB(B0, 1, 0); PG8_SCHED; PG8_LDA(At, 1, 0); PG8_STAGE(PG8_SA(0, 1), a2 + hstep, voffA);
            PG8_WAIT_L(8); PG8_BAR; PG8_WAIT_L(0); PG8_MMA(0, 0, At, B0); PG8_BAR; PG8_SCHED;
            PG8_LDB(B1, 1, 1); PG8_STAGE(PG8_SB(1, 0), b3, voffB);
            PG8_BAR; PG8_WAIT_L(0); PG8_MMA(0, 1, At, B1); PG8_BAR;
            PG8_LDA(At, 1, 1); PG8_STAGE(PG8_SA(1, 0), a3, voffA);
            PG8_BAR; PG8_WAIT_L(0); PG8_MMA(1, 0, At, B0); PG8_BAR; PG8_SCHED;
            PG8_STAGE(PG8_SB(1, 1), b3 + hstep, voffB);
            PG8_WAIT_V(6); PG8_BAR; PG8_MMA(1, 1, At, B1); PG8_BAR;
            }
        }
        if constexpr (ALIGN_EPI) { if (wr == 0) PG8_BAR; }
        if constexpr (!Epi::AFTER_DRAIN) { E(acc, cur, wr, wc, fr, fq); S.done(cur); }
        if (!has_next) break;
#pragma unroll
        for (int a = 0; a < 2; ++a)
#pragma unroll
            for (int b = 0; b < 2; ++b)
#pragma unroll
                for (int m = 0; m < 4; ++m)
#pragma unroll
                    for (int n = 0; n < 2; ++n) acc[a][b][m][n] = (f32x4){0.f, 0.f, 0.f, 0.f};
        cur = nxt; cA = nA; cB = nB; ++ui;
        if constexpr (ALIGN_EPI) { if (wr == 1) PG8_BAR; }
    }
    PG8_WAIT_V(0);
    if constexpr (!ALIGN_EPI) { if (wr == 0) PG8_BAR; }
    PG8_BAR;
    if constexpr (Epi::AFTER_DRAIN) { E.fused(acc, cur, wr, wc, fr, fq, lds, wid, lane); S.done(cur); }
#undef PG8_SA
#undef PG8_SB
#undef PG8_STAGE
#undef PG8_LDA
#undef PG8_LDB
#undef PG8_MMA
#undef PG8_WAIT_V
#undef PG8_WAIT_L
#undef PG8_BAR
#undef PG8_SCHED
}
}
#ifndef PG8_SP2
#define PG8_SP2 true
#endif
#ifndef PG8_ALIGN
#define PG8_ALIGN true
#endif

namespace mk {
using pg8::bf16_t; using pg8::f32x4; using pg8::u32x4; using pg8::Unit;
#define GAS __attribute__((address_space(1)))
#define LAS __attribute__((address_space(3)))
typedef GAS unsigned gu32;
#define RLX_AGENT __ATOMIC_RELAXED, __HIP_MEMORY_SCOPE_AGENT
#define LDS_WAIT() asm volatile("s_waitcnt lgkmcnt(0)" ::: "memory")
#define VM_WAIT() asm volatile("s_waitcnt vmcnt(0)" ::: "memory")

constexpr int D = 1024, T = 2048, NB = 8, MP = NB * T, SB = 128, ST = 4, MS = SB * ST, MT = MP + MS;
constexpr int INW = 4096, NMEM = 256, XH = 4, XHD = 256, DFF = 2816, PAST = 16384, MMEM = NB * NMEM;
constexpr int PBW = 4096;
constexpr float EPS = 1e-6f;
constexpr int NWAVES = 8;

constexpr size_t MiB = 1u << 20;
constexpr size_t WS_CTL = 0, CTL_ZERO_BYTES = 1 * MiB;
constexpr size_t WS_W_IN = 1 * MiB, WS_W_OUT = 9 * MiB, WS_W_XQ = 11 * MiB, WS_W_KV = 13 * MiB, WS_W_XO = 17 * MiB, WS_W_GU = 19 * MiB, WS_W_DN = 30 * MiB;
constexpr size_t WS_CS = 36 * MiB, WS_LOW = 38 * MiB, WS_RS0 = 39 * MiB, WS_RSM = WS_RS0 + 256 * 1024, WS_ST1 = 40 * MiB, WS_ST2 = 42 * MiB, WS_ST3 = 44 * MiB;
constexpr size_t WS_MB = 46 * MiB, WS_MK = 50 * MiB, WS_MV = 54 * MiB, WS_XB0 = 58 * MiB, WS_PB = 91 * MiB, WS_LF = 223 * MiB, WS_OB = 256 * MiB;
constexpr size_t WS_XB1 = 289 * MiB, WS_Q = 322 * MiB, WS_XB2 = 355 * MiB, WS_ACT = 388 * MiB, WS_END = 479 * MiB;
static_assert(WS_PB + (size_t)MT * PBW * 2 <= WS_LF && WS_LF + (size_t)MT * 512 * 4 <= WS_OB && WS_ACT + (size_t)MT * DFF * 2 <= WS_END, "ws map");
constexpr size_t WS_Y2 = WS_PB, WS_Y3 = WS_LF;
static_assert(WS_Y3 + (size_t)MT * D * 4 <= WS_XB1, "Y3 fits LF|OB");
constexpr size_t WS_SLOC = 479 * MiB, WS_DSEG = 491 * MiB;
constexpr int CW_BAR = 4096;

constexpr int RING_OFF = 0, RING_BYTES = 155648, LDSCTL_OFF = RING_BYTES, MISC_OFF = LDSCTL_OFF + 320, LDS_BYTES = 163840;

typedef float f32x2_t __attribute__((ext_vector_type(2)));
typedef __bf16 bf16x2_t __attribute__((ext_vector_type(2)));
__device__ __forceinline__ unsigned pk_bf16(float lo, float hi) { f32x2_t v = {lo, hi}; bf16x2_t b = __builtin_convertvector(v, bf16x2_t); return __builtin_bit_cast(unsigned, b); }
__device__ __forceinline__ float bf2f(unsigned short h) { return __uint_as_float((unsigned)h << 16); }
__device__ __forceinline__ float silu_f(float x) { return x / (1.f + __expf(-x)); }
__device__ __forceinline__ float sigmoid_f(float x) { return 1.f / (1.f + __expf(-x)); }

__device__ __forceinline__ void sincos_d(double x, double& s, double& c) {
    const double two_over_pi = 0.63661977236758134308;
    const double pio2_hi = 1.57079632673412561417e+00, pio2_lo = 6.07710050650619224932e-11;
    double qd = rint(x * two_over_pi);
    double r = x - qd * pio2_hi; r -= qd * pio2_lo;
    long long q = (long long)qd;
    double r2 = r * r;
    double sp = r * (1.0 + r2 * (-1.0 / 6 + r2 * (1.0 / 120 + r2 * (-1.0 / 5040 + r2 * (1.0 / 362880 + r2 * (-1.0 / 39916800 + r2 * (1.0 / 6227020800.0 + r2 * (-1.0 / 1307674368000.0))))))));
    double cp = 1.0 + r2 * (-0.5 + r2 * (1.0 / 24 + r2 * (-1.0 / 720 + r2 * (1.0 / 40320 + r2 * (-1.0 / 3628800 + r2 * (1.0 / 479001600.0 + r2 * (-1.0 / 87178291200.0 + r2 * (1.0 / 20922789888000.0))))))));
    switch (q & 3) {
        case 0: s = sp; c = cp; break;
        case 1: s = cp; c = -sp; break;
        case 2: s = -sp; c = -cp; break;
        default: s = -cp; c = sp; break;
    }
}
__device__ __forceinline__ float wave_sum(float v) {
#pragma unroll
    for (int o = 1; o < 64; o <<= 1) v += __shfl_xor(v, o);
    return v;
}
#define XB_TMO      128
#define XB_XCNT(j)  (256  + 64 * (j))
#define XB_XSUB(j)  (1280 + 64 * (j))
#define XB_XGEN(j)  (2304 + 64 * (j))
#define XB_TOP      3328
#define XB_TOPGEN   3392
#define XCD_BAR_WORDS 3456
#define XB_SPIN_CAP (1u << 18)

__device__ __forceinline__ unsigned xb_ld(unsigned* p)              { return __hip_atomic_load(p, __ATOMIC_RELAXED, __HIP_MEMORY_SCOPE_AGENT); }
__device__ __forceinline__ unsigned xb_add(unsigned* p, unsigned v) { return __hip_atomic_fetch_add(p, v, __ATOMIC_RELAXED, __HIP_MEMORY_SCOPE_AGENT); }
__device__ __forceinline__ unsigned xb_xcc_id() { return (unsigned)__builtin_amdgcn_s_getreg((3 << 11) | 20) & 0xFu; }
#define XB_SPIN(cond, bar) do { unsigned _sp = 0; while (cond) { __builtin_amdgcn_s_sleep(1); \
    if ((++_sp & 255u) == 0u) { if (xb_ld(&(bar)[XB_TMO])) break; if (_sp > XB_SPIN_CAP) { atomicAdd(&(bar)[XB_TMO], 1u); break; } } } } while (0)

struct XcdBarrier {
    unsigned* bar; unsigned x;
    volatile LAS unsigned* st;
    int wave;
};
__device__ __forceinline__ bool xb_leader(int wave) { return wave == 0 && __builtin_amdgcn_mbcnt_hi(~0u, __builtin_amdgcn_mbcnt_lo(~0u, 0u)) == 0u; }

__device__ __forceinline__ XcdBarrier xcd_barrier_post(unsigned* bar, volatile LAS unsigned* st, int wave) {
    XcdBarrier b; b.bar = bar; b.x = xb_xcc_id(); b.st = st; b.wave = wave;
    if (xb_leader(wave)) (void)xb_add(&bar[XB_XCNT(b.x)], 1u);
    return b;
}
__device__ __forceinline__ void xcd_barrier_complete(unsigned* bar, unsigned x, unsigned& nloc, unsigned& nx) {
    const unsigned G = gridDim.x * gridDim.y * gridDim.z;
    unsigned sum, cnt, mine, sp = 0u;
    for (;;) {
        sum = 0u; cnt = 0u; mine = 0u;
#pragma unroll
        for (unsigned j = 0; j < 16; ++j) { const unsigned c = xb_ld(&bar[XB_XCNT(j)]); sum += c; cnt += (c > 0u) ? 1u : 0u; mine = (j == x) ? c : mine; }
        if (sum == G) break;
        __builtin_amdgcn_s_sleep(1);
        if ((++sp & 255u) == 0u) { if (xb_ld(&bar[XB_TMO])) break; if (sp > XB_SPIN_CAP) { atomicAdd(&bar[XB_TMO], 1u); break; } }
    }
    nloc = mine > 0u ? mine : 1u; nx = cnt > 0u ? cnt : 1u;
}

__device__ __forceinline__ void xcd_barrier(const XcdBarrier& b) {
    asm volatile("s_waitcnt vmcnt(0)" ::: "memory");
    __syncthreads();
    if (xb_leader(b.wave)) {
        unsigned* bar = b.bar;
        __builtin_amdgcn_s_waitcnt(0);
        unsigned nloc = b.st[0], nx = b.st[1];
        if (nloc == 0u) { xcd_barrier_complete(bar, b.x, nloc, nx); b.st[0] = nloc; b.st[1] = nx; }
        const unsigned old = xb_add(&bar[XB_XSUB(b.x)], 1u);
        const unsigned gen = old / nloc;
        if (old + 1u == (gen + 1u) * nloc) {
            __builtin_amdgcn_fence(__ATOMIC_RELEASE, "agent");
            asm volatile("s_waitcnt vmcnt(0)" ::: "memory");
            const unsigned og = xb_add(&bar[XB_TOP], 1u);
            const unsigned tg = og / nx;
            if (og + 1u == (tg + 1u) * nx) xb_add(&bar[XB_TOPGEN], 1u);
            else XB_SPIN(xb_ld(&bar[XB_TOPGEN]) == tg, bar);
            __builtin_amdgcn_fence(__ATOMIC_ACQUIRE, "agent");
            xb_add(&bar[XB_XGEN(b.x)], 1u);
            asm volatile("s_waitcnt vmcnt(0)" ::: "memory");
        } else {
            XB_SPIN(xb_ld(&bar[XB_XGEN(b.x)]) == gen, bar);
            __builtin_amdgcn_fence(__ATOMIC_ACQUIRE, "agent");
            asm volatile("s_waitcnt vmcnt(0)" ::: "memory");
        }
    }
    __syncthreads();
}
struct Args { const float* in[24]; float* out; unsigned char* ws; float inv_freq[64]; int ph_lo, ph_hi, li, pad; };
enum { I_XP = 0, I_XS, I_MEM, I_SRET, I_SHG, I_CK, I_CV, I_GMIX, I_WIN, I_RGAIN, I_HGAIN, I_HGLB, I_WOUT, I_GXA, I_GMEM, I_WXQ, I_WXK, I_WXV, I_WXO, I_GFFN, I_WGATE, I_WUP, I_WDOWN, I_GFINAL };
constexpr size_t O_Y = 0, O_RETP = (size_t)MT * D, O_HGP = O_RETP + (size_t)NB * 4 * 16384, O_MEMK = O_HGP + (size_t)NB * 4 * 16384, O_MEMV = O_MEMK + (size_t)MMEM * D,
                 O_RETS = O_MEMV + (size_t)MMEM * D, O_HGS = O_RETS + (size_t)SB * 4 * 16384;

struct Frame {
    LAS unsigned char* lds; volatile LAS unsigned* MISC; gu32* ctl;
    int wave, vcu, G;
};
__device__ __forceinline__ int lane_id() { return (int)__builtin_amdgcn_mbcnt_hi(~0u, __builtin_amdgcn_mbcnt_lo(~0u, 0u)); }

__device__ __forceinline__ const float* wsrc(int mode, const float* s0, const float* s1, int n) {
    if (mode == 1) { if (n < 1024) { const int blk = n >> 9, h = (n & 511) >> 7, j = n & 127; return s0 + blk * 512 + h * 128 + (j >> 1) + 64 * (j & 1); } return s0 + n; }
    if (mode == 2) return n < 1024 ? s0 + n : s1 + (n - 1024);
    if (mode == 3) { const int jj = (n >> 3) * 4 + (n & 3); return (n & 4) ? s1 + jj : s0 + jj; }
    return s0 + n;
}
__device__ __forceinline__ void transpose_item(int mode, const float* s0, const float* s1, int ldw, const float* g, int K, int nblk, bf16_t* WT, LAS float* scr, int item, int lane) {
    const int kb = item / nblk, nb = item % nblk, k0 = 64 * kb, n0 = 32 * nb;
    const float* colp = wsrc(mode, s0, s1, n0 + (lane & 31));
    float tv[32];
    const float* cp = colp + (size_t)(k0 + (lane >> 5)) * ldw; asm volatile("" : "+v"(cp));
#pragma unroll
    for (int i = 0; i < 32; ++i) tv[i] = cp[(size_t)(2 * i) * ldw];
    if (g) { const float* gp = g + k0 + (lane >> 5);
#pragma unroll
        for (int i = 0; i < 32; ++i) tv[i] *= gp[2 * i]; }
#pragma unroll
    for (int i = 0; i < 32; ++i) scr[(2 * i + (lane >> 5)) * 33 + (lane & 31)] = tv[i];
    LDS_WAIT(); asm volatile("" ::: "memory");
    const int c = lane & 7;
#pragma unroll
    for (int j = 0; j < 4; ++j) { const int n = (lane >> 3) + 8 * j; const LAS float* s = scr + (8 * c) * 33 + n;
        u32x4 o; o.x = pk_bf16(s[0 * 33], s[1 * 33]); o.y = pk_bf16(s[2 * 33], s[3 * 33]); o.z = pk_bf16(s[4 * 33], s[5 * 33]); o.w = pk_bf16(s[6 * 33], s[7 * 33]);
        *(GAS u32x4*)(WT + (size_t)(n0 + n) * K + k0 + 8 * c) = o; }
    LDS_WAIT(); asm volatile("" ::: "memory");
}
__device__ __forceinline__ void row_to_bf16(const float* xrow, bf16_t* orow, float* rs, int lane) {
    const GAS f32x4* xr = (const GAS f32x4*)xrow + lane;
    f32x4 v[4]; float s = 0.f;
#pragma unroll
    for (int j = 0; j < 4; ++j) { v[j] = xr[64 * j]; s += (v[j].x * v[j].x + v[j].y * v[j].y) + (v[j].z * v[j].z + v[j].w * v[j].w); }
    s = wave_sum(s);
    if (lane == 0) *rs = rsqrtf(s * (1.f / D) + EPS);
    GAS unsigned long long* o8 = (GAS unsigned long long*)orow + lane;
#pragma unroll
    for (int j = 0; j < 4; ++j) o8[64 * j] = (unsigned long long)pk_bf16(v[j].x, v[j].y) | ((unsigned long long)pk_bf16(v[j].z, v[j].w) << 32);
}
constexpr int CV_I0 = (D / 64) * (INW / 32), CV_I1 = (D / 64) * (D / 32), CV_I3 = (D / 64) * (2 * D / 32), CV_I5 = (D / 64) * (2 * DFF / 32), CV_I6 = (DFF / 64) * (D / 32);
constexpr int CV_EARLY = CV_I0 + CV_I3, CV_ALL = CV_EARLY + 3 * CV_I1 + CV_I5 + CV_I6;
__device__ __forceinline__ void convert_items(Frame& F, const Args& a, int lo, int hi, int gw, int NGW) {
    unsigned char* ws = a.ws; const int lane = lane_id();
    LAS float* scr = (LAS float*)(F.lds + RING_OFF + F.wave * 16384);
    for (int it = lo + gw; it < hi; it += NGW) {
        int r = it;
        if (r < CV_I0) { transpose_item(1, a.in[I_WIN], nullptr, INW, a.in[I_GMIX], D, INW / 32, (bf16_t*)(ws + WS_W_IN), scr, r, lane); continue; } r -= CV_I0;
        if (r < CV_I3) { transpose_item(2, a.in[I_WXK], a.in[I_WXV], D, a.in[I_GMEM], D, 2 * D / 32, (bf16_t*)(ws + WS_W_KV), scr, r, lane); continue; } r -= CV_I3;
        if (r < CV_I1) { transpose_item(0, a.in[I_WOUT], nullptr, D, nullptr, D, D / 32, (bf16_t*)(ws + WS_W_OUT), scr, r, lane); continue; } r -= CV_I1;
        if (r < CV_I1) { transpose_item(0, a.in[I_WXQ], nullptr, D, a.in[I_GXA], D, D / 32, (bf16_t*)(ws + WS_W_XQ), scr, r, lane); continue; } r -= CV_I1;
        if (r < CV_I1) { transpose_item(0, a.in[I_WXO], nullptr, D, nullptr, D, D / 32, (bf16_t*)(ws + WS_W_XO), scr, r, lane); continue; } r -= CV_I1;
        if (r < CV_I5) { transpose_item(3, a.in[I_WGATE], a.in[I_WUP], DFF, a.in[I_GFFN], D, 2 * DFF / 32, (bf16_t*)(ws + WS_W_GU), scr, r, lane); continue; } r -= CV_I5;
        transpose_item(0, a.in[I_WDOWN], nullptr, D, nullptr, DFF, D / 32, (bf16_t*)(ws + WS_W_DN), scr, r, lane);
    }
}
__device__ __forceinline__ void phase_prep(Frame& F, const Args& a) {
    unsigned char* ws = a.ws; const int lane = lane_id(), tid = F.wave * 64 + lane;
    const int gw = F.vcu * NWAVES + F.wave, NGW = F.G * NWAVES;
    convert_items(F, a, 0, F.G == 256 ? CV_EARLY : CV_ALL, gw, NGW);
    for (int m = gw; m < MT + MMEM; m += NGW) {
        if (m < MP) row_to_bf16(a.in[I_XP] + (size_t)m * D, (bf16_t*)(ws + WS_XB0) + (size_t)m * D, (float*)(ws + WS_RS0) + m, lane);
        else if (m < MT) row_to_bf16(a.in[I_XS] + (size_t)(m - MP) * D, (bf16_t*)(ws + WS_XB0) + (size_t)m * D, (float*)(ws + WS_RS0) + m, lane);
        else row_to_bf16(a.in[I_MEM] + (size_t)(m - MT) * D, (bf16_t*)(ws + WS_MB) + (size_t)(m - MT) * D, (float*)(ws + WS_RSM) + (m - MT), lane);
    }
    float* cs = (float*)(ws + WS_CS);
    for (int e = F.vcu * 512 + tid; e < (T + ST) * 64; e += F.G * 512) {
        const int p = e >> 6, i = e & 63; const int pos = p < T ? p : PAST + (p - T);
        const float ang = (float)pos * a.inv_freq[i];
        double sd, cd; sincos_d((double)ang, sd, cd);
        cs[2 * e] = (float)cd; cs[2 * e + 1] = (float)sd;
    }
    if (F.vcu == 0) {
        const float* lb = a.in[I_HGLB]; float* low = (float*)(ws + WS_LOW);
        const int c = tid; const float x0 = lb[c], x1 = lb[512 + c]; const float m = fmaxf(x0, x1); const float e0 = expf(x0 - m), e1 = expf(x1 - m); low[c] = e0 / (e0 + e1);
    }
}
struct EpiMemKV {
    static constexpr bool PERM = true, AFTER_DRAIN = false;
    const float* rsm; float* outk; float* outv; bf16_t* mk; bf16_t* mv;
    __device__ __forceinline__ void operator()(const f32x4 (&acc)[2][2][4][2], const Unit& u, int wr, int wc, int fr, int fq) const {
        const bool isv = u.pn >= 4; float* of = isv ? outv : outk; bf16_t* ob = isv ? mv : mk;
        const int cn = (u.pn & 3) * 256 + wc * 32 + 8 * fq;
#pragma unroll
        for (int ai = 0; ai < 2; ++ai)
#pragma unroll
            for (int m = 0; m < 4; ++m) { const int row = u.pm * 256 + ai * 128 + wr * 64 + m * 16 + fr; const float rs = rsm[row];
#pragma unroll
                for (int bj = 0; bj < 2; ++bj) { const size_t off = (size_t)row * D + cn + bj * 128;
                    const f32x4 v0 = acc[ai][bj][m][0] * rs, v1 = acc[ai][bj][m][1] * rs;
                    *(f32x4*)(of + off) = v0; *(f32x4*)(of + off + 4) = v1;
                    u32x4 w; w.x = pk_bf16(v0[0], v0[1]); w.y = pk_bf16(v0[2], v0[3]); w.z = pk_bf16(v1[0], v1[1]); w.w = pk_bf16(v1[2], v1[3]);
                    *(u32x4*)(ob + off) = w; } }
    }
};
__device__ __forceinline__ u32x4 pk8(const f32x4& a, const f32x4& b) { u32x4 w; w.x = pk_bf16(a[0], a[1]); w.y = pk_bf16(a[2], a[3]); w.z = pk_bf16(b[0], b[1]); w.w = pk_bf16(b[2], b[3]); return w; }
__device__ __forceinline__ f32x4 silu4(const f32x4& v) { return (f32x4){silu_f(v[0]), silu_f(v[1]), silu_f(v[2]), silu_f(v[3])}; }
__device__ __forceinline__ float row_rs(const float* st, int row) {
    const f32x4* p = (const f32x4*)(st + (size_t)row * 16); const f32x4 a = p[0], b = p[1], c = p[2], d = p[3];
    const float s = ((a[0] + a[1]) + (a[2] + a[3])) + ((b[0] + b[1]) + (b[2] + b[3])) + ((c[0] + c[1]) + (c[2] + c[3])) + ((d[0] + d[1]) + (d[2] + d[3]));
    return rsqrtf(s * (1.f / D) + EPS);
}
__device__ __forceinline__ float scan16(float x) {
    x += __builtin_bit_cast(float, __builtin_amdgcn_update_dpp(0, __builtin_bit_cast(int, x), 0x111, 0xf, 0xf, true));
    x += __builtin_bit_cast(float, __builtin_amdgcn_update_dpp(0, __builtin_bit_cast(int, x), 0x112, 0xf, 0xf, true));
    x += __builtin_bit_cast(float, __builtin_amdgcn_update_dpp(0, __builtin_bit_cast(int, x), 0x114, 0xf, 0xf, true));
    x += __builtin_bit_cast(float, __builtin_amdgcn_update_dpp(0, __builtin_bit_cast(int, x), 0x118, 0xf, 0xf, true));
    return x;
}
struct EpiInProj {
    static constexpr bool PERM = true, AFTER_DRAIN = false;
    const float* rs0; const float* cs; const float* low; const float* rgain; const float* hgain; bf16_t* pb; float* lf;
    __device__ __forceinline__ void operator()(const f32x4 (&acc)[2][2][4][2], const Unit& u, int wr, int wc, int fr, int fq) const {
        const int kind = u.pn >> 1; const int colt = u.pn * 256 + wc * 32 + 8 * fq;
        f32x4 carry[2][2];
#pragma unroll
        for (int x = 0; x < 2; ++x) { carry[x][0] = (f32x4){0.f, 0.f, 0.f, 0.f}; carry[x][1] = (f32x4){0.f, 0.f, 0.f, 0.f}; }
#pragma unroll
        for (int ai = 0; ai < 2; ++ai)
#pragma unroll
            for (int m = 0; m < 4; ++m) {
                const int row = u.pm * 256 + ai * 128 + wr * 64 + m * 16 + fr; const float rs = rs0[row];
                const bool samp = row >= MP; const int t = row & (T - 1); const int pidx = samp ? T + ((row - MP) & 3) : t;
#pragma unroll
                for (int bj = 0; bj < 2; ++bj) {
                    const int c0 = colt + bj * 128;
                    f32x4 v0 = acc[ai][bj][m][0] * rs, v1 = acc[ai][bj][m][1] * rs;
                    if (kind <= 1) {
                        const int h = (c0 & 511) >> 7, i0 = (c0 & 127) >> 1;
                        const f32x4* tp = (const f32x4*)(cs + ((size_t)pidx * 64 + i0) * 2); const f32x4 t0 = tp[0], t1 = tp[1];
                        const float lg = __log2f(1.f - exp2f(-5.f - (float)h)); const float e = (float)((t & 31) + 1);
                        float sc = kind == 0 ? 1.f : 0.08838834764831845f;
                        if (!samp) sc *= exp2f(kind == 0 ? e * lg : -e * lg);
                        f32x4 o0, o1;
                        o0[0] = (v0[0] * t0[0] - v0[1] * t0[1]) * sc; o0[1] = (v0[0] * t0[1] + v0[1] * t0[0]) * sc;
                        o0[2] = (v0[2] * t0[2] - v0[3] * t0[3]) * sc; o0[3] = (v0[2] * t0[3] + v0[3] * t0[2]) * sc;
                        o1[0] = (v1[0] * t1[0] - v1[1] * t1[1]) * sc; o1[1] = (v1[0] * t1[1] + v1[1] * t1[0]) * sc;
                        o1[2] = (v1[2] * t1[2] - v1[3] * t1[3]) * sc; o1[3] = (v1[2] * t1[3] + v1[3] * t1[2]) * sc;
                        *(u32x4*)(pb + (size_t)row * PBW + c0) = pk8(o0, o1);
                    } else if (kind == 2) {
                        *(u32x4*)(pb + (size_t)row * PBW + c0) = pk8(v0, v1);
                    } else if (kind == 3) {
                        const f32x4* gp = (const f32x4*)(rgain + (c0 - 1536));
                        *(u32x4*)(pb + (size_t)row * PBW + c0) = pk8(silu4(v0) * gp[0], silu4(v1) * gp[1]);
                    } else if (kind == 4) {
                        *(u32x4*)(pb + (size_t)row * PBW + c0) = pk8(silu4(v0), silu4(v1));
                    } else if (kind == 5) {
                        const f32x4* lp = (const f32x4*)(low + (c0 - 2560)); const f32x4 l0 = lp[0], l1 = lp[1];
                        f32x4 o0, o1, k0, k1;
#pragma unroll
                        for (int e = 0; e < 4; ++e) { const float s0 = sigmoid_f(v0[e]), s1 = sigmoid_f(v1[e]);
                            o0[e] = __logf(l0[e] + (1.f - l0[e]) * s0); o1[e] = __logf(l1[e] + (1.f - l1[e]) * s1);
                            k0[e] = (1.f - l0[e]) * (1.f - s0); k1[e] = (1.f - l1[e]) * (1.f - s1); }
                        *(u32x4*)(pb + (size_t)row * PBW + 3584 + (c0 - 2560)) = pk8(k0, k1);
                        if (!samp) {
#pragma unroll
                            for (int e = 0; e < 4; ++e) { o0[e] = scan16(o0[e]); o1[e] = scan16(o1[e]); }
                            if (m & 1) { o0 = o0 + carry[bj][0]; o1 = o1 + carry[bj][1]; }
                            else {
#pragma unroll
                                for (int e = 0; e < 4; ++e) { carry[bj][0][e] = __shfl(o0[e], (fq << 4) | 15); carry[bj][1][e] = __shfl(o1[e], (fq << 4) | 15); } }
                        }
                        float* lp2 = lf + (size_t)row * 512 + (c0 - 2560);
                        *(f32x4*)lp2 = o0; *(f32x4*)(lp2 + 4) = o1;
                    } else if (kind == 6) {
                        *(u32x4*)(pb + (size_t)row * PBW + c0 - 512) = pk8(v0, v1);
                    } else {
                        const f32x4* gp = (const f32x4*)(hgain + (c0 - 3584));
                        *(u32x4*)(pb + (size_t)row * PBW + c0 - 512) = pk8(silu4(v0) * gp[0], silu4(v1) * gp[1]);
                    }
                }
            }
    }
};
struct EpiResid {
    static constexpr bool PERM = true, AFTER_DRAIN = false;
    const float* xold_p; const float* xold_s; float* y; bf16_t* xb; float* st;
    __device__ __forceinline__ void operator()(const f32x4 (&acc)[2][2][4][2], const Unit& u, int wr, int wc, int fr, int fq) const {
        const int cn = u.pn * 256 + wc * 32 + 8 * fq;
#pragma unroll
        for (int ai = 0; ai < 2; ++ai)
#pragma unroll
            for (int m = 0; m < 4; ++m) {
                const int row = u.pm * 256 + ai * 128 + wr * 64 + m * 16 + fr;
                const float* xo = row < MP ? xold_p + (size_t)row * D : xold_s + (size_t)(row - MP) * D;
                float ss = 0.f;
#pragma unroll
                for (int bj = 0; bj < 2; ++bj) { const int c = cn + bj * 128;
                    const f32x4 v0 = *(const f32x4*)(xo + c) + acc[ai][bj][m][0], v1 = *(const f32x4*)(xo + c + 4) + acc[ai][bj][m][1];
                    ss += (v0[0] * v0[0] + v0[1] * v0[1]) + (v0[2] * v0[2] + v0[3] * v0[3]) + (v1[0] * v1[0] + v1[1] * v1[1]) + (v1[2] * v1[2] + v1[3] * v1[3]);
                    *(f32x4*)(y + (size_t)row * D + c) = v0; *(f32x4*)(y + (size_t)row * D + c + 4) = v1;
                    *(u32x4*)(xb + (size_t)row * D + c) = pk8(v0, v1); }
                ss += __shfl_xor(ss, 16); ss += __shfl_xor(ss, 32);
                if (fq == 0) st[(size_t)row * 16 + u.pn * 4 + wc] = ss;
            }
    }
};
struct EpiScaleBf16 {
    static constexpr bool PERM = true, AFTER_DRAIN = false;
    const float* st; bf16_t* o; float scale;
    __device__ __forceinline__ void operator()(const f32x4 (&acc)[2][2][4][2], const Unit& u, int wr, int wc, int fr, int fq) const {
        const int cn = u.pn * 256 + wc * 32 + 8 * fq;
#pragma unroll
        for (int ai = 0; ai < 2; ++ai)
#pragma unroll
            for (int m = 0; m < 4; ++m) { const int row = u.pm * 256 + ai * 128 + wr * 64 + m * 16 + fr; const float rs = row_rs(st, row) * scale;
#pragma unroll
                for (int bj = 0; bj < 2; ++bj) *(u32x4*)(o + (size_t)row * D + cn + bj * 128) = pk8(acc[ai][bj][m][0] * rs, acc[ai][bj][m][1] * rs); }
    }
};
struct EpiGateUp {
    static constexpr bool PERM = true, AFTER_DRAIN = false;
    const float* st; bf16_t* act;
    __device__ __forceinline__ void operator()(const f32x4 (&acc)[2][2][4][2], const Unit& u, int wr, int wc, int fr, int fq) const {
        const int jn = u.pn * 128 + wc * 16 + 4 * fq;
#pragma unroll
        for (int ai = 0; ai < 2; ++ai)
#pragma unroll
            for (int m = 0; m < 4; ++m) { const int row = u.pm * 256 + ai * 128 + wr * 64 + m * 16 + fr; const float rs = row_rs(st, row);
#pragma unroll
                for (int bj = 0; bj < 2; ++bj) { const f32x4 g = silu4(acc[ai][bj][m][0] * rs), up = acc[ai][bj][m][1] * rs; const f32x4 a = g * up;
                    unsigned long long w = (unsigned long long)pk_bf16(a[0], a[1]) | ((unsigned long long)pk_bf16(a[2], a[3]) << 32);
                    *(unsigned long long*)(act + (size_t)row * DFF + jn + bj * 64) = w; } }
    }
};
__device__ __forceinline__ void phase_final(Frame& F, const Args& a) {
    const int gw = F.vcu * NWAVES + F.wave, NGW = F.G * NWAVES, lane = lane_id();
    const float* st = (const float*)(a.ws + WS_ST3); const GAS f32x4* g4 = (const GAS f32x4*)a.in[I_GFINAL] + lane;
    for (int m = gw; m < MT; m += NGW) { const float rs = row_rs(st, m); GAS f32x4* yr = (GAS f32x4*)(a.out + O_Y + (size_t)m * D) + lane;
        const GAS f32x4* xr = (const GAS f32x4*)((const float*)(a.ws + WS_Y3) + (size_t)m * D) + lane;
#pragma unroll
        for (int j = 0; j < 4; ++j) yr[64 * j] = xr[64 * j] * rs * g4[64 * j]; }
}
typedef short bf16x8v __attribute__((ext_vector_type(8)));
typedef short s16x4v __attribute__((ext_vector_type(4)));
typedef float f32x16v __attribute__((ext_vector_type(16)));
constexpr int RC_RS = 272;
constexpr int RC_TILE = 32 * RC_RS, RC_BUF = 3 * RC_TILE;
constexpr int RC_ORS = 528, RC_OSZ = 32 * RC_ORS;
constexpr int RC_OOFF = 2 * RC_BUF, RC_EOFF = RC_OOFF + 2 * RC_OSZ, RC_END = RC_EOFF + 2 * 512;
static_assert(RC_END <= RING_BYTES, "recurrence LDS");
__device__ __forceinline__ int crow(int r, int h) { return (r & 3) + 8 * (r >> 2) + 4 * h; }
__device__ __forceinline__ s16x4v tr16(const LAS unsigned char* p) { typedef short v4i16_t __attribute__((ext_vector_type(4))); return __builtin_bit_cast(s16x4v, __builtin_amdgcn_ds_read_tr16_b64_v4i16((LAS v4i16_t*)p)); }
__device__ __forceinline__ bf16x8v cat8(s16x4v lo, s16x4v hi) { return (bf16x8v){lo[0], lo[1], lo[2], lo[3], hi[0], hi[1], hi[2], hi[3]}; }
__device__ __forceinline__ bf16x8v pack_step(const f32x16v& x, int s) {
    u32x4 p; p.x = pk_bf16(x[8 * s], x[8 * s + 1]); p.y = pk_bf16(x[8 * s + 2], x[8 * s + 3]); p.z = pk_bf16(x[8 * s + 4], x[8 * s + 5]); p.w = pk_bf16(x[8 * s + 6], x[8 * s + 7]);
    return __builtin_bit_cast(bf16x8v, p);
}
#define MFMA32(a, b, c) __builtin_amdgcn_mfma_f32_32x32x16_bf16((a), (b), (c), 0, 0, 0)

#define RC_LDS_BARRIER() do { asm volatile("s_waitcnt lgkmcnt(0)" ::: "memory"); __builtin_amdgcn_s_barrier(); asm volatile("" ::: "memory"); } while (0)

__device__ __forceinline__ void st_store_plain(const f32x16v (&S)[4], float* base  ) {
    float* p = base;
#pragma unroll
    for (int dt = 0; dt < 4; ++dt)
#pragma unroll
        for (int gq = 0; gq < 4; ++gq) { asm volatile("" : "+v"(p));
#pragma unroll
            for (int e = 0; e < 4; ++e) p[e * 128] = S[dt][4 * gq + e];
            p += 8 * 128; }
}
__device__ __forceinline__ void st_store_deint(const f32x16v (&S)[4], float* base  ) {
    float* p = base;
#pragma unroll
    for (int dt = 0; dt < 4; ++dt)
#pragma unroll
        for (int gq = 0; gq < 4; ++gq) { asm volatile("" : "+v"(p));
            p[0] = S[dt][4 * gq]; p[64 * 128] = S[dt][4 * gq + 1]; p[128] = S[dt][4 * gq + 2]; p[64 * 128 + 128] = S[dt][4 * gq + 3];
            p += 4 * 128; }
}
__device__ __forceinline__ void st_fold(f32x16v (&S)[4], const float* base  , const float* dg  , float dret) {
    const float* p = base; const float* q = dg;
#pragma unroll
    for (int dt = 0; dt < 4; ++dt)
#pragma unroll
        for (int gq = 0; gq < 4; ++gq) { asm volatile("" : "+v"(p));
            f32x4 dv = (f32x4){dret, dret, dret, dret};
            if (dg) { asm volatile("" : "+v"(q)); dv = *(const f32x4*)q; q += 8; }
#pragma unroll
            for (int e = 0; e < 4; ++e) S[dt][4 * gq + e] = dv[e] * S[dt][4 * gq + e] + p[e * 128];
            p += 8 * 128; }
}
constexpr int NSEG = 4, SEGC = (T / 32) / NSEG;
__device__ __forceinline__ void rec_prompt_unit(Frame& F, const Args& a, int unit, int seg) {
    const int kind = unit >> 5, b = (unit >> 2) & 7, h = unit & 3; const int c0 = seg * SEGC, c1 = c0 + SEGC;
    unsigned char* ws = a.ws;
    const bf16_t* pb = (const bf16_t*)(ws + WS_PB); const float* lf = (const float*)(ws + WS_LF); bf16_t* ob = (bf16_t*)(ws + WS_OB);
    LAS unsigned char* L = F.lds + RING_OFF;
    const int lane = lane_id(), r32 = lane & 31, hh = lane >> 5, g = (lane >> 4) & 1, q4 = (lane & 15) >> 2, p4 = lane & 3;
    const int row_base = b * T;
    const int qcol = kind == 0 ? h * 128 : 2048 + h * 128, kcol = 512 + h * 128, vcol = kind == 0 ? 1024 + h * 128 : 2560 + h * 128, gcol = kind == 0 ? 1536 + h * 128 : 3072 + h * 128;
    const float Eret = exp2f(32.f * __log2f(1.f - exp2f(-5.f - (float)h)));
    const int pt = F.wave * 64 + lane - 256;

    u32x4 pre[6]; f32x4 preb[4]; u32x4 gpre[2];
    const int prow = pt >> 4, pch = pt & 15;
    const bf16_t* pbase = pb + (size_t)(row_base + prow) * PBW + pch * 8;
    const float* lbase = lf + (size_t)(row_base + prow) * 512 + h * 128 + pch * 8;
    const int lofs = prow * RC_RS + pch * 16;
    auto stage_load = [&](int c) {
        const bf16_t* p = pbase + (size_t)32 * c * PBW; asm volatile("" : "+v"(p));
        if (kind == 0) {
#pragma unroll
            for (int j = 0; j < 2; ++j) { pre[j] = *(const u32x4*)(p + (size_t)16 * j * PBW + qcol); pre[2 + j] = *(const u32x4*)(p + (size_t)16 * j * PBW + kcol); pre[4 + j] = *(const u32x4*)(p + (size_t)16 * j * PBW + vcol); }
        } else {
            const float* lp = lbase + (size_t)32 * c * 512; asm volatile("" : "+v"(lp));
#pragma unroll
            for (int j = 0; j < 2; ++j) { pre[j] = *(const u32x4*)(p + (size_t)16 * j * PBW + qcol); pre[2 + j] = *(const u32x4*)(p + (size_t)16 * j * PBW + 3584 + h * 128); pre[4 + j] = *(const u32x4*)(p + (size_t)16 * j * PBW + vcol);
                preb[2 * j] = *(const f32x4*)(lp + (size_t)16 * j * 512); preb[2 * j + 1] = *(const f32x4*)(lp + (size_t)16 * j * 512 + 4); }
        }
    };
    auto stage_write = [&](int c) {
        LAS unsigned char* B = L + (c & 1) * RC_BUF + lofs; asm volatile("" : "+v"(B));
        if (kind == 0) {
#pragma unroll
            for (int j = 0; j < 2; ++j) { *(LAS u32x4*)(B + 16 * j * RC_RS) = pre[j]; *(LAS u32x4*)(B + RC_TILE + 16 * j * RC_RS) = pre[2 + j]; *(LAS u32x4*)(B + 2 * RC_TILE + 16 * j * RC_RS) = pre[4 + j]; }
        } else {
#pragma unroll
            for (int j = 0; j < 2; ++j) {
                u32x4 qo, ko; f32x4 eb[2];
#pragma unroll
                for (int x = 0; x < 2; ++x)
#pragma unroll
                    for (int e = 0; e < 4; ++e) eb[x][e] = exp2f(preb[2 * j + x][e] * 1.4426950408889634f);
#pragma unroll
                for (int e = 0; e < 4; ++e) { const unsigned qw = pre[j][e], kw = pre[2 + j][e];
                    const float e0 = eb[e >> 1][2 * (e & 1)], e1 = eb[e >> 1][2 * (e & 1) + 1];
                    qo[e] = pk_bf16(__uint_as_float(qw << 16) * e0, __uint_as_float(qw & 0xffff0000u) * e1);
                    ko[e] = pk_bf16(__uint_as_float(kw << 16) * __builtin_amdgcn_rcpf(e0), __uint_as_float(kw & 0xffff0000u) * __builtin_amdgcn_rcpf(e1)); }
                *(LAS u32x4*)(B + 16 * j * RC_RS) = qo; *(LAS u32x4*)(B + RC_TILE + 16 * j * RC_RS) = ko; *(LAS u32x4*)(B + 2 * RC_TILE + 16 * j * RC_RS) = pre[4 + j];
                if (j == 1 && prow == 15) { LAS float* Ep = (LAS float*)(L + RC_EOFF + (c & 1) * 512) + pch * 8; *(LAS f32x4*)Ep = eb[0]; *(LAS f32x4*)(Ep + 4) = eb[1]; }
            }
        }
    };
    const int et = pt >> 3, ecg = pt & 7;
    auto gate_load = [&](int c) { const u32x4* gp = (const u32x4*)(pb + (size_t)(row_base + 32 * c + et) * PBW + gcol + ecg * 16); gpre[0] = gp[0]; gpre[1] = gp[1]; };
    auto epilogue = [&](int c) {
        const int row = row_base + 32 * c + et;
        const LAS f32x4* op = (const LAS f32x4*)(L + RC_OOFF + (c & 1) * RC_OSZ + et * RC_ORS + ecg * 64);
        f32x4 o[4]; float ss = 0.f;
#pragma unroll
        for (int j = 0; j < 4; ++j) { o[j] = op[j]; ss += (o[j][0] * o[j][0] + o[j][1] * o[j][1]) + (o[j][2] * o[j][2] + o[j][3] * o[j][3]); }
        ss += __shfl_xor(ss, 1); ss += __shfl_xor(ss, 2); ss += __shfl_xor(ss, 4);
        const float rs = rsqrtf(ss * (1.f / 128.f) + EPS);
        u32x4* dp = (u32x4*)(ob + (size_t)row * D + kind * 512 + h * 128 + ecg * 16);
#pragma unroll
        for (int j = 0; j < 2; ++j) { const u32x4 gw = gpre[j]; u32x4 w;
#pragma unroll
            for (int e = 0; e < 4; ++e) { const float g0 = __uint_as_float(gw[e] << 16), g1 = __uint_as_float(gw[e] & 0xffff0000u);
                const float o0 = o[2 * j + (e >> 1)][2 * (e & 1)], o1 = o[2 * j + (e >> 1)][2 * (e & 1) + 1];
                w[e] = pk_bf16(o0 * rs * g0, o1 * rs * g1); }
            dp[j] = w; }
    };

    if (F.wave >= 4) {
        stage_load(c0); stage_write(c0); stage_load(c0 + 1);
        RC_LDS_BARRIER();
        for (int c = c0; c < c1; ++c) {
            if (c + 1 < c1) { stage_write(c + 1); if (c + 2 < c1) stage_load(c + 2); }
            if (c > c0) epilogue(c - 1);
            gate_load(c);
            RC_LDS_BARRIER();
        }
        epilogue(c1 - 1);
    } else {
        f32x16v S[4];
#pragma unroll
        for (int dt = 0; dt < 4; ++dt)
#pragma unroll
            for (int i = 0; i < 16; ++i) S[dt][i] = 0.f;
        { const float dret = exp2f(512.f * __log2f(1.f - exp2f(-5.f - (float)h)));
          for (int j = 0; j < seg; ++j) {
            const float* sl = (const float*)(ws + WS_SLOC) + (size_t)(unit * 3 + j) * 16384 + (size_t)(4 * hh) * 128 + 32 * F.wave + r32;
            const float* dg = kind == 0 ? nullptr : (const float*)(ws + WS_DSEG) + (size_t)(unit * 3 + j) * 128 + 4 * hh;
            st_fold(S, sl, dg, dret); } }
        RC_LDS_BARRIER();
        for (int c = c0; c < c1; ++c) {
        const int w = F.wave;
        const LAS unsigned char* B = L + (c & 1) * RC_BUF;
        const LAS unsigned char* QE = B; const LAS unsigned char* KE = B + RC_TILE; const LAS unsigned char* V = B + 2 * RC_TILE;
        f32x16v X;
#pragma unroll
        for (int i = 0; i < 16; ++i) X[i] = 0.f;
#pragma unroll
        for (int kk = 0; kk < 8; ++kk) { const bf16x8v ka = *(const LAS bf16x8v*)(KE + r32 * RC_RS + kk * 32 + hh * 16), qb = *(const LAS bf16x8v*)(QE + r32 * RC_RS + kk * 32 + hh * 16);
            X = MFMA32(ka, qb, X); }
#pragma unroll
        for (int i = 0; i < 16; ++i) if (crow(i, hh) > r32) X[i] = 0.f;
        bf16x8v vf[2];
#pragma unroll
        for (int kk = 0; kk < 2; ++kk) { const LAS unsigned char* vp = V + (16 * kk + 4 * hh + q4) * RC_RS + (32 * w + 16 * g + 4 * p4) * 2; vf[kk] = cat8(tr16(vp), tr16(vp + 8 * RC_RS)); }
        f32x16v o;
#pragma unroll
        for (int i = 0; i < 16; ++i) o[i] = 0.f;
#pragma unroll
        for (int kk = 0; kk < 2; ++kk) o = MFMA32(pack_step(X, kk), vf[kk], o);
#pragma unroll
        for (int dt = 0; dt < 4; ++dt)
#pragma unroll
            for (int kk = 0; kk < 2; ++kk) { const LAS unsigned char* qp = QE + r32 * RC_RS + (32 * dt + 16 * kk + 4 * hh) * 2;
                const bf16x8v qa = cat8(*(const LAS s16x4v*)qp, *(const LAS s16x4v*)(qp + 16));
                o = MFMA32(qa, pack_step(S[dt], kk), o); }
        { LAS unsigned char* OB = L + RC_OOFF + (c & 1) * RC_OSZ;
#pragma unroll
          for (int i = 0; i < 16; ++i) *(LAS float*)(OB + crow(i, hh) * RC_ORS + (32 * w + r32) * 4) = o[i]; }
#pragma unroll
        for (int dt = 0; dt < 4; ++dt)
#pragma unroll
            for (int kk = 0; kk < 2; ++kk) { const LAS unsigned char* kp = KE + (16 * kk + 4 * hh + q4) * RC_RS + (32 * dt + 16 * g + 4 * p4) * 2;
                S[dt] = MFMA32(cat8(tr16(kp), tr16(kp + 8 * RC_RS)), vf[kk], S[dt]); }
        if (kind == 0) {
#pragma unroll
            for (int dt = 0; dt < 4; ++dt) S[dt] = S[dt] * Eret;
        } else {
            const LAS unsigned char* EB = L + RC_EOFF + (c & 1) * 512;
#pragma unroll
            for (int dt = 0; dt < 4; ++dt)
#pragma unroll
                for (int gq = 0; gq < 4; ++gq) { const f32x4 e4 = *(const LAS f32x4*)(EB + (32 * dt + 8 * gq + 4 * hh) * 4);
#pragma unroll
                    for (int e = 0; e < 4; ++e) S[dt][4 * gq + e] *= e4[e]; }
        }
            RC_LDS_BARRIER();
        }
        if (seg == NSEG - 1) {
            float* so = a.out + (kind == 0 ? O_RETP : O_HGP) + (size_t)(b * 4 + h) * 16384 + 32 * F.wave + r32;
            if (kind == 0) st_store_deint(S, so + (size_t)(2 * hh) * 128); else st_store_plain(S, so + (size_t)(4 * hh) * 128);
        }
    }
    __syncthreads();
}

__device__ __forceinline__ void rec_state_unit(Frame& F, const Args& a, int unit, int seg) {
    const int kind = unit >> 5, b = (unit >> 2) & 7, h = unit & 3; const int c0 = seg * SEGC, c1 = c0 + SEGC;
    unsigned char* ws = a.ws;
    const bf16_t* pb = (const bf16_t*)(ws + WS_PB); const float* lf = (const float*)(ws + WS_LF);
    LAS unsigned char* L = F.lds + RING_OFF;
    const int lane = lane_id(), r32 = lane & 31, hh = lane >> 5, g = (lane >> 4) & 1, q4 = (lane & 15) >> 2, p4 = lane & 3;
    const int row_base = b * T;
    const int kcol = kind == 0 ? 512 + h * 128 : 3584 + h * 128, vcol = kind == 0 ? 1024 + h * 128 : 2560 + h * 128;
    const float Eret = exp2f(32.f * __log2f(1.f - exp2f(-5.f - (float)h)));
    const int pt = F.wave * 64 + lane - 256;
    if (F.wave >= 4) {
        u32x4 pre[4]; f32x4 preb[4]; f32x4 dacc[2] = {(f32x4){1.f, 1.f, 1.f, 1.f}, (f32x4){1.f, 1.f, 1.f, 1.f}};
        const int prow = pt >> 4, pch = pt & 15;
        const bf16_t* pbase = pb + (size_t)(row_base + prow) * PBW + pch * 8;
        const float* lbase = lf + (size_t)(row_base + prow) * 512 + h * 128 + pch * 8;
        const int lofs = prow * RC_RS + pch * 16;
        auto stage_load = [&](int c) {
            const bf16_t* p = pbase + (size_t)32 * c * PBW; asm volatile("" : "+v"(p));
#pragma unroll
            for (int j = 0; j < 2; ++j) { pre[j] = *(const u32x4*)(p + (size_t)16 * j * PBW + kcol); pre[2 + j] = *(const u32x4*)(p + (size_t)16 * j * PBW + vcol); }
            if (kind == 1) { const float* lp = lbase + (size_t)32 * c * 512; asm volatile("" : "+v"(lp));
#pragma unroll
                for (int j = 0; j < 2; ++j) { preb[2 * j] = *(const f32x4*)(lp + (size_t)16 * j * 512); preb[2 * j + 1] = *(const f32x4*)(lp + (size_t)16 * j * 512 + 4); } }
        };
        auto stage_write = [&](int c) {
            LAS unsigned char* B = L + (c & 1) * RC_BUF + lofs; asm volatile("" : "+v"(B));
#pragma unroll
            for (int j = 0; j < 2; ++j) {
                u32x4 ko = pre[j];
                if (kind == 1) { f32x4 eb[2];
#pragma unroll
                    for (int x = 0; x < 2; ++x)
#pragma unroll
                        for (int e = 0; e < 4; ++e) eb[x][e] = exp2f(preb[2 * j + x][e] * 1.4426950408889634f);
#pragma unroll
                    for (int e = 0; e < 4; ++e) { const unsigned kw = pre[j][e]; const float e0 = eb[e >> 1][2 * (e & 1)], e1 = eb[e >> 1][2 * (e & 1) + 1];
                        ko[e] = pk_bf16(__uint_as_float(kw << 16) * __builtin_amdgcn_rcpf(e0), __uint_as_float(kw & 0xffff0000u) * __builtin_amdgcn_rcpf(e1)); }
                    if (j == 1 && prow == 15) { LAS float* Ep = (LAS float*)(L + RC_EOFF + (c & 1) * 512) + pch * 8; *(LAS f32x4*)Ep = eb[0]; *(LAS f32x4*)(Ep + 4) = eb[1]; dacc[0] = dacc[0] * eb[0]; dacc[1] = dacc[1] * eb[1]; }
                }
                *(LAS u32x4*)(B + RC_TILE + 16 * j * RC_RS) = ko; *(LAS u32x4*)(B + 2 * RC_TILE + 16 * j * RC_RS) = pre[2 + j];
            }
        };
        stage_load(c0); stage_write(c0); stage_load(c0 + 1);
        RC_LDS_BARRIER();
        for (int c = c0; c < c1; ++c) {
            if (c + 1 < c1) { stage_write(c + 1); if (c + 2 < c1) stage_load(c + 2); }
            RC_LDS_BARRIER();
        }
        if (kind == 1 && prow == 15) { float* dg = (float*)(ws + WS_DSEG) + (size_t)(unit * 3 + seg) * 128 + pch * 8; *(f32x4*)dg = dacc[0]; *(f32x4*)(dg + 4) = dacc[1]; }
    } else {
        f32x16v S[4];
#pragma unroll
        for (int dt = 0; dt < 4; ++dt)
#pragma unroll
            for (int i = 0; i < 16; ++i) S[dt][i] = 0.f;
        RC_LDS_BARRIER();
        const int w = F.wave;
        for (int c = c0; c < c1; ++c) {
            const LAS unsigned char* B = L + (c & 1) * RC_BUF;
            const LAS unsigned char* KE = B + RC_TILE; const LAS unsigned char* V = B + 2 * RC_TILE;
            bf16x8v vf[2];
#pragma unroll
            for (int kk = 0; kk < 2; ++kk) { const LAS unsigned char* vp = V + (16 * kk + 4 * hh + q4) * RC_RS + (32 * w + 16 * g + 4 * p4) * 2; vf[kk] = cat8(tr16(vp), tr16(vp + 8 * RC_RS)); }
#pragma unroll
            for (int dt = 0; dt < 4; ++dt)
#pragma unroll
                for (int kk = 0; kk < 2; ++kk) { const LAS unsigned char* kp = KE + (16 * kk + 4 * hh + q4) * RC_RS + (32 * dt + 16 * g + 4 * p4) * 2;
                    S[dt] = MFMA32(cat8(tr16(kp), tr16(kp + 8 * RC_RS)), vf[kk], S[dt]); }
            if (kind == 0) {
#pragma unroll
                for (int dt = 0; dt < 4; ++dt) S[dt] = S[dt] * Eret;
            } else {
                const LAS unsigned char* EB = L + RC_EOFF + (c & 1) * 512;
#pragma unroll
                for (int dt = 0; dt < 4; ++dt)
#pragma unroll
                    for (int gq = 0; gq < 4; ++gq) { const f32x4 e4 = *(const LAS f32x4*)(EB + (32 * dt + 8 * gq + 4 * hh) * 4);
#pragma unroll
                        for (int e = 0; e < 4; ++e) S[dt][4 * gq + e] *= e4[e]; }
            }
            RC_LDS_BARRIER();
        }
        st_store_plain(S, (float*)(ws + WS_SLOC) + (size_t)(unit * 3 + seg) * 16384 + (size_t)(4 * hh) * 128 + 32 * w + r32);
    }
    __syncthreads();
}
constexpr int SR_DQK = 0, SR_OPART = 8192, SR_RED = SR_OPART + 16384, SR_END = SR_RED + 64;
__device__ __forceinline__ void rec_sample_item(Frame& F, const Args& a, int item) {
    const int kind = item >> 9, bh = item & 511, b = bh >> 2, h = bh & 3;
    unsigned char* ws = a.ws;
    const bf16_t* pb = (const bf16_t*)(ws + WS_PB); const float* lf = (const float*)(ws + WS_LF); bf16_t* ob = (bf16_t*)(ws + WS_OB);
    LAS unsigned char* L = F.lds + RING_OFF;
    LAS float* DEC = (LAS float*)(L + SR_DQK); LAS float* KK = DEC + 512; LAS float* QQ = KK + 512;
    const int lane = lane_id(), w = F.wave, rp = lane >> 5, e4 = (lane & 31) * 4, tid_ = w * 64 + lane;
    const int vcol = kind == 0 ? 1024 + h * 128 : 2560 + h * 128, gcol = kind == 0 ? 1536 + h * 128 : 3072 + h * 128;
    const float* s0 = a.in[kind == 0 ? I_SRET : I_SHG] + (size_t)bh * 16384;
    float* so = a.out + (kind == 0 ? O_RETS : O_HGS) + (size_t)bh * 16384;
    f32x4 S[8];
#pragma unroll
    for (int i = 0; i < 8; ++i) S[i] = *(const f32x4*)(s0 + (size_t)(16 * w + 2 * i + rp) * 128 + e4);
    const int tt = tid_ >> 7, d = tid_ & 127; const size_t rowt = (size_t)MP + b * 4 + tt;
    {
        float dec, k, q;
        if (kind == 0) { const int dp = d < 64 ? 2 * d : 2 * (d - 64) + 1; q = bf2f(pb[rowt * PBW + h * 128 + dp]); k = bf2f(pb[rowt * PBW + 512 + h * 128 + dp]); dec = 1.f - exp2f(-5.f - (float)h); }
        else { const float f = __expf(lf[rowt * 512 + h * 128 + d]); dec = f; k = 1.f - f; q = bf2f(pb[rowt * PBW + 2048 + h * 128 + d]); }
        DEC[tt * 128 + d] = dec; KK[tt * 128 + d] = k; QQ[tt * 128 + d] = q;
    }
    f32x4 v4[4];
#pragma unroll
    for (int t = 0; t < 4; ++t) { const unsigned long long u = *(const unsigned long long*)(pb + ((size_t)MP + b * 4 + t) * PBW + vcol + e4);
        v4[t] = (f32x4){__uint_as_float((unsigned)u << 16), __uint_as_float((unsigned)u & 0xffff0000u), __uint_as_float((unsigned)(u >> 32) << 16), __uint_as_float((unsigned)(u >> 32) & 0xffff0000u)}; }
    __syncthreads();
#pragma unroll
    for (int t = 0; t < 4; ++t) {
        f32x4 o = {0.f, 0.f, 0.f, 0.f};
#pragma unroll
        for (int i = 0; i < 8; ++i) { const int dd = t * 128 + 16 * w + 2 * i + rp; const float dec = DEC[dd], k = KK[dd], q = QQ[dd];
            S[i] = S[i] * dec + v4[t] * k; o += S[i] * q; }
#pragma unroll
        for (int e = 0; e < 4; ++e) o[e] += __shfl_xor(o[e], 32);
        if (rp == 0) *(LAS f32x4*)(L + SR_OPART + ((w * 4 + t) * 128 + e4) * 4) = o;
    }
#pragma unroll
    for (int i = 0; i < 8; ++i) *(f32x4*)(so + (size_t)(16 * w + 2 * i + rp) * 128 + e4) = S[i];
    __syncthreads();
    {
        const int e = d; float o = 0.f;
#pragma unroll
        for (int ww = 0; ww < 8; ++ww) o += *(const LAS float*)(L + SR_OPART + ((ww * 4 + tt) * 128 + e) * 4);
        float ss = wave_sum(o * o);
        LAS float* RED = (LAS float*)(L + SR_RED);
        if (lane == 0) RED[w] = ss;
        __syncthreads();
        ss = RED[w & ~1] + RED[w | 1];
        const float rs = rsqrtf(ss * (1.f / 128.f) + EPS);
        const float val = o * rs * bf2f(pb[rowt * PBW + gcol + e]);
        const float other = __shfl_xor(val, 1);
        if ((e & 1) == 0) *(unsigned*)(ob + rowt * D + kind * 512 + h * 128 + e) = pk_bf16(val, other);
    }
    __syncthreads();
}
constexpr int AT_KRS = 528, AT_VRS = 272, AT_STAGE = 69632, AT_SCR = 2 * AT_STAGE, AT_END = AT_SCR + 1024;
static_assert(128 * AT_KRS <= AT_STAGE && 256 * AT_VRS <= AT_STAGE && AT_END <= RING_BYTES, "attention LDS");
template <int N> struct IC { static constexpr int value = N; };

__device__ __forceinline__ void attn_prompt_unit(Frame& F, const Args& a, int unit) {
    const int b = unit >> 5, head = (unit >> 3) & 3, qb = unit & 7;
    unsigned char* ws = a.ws;
    const bf16_t* Q = (const bf16_t*)(ws + WS_Q); const bf16_t* MK = (const bf16_t*)(ws + WS_MK); const bf16_t* MV = (const bf16_t*)(ws + WS_MV); bf16_t* O = (bf16_t*)(ws + WS_OB);
    LAS unsigned char* L = F.lds + RING_OFF;
    const int lane = lane_id(), w = F.wave, r32 = lane & 31, hh = lane >> 5, g = (lane >> 4) & 1, q4 = (lane & 15) >> 2, p4 = lane & 3, tid = w * 64 + lane;
    const int qrow0 = b * T + qb * 256 + w * 32;
    const bf16_t* qp = Q + (size_t)(qrow0 + r32) * D + head * XHD + 8 * hh;
    u32x4 ld[8];
    const bf16_t* kg = MK + (size_t)(b * NMEM + (tid >> 5)) * D + head * XHD + (tid & 31) * 8;
    const bf16_t* vg = MV + (size_t)(b * NMEM + (tid >> 4)) * D + head * XHD + (tid & 15) * 8;
    const int kl = (tid >> 5) * AT_KRS + (tid & 31) * 16, vl = (tid >> 4) * AT_VRS + (tid & 15) * 16;
    auto load_k = [&](int kh) { const bf16_t* p = kg + (size_t)kh * 128 * D; asm volatile("" : "+v"(p));
#pragma unroll
        for (int j = 0; j < 8; ++j) ld[j] = *(const u32x4*)(p + (size_t)j * 16 * D); };
    auto write_k = [&](int buf) { LAS unsigned char* p = L + buf * AT_STAGE + kl; asm volatile("" : "+v"(p));
#pragma unroll
        for (int j = 0; j < 8; ++j) *(LAS u32x4*)(p + j * 16 * AT_KRS) = ld[j]; };
    auto load_v = [&](int eh) { const bf16_t* p = vg + eh * 128; asm volatile("" : "+v"(p));
#pragma unroll
        for (int j = 0; j < 8; ++j) ld[j] = *(const u32x4*)(p + (size_t)j * 32 * D); };
    auto write_v = [&](int buf) { LAS unsigned char* p = L + buf * AT_STAGE + vl; asm volatile("" : "+v"(p));
#pragma unroll
        for (int j = 0; j < 8; ++j) *(LAS u32x4*)(p + j * 32 * AT_VRS) = ld[j]; };
    f32x16v Sc[8];
#pragma unroll
    for (int m = 0; m < 8; ++m)
#pragma unroll
        for (int i = 0; i < 16; ++i) Sc[m][i] = 0.f;
    auto pass1 = [&](auto KH, int buf) {
        constexpr int kh = decltype(KH)::value;
        const LAS unsigned char* B = L + buf * AT_STAGE + r32 * AT_KRS + 16 * hh;
#pragma unroll
        for (int kb = 0; kb < 4; ++kb) {
            bf16x8v qf[4];
#pragma unroll
            for (int k8 = 0; k8 < 4; ++k8) qf[k8] = *(const bf16x8v*)(qp + 16 * (4 * kb + k8));
#pragma unroll
            for (int k8 = 0; k8 < 4; ++k8)
#pragma unroll
                for (int mt = 0; mt < 4; ++mt) { const bf16x8v kf = *(const LAS bf16x8v*)(B + 32 * mt * AT_KRS + 32 * (4 * kb + k8));
                    Sc[4 * kh + mt] = MFMA32(kf, qf[k8], Sc[4 * kh + mt]); }
        }
    };
    load_k(0); write_k(0); __syncthreads();
    load_k(1); pass1(IC<0>{}, 0); write_k(1); __syncthreads();
    pass1(IC<1>{}, 1);
    load_v(0);
    float mx = Sc[0][0];
#pragma unroll
    for (int m = 0; m < 8; ++m)
#pragma unroll
        for (int i = 0; i < 16; ++i) mx = fmaxf(mx, Sc[m][i]);
    mx = fmaxf(mx, __shfl_xor(mx, 32));
    const float ml = mx * 1.4426950408889634f; float sum = 0.f;
    bf16x8v Pp[8][2];
#pragma unroll
    for (int m = 0; m < 8; ++m) {
#pragma unroll
        for (int i = 0; i < 16; ++i) { const float p = exp2f(Sc[m][i] * 1.4426950408889634f - ml); Sc[m][i] = p; sum += p; }
        Pp[m][0] = pack_step(Sc[m], 0); Pp[m][1] = pack_step(Sc[m], 1);
        asm volatile("" : "+v"(Pp[m][0]), "+v"(Pp[m][1]));
    }
    sum += __shfl_xor(sum, 32);
    LAS float* scr = (LAS float*)(L + AT_SCR) + w * 32;
    if (hh == 0) scr[r32] = 1.f / sum;
    write_v(0); __syncthreads();
    auto pass2 = [&](int eh, int buf) {
        f32x16v Oa[4];
#pragma unroll
        for (int et = 0; et < 4; ++et)
#pragma unroll
            for (int i = 0; i < 16; ++i) Oa[et][i] = 0.f;
        const LAS unsigned char* B = L + buf * AT_STAGE + (4 * hh + q4) * AT_VRS + (16 * g + 4 * p4) * 2;
#pragma unroll
        for (int mt = 0; mt < 8; ++mt)
#pragma unroll
            for (int kk = 0; kk < 2; ++kk)
#pragma unroll
                for (int et = 0; et < 4; ++et) { const LAS unsigned char* vp = B + (32 * mt + 16 * kk) * AT_VRS + 64 * et;
                    Oa[et] = MFMA32(Pp[mt][kk], cat8(tr16(vp), tr16(vp + 8 * AT_VRS)), Oa[et]); }
        f32x4 inv[4];
#pragma unroll
        for (int gq = 0; gq < 4; ++gq) inv[gq] = *(const LAS f32x4*)(scr + 8 * gq + 4 * hh);
#pragma unroll
        for (int et = 0; et < 4; ++et)
#pragma unroll
            for (int i = 0; i < 16; ++i) { const float val = Oa[et][i] * inv[i >> 2][i & 3]; const float other = __shfl_xor(val, 1);
                if (((lane ^ i) & 1) == 0) { const int row = qrow0 + crow(i, hh), col = head * XHD + 128 * eh + 32 * et + (r32 & ~1);
                    *(unsigned*)(O + (size_t)row * D + col) = (lane & 1) ? pk_bf16(other, val) : pk_bf16(val, other); } }
    };
    load_v(1); pass2(0, 0); write_v(1); __syncthreads();
    pass2(1, 1);
    __syncthreads();
}

constexpr int AS_SC = 0, AS_PL = 4096, AS_OPART = 8192, AS_END = AS_OPART + 32768;
__device__ __forceinline__ f32x4 bf4_to_f32(unsigned long long u) {
    return (f32x4){__uint_as_float((unsigned)u << 16), __uint_as_float((unsigned)u & 0xffff0000u), __uint_as_float((unsigned)(u >> 32) << 16), __uint_as_float((unsigned)(u >> 32) & 0xffff0000u)};
}
__device__ __forceinline__ void attn_sample_item(Frame& F, const Args& a, int item) {
    const int b = item >> 2, head = item & 3;
    unsigned char* ws = a.ws;
    const bf16_t* Q = (const bf16_t*)(ws + WS_Q); bf16_t* O = (bf16_t*)(ws + WS_OB);
    const float* Kf = a.in[I_CK] + ((size_t)b * NMEM * XH + head) * XHD; const float* Vf = a.in[I_CV] + ((size_t)b * NMEM * XH + head) * XHD;
    LAS unsigned char* L = F.lds + RING_OFF;
    const int lane = lane_id(), w = F.wave, tid = w * 64 + lane;
    f32x4 q4v[4];
#pragma unroll
    for (int t = 0; t < 4; ++t) q4v[t] = bf4_to_f32(*(const unsigned long long*)(Q + ((size_t)MP + 4 * b + t) * D + head * XHD + 4 * lane));
    float r64[64], r32v[32], r16[16], r8[8], r4[4], r2[2];
#pragma unroll
    for (int pr = 0; pr < 2; ++pr) {
        float pa[32], pbv[32];
#pragma unroll
        for (int half = 0; half < 2; ++half) {
            f32x4 k4[8];
#pragma unroll
            for (int jj = 0; jj < 8; ++jj) k4[jj] = *(const f32x4*)(Kf + (size_t)(32 * w + 16 * half + 8 * pr + jj) * (XH * XHD) + 4 * lane);
#pragma unroll
            for (int jj = 0; jj < 8; ++jj)
#pragma unroll
                for (int t = 0; t < 4; ++t) { const float dv = (q4v[t][0] * k4[jj][0] + q4v[t][1] * k4[jj][1]) + (q4v[t][2] * k4[jj][2] + q4v[t][3] * k4[jj][3]);
                    if (half == 0) pa[jj * 4 + t] = dv; else pbv[jj * 4 + t] = dv; }
        }
        const bool bit = lane & 32;
#pragma unroll
        for (int i = 0; i < 32; ++i) { const float keep = bit ? pbv[i] : pa[i], send = bit ? pa[i] : pbv[i]; r64[32 * pr + i] = keep + __shfl_xor(send, 32); }
    }
    { const bool bit = lane & 16;
#pragma unroll
      for (int i = 0; i < 32; ++i) { const float keep = bit ? r64[i + 32] : r64[i], send = bit ? r64[i] : r64[i + 32]; r32v[i] = keep + __shfl_xor(send, 16); } }
    { const bool bit = lane & 8;
#pragma unroll
      for (int i = 0; i < 16; ++i) { const float keep = bit ? r32v[i + 16] : r32v[i], send = bit ? r32v[i] : r32v[i + 16]; r16[i] = keep + __shfl_xor(send, 8); } }
    { const bool bit = lane & 4;
#pragma unroll
      for (int i = 0; i < 8; ++i) { const float keep = bit ? r16[i + 8] : r16[i], send = bit ? r16[i] : r16[i + 8]; r8[i] = keep + __shfl_xor(send, 4); } }
    { const bool bit = lane & 2;
#pragma unroll
      for (int i = 0; i < 4; ++i) { const float keep = bit ? r8[i + 4] : r8[i], send = bit ? r8[i] : r8[i + 4]; r4[i] = keep + __shfl_xor(send, 2); } }
    { const bool bit = lane & 1;
#pragma unroll
      for (int i = 0; i < 2; ++i) { const float keep = bit ? r4[i + 2] : r4[i], send = bit ? r4[i] : r4[i + 2]; r2[i] = keep + __shfl_xor(send, 1); } }
    { LAS float* SC = (LAS float*)(L + AS_SC); const int m = 32 * w + (lane >> 1), t0 = 2 * (lane & 1); SC[t0 * 256 + m] = r2[0]; SC[(t0 + 1) * 256 + m] = r2[1]; }
    __syncthreads();
    if (w < 4) {
        const f32x4 s4 = *(const LAS f32x4*)(L + AS_SC + (w * 256 + 4 * lane) * 4);
        float mx = fmaxf(fmaxf(s4[0], s4[1]), fmaxf(s4[2], s4[3]));
#pragma unroll
        for (int o = 1; o < 64; o <<= 1) mx = fmaxf(mx, __shfl_xor(mx, o));
        f32x4 p; float sum = 0.f;
#pragma unroll
        for (int e = 0; e < 4; ++e) { p[e] = __expf(s4[e] - mx); sum += p[e]; }
        sum = wave_sum(sum); const float inv = 1.f / sum;
        LAS float* PL = (LAS float*)(L + AS_PL);
#pragma unroll
        for (int e = 0; e < 4; ++e) PL[(4 * lane + e) * 4 + w] = p[e] * inv;
    }
    __syncthreads();
    f32x4 acc[4];
#pragma unroll
    for (int t = 0; t < 4; ++t) acc[t] = (f32x4){0.f, 0.f, 0.f, 0.f};
#pragma unroll
    for (int grp = 0; grp < 4; ++grp) {
        f32x4 v4[8];
#pragma unroll
        for (int jj = 0; jj < 8; ++jj) v4[jj] = *(const f32x4*)(Vf + (size_t)(32 * w + 8 * grp + jj) * (XH * XHD) + 4 * lane);
#pragma unroll
        for (int jj = 0; jj < 8; ++jj) { const f32x4 p4v = *(const LAS f32x4*)(L + AS_PL + (32 * w + 8 * grp + jj) * 16);
#pragma unroll
            for (int t = 0; t < 4; ++t) acc[t] += v4[jj] * p4v[t]; }
    }
#pragma unroll
    for (int t = 0; t < 4; ++t) *(LAS f32x4*)(L + AS_OPART + ((w * 4 + t) * 256 + 4 * lane) * 4) = acc[t];
    __syncthreads();
    { const int t = tid >> 7, c2 = (tid & 127) * 2; float o0 = 0.f, o1 = 0.f;
#pragma unroll
      for (int ww = 0; ww < 8; ++ww) { const f32x2_t v = *(const LAS f32x2_t*)(L + AS_OPART + ((ww * 4 + t) * 256 + c2) * 4); o0 += v[0]; o1 += v[1]; }
      *(unsigned*)(O + ((size_t)MP + 4 * b + t) * D + head * XHD + c2) = pk_bf16(o0, o1); }
    __syncthreads();
}
constexpr int MU_SLAB = 32 * 64 * 4;
constexpr int MU_KC = 256, MU_ABYTES = 32 * MU_KC * 2, MU_WBYTES = 64 * MU_KC * 2, MU_BUF = MU_ABYTES + MU_WBYTES; static_assert(3 * MU_BUF <= RING_BYTES, "mini LDS");
template <class G>
__device__ __forceinline__ void mini_unit(Frame& F, const bf16_t* __restrict__ A, const bf16_t* __restrict__ Wt, int K, int unit, const G& gran) {
    const int rb = unit >> 4, cb = unit & 15;
    const int lane = lane_id(), w = F.wave, r32 = lane & 31, hh = lane >> 5, ct = w & 1, ks = w >> 1;
    LAS unsigned char* L = F.lds + RING_OFF;
    const int lrow = lane >> 5, lpos = lane & 31;
    auto dma = [&](int ch, int buf) {
#pragma unroll
        for (int j = 0; j < 6; ++j) {
            const int idx = w * 6 + j;
            const bool isA = idx < 16; const int pr = isA ? idx : idx - 16, row = 2 * pr + lrow;
            const bf16_t* src = (isA ? A + (size_t)(MP + 32 * rb + row) * K : Wt + (size_t)(64 * cb + row) * K) + ch * MU_KC + ((lpos ^ (row & 31)) << 3);
            LAS unsigned char* dst = L + buf * MU_BUF + (isA ? 0 : MU_ABYTES) + pr * 1024;
            __builtin_amdgcn_global_load_lds((const unsigned*)src, (LAS unsigned*)dst, 16, 0, 0);
        }
    };
    f32x16v acc;
#pragma unroll
    for (int i = 0; i < 16; ++i) acc[i] = 0.f;
    const int nch = K / MU_KC;
    dma(0, 0); dma(1, 1);
    for (int ch = 0; ch < nch; ++ch) {
        if (ch + 1 < nch) asm volatile("s_waitcnt vmcnt(6) lgkmcnt(0)" ::: "memory"); else asm volatile("s_waitcnt vmcnt(0) lgkmcnt(0)" ::: "memory");
        __builtin_amdgcn_s_barrier(); asm volatile("" ::: "memory");
        const int bsel = ch % 3;
        if (ch + 2 < nch) dma(ch + 2, (ch + 2) % 3);
        const LAS unsigned char* Ab = L + bsel * MU_BUF + r32 * 512;
        const LAS unsigned char* Wb = L + bsel * MU_BUF + MU_ABYTES + (32 * ct + r32) * 512;
#pragma unroll
        for (int s = 0; s < 4; ++s) { const int c = 8 * ks + 2 * s + hh;
            const bf16x8v af = *(const LAS bf16x8v*)(Ab + ((c ^ r32) << 4)), wf = *(const LAS bf16x8v*)(Wb + ((c ^ r32) << 4));
            acc = MFMA32(wf, af, acc); }
    }
    asm volatile("s_waitcnt lgkmcnt(0)" ::: "memory"); __builtin_amdgcn_s_barrier(); asm volatile("" ::: "memory");
    { LAS float* C = (LAS float*)(L + ks * MU_SLAB) + r32 * 64 + 32 * ct;
#pragma unroll
      for (int gq = 0; gq < 4; ++gq) *(LAS f32x4*)(C + 8 * gq + 4 * hh) = (f32x4){acc[4 * gq], acc[4 * gq + 1], acc[4 * gq + 2], acc[4 * gq + 3]}; }
    __syncthreads();
    { const int tid = w * 64 + lane, m = tid >> 4, g = tid & 15;
      const LAS f32x4* C = (const LAS f32x4*)(L + (m * 64 + 4 * g) * 4);
      const f32x4 v = (C[0] + C[MU_SLAB / 16]) + (C[2 * MU_SLAB / 16] + C[3 * MU_SLAB / 16]);
      gran(MP + 32 * rb + m, 64 * cb + 4 * g, v, cb, g); }
    __syncthreads();
}
struct GranResid {
    const float* xold_s; float* y; bf16_t* xb; float* st;
    __device__ __forceinline__ void operator()(int row, int col, const f32x4& acc, int cb, int g) const {
        const f32x4 v = *(const f32x4*)(xold_s + (size_t)(row - MP) * D + col) + acc;
        *(f32x4*)(y + (size_t)row * D + col) = v;
        *(unsigned long long*)(xb + (size_t)row * D + col) = (unsigned long long)pk_bf16(v[0], v[1]) | ((unsigned long long)pk_bf16(v[2], v[3]) << 32);
        float ss = (v[0] * v[0] + v[1] * v[1]) + (v[2] * v[2] + v[3] * v[3]);
        ss += __shfl_xor(ss, 1); ss += __shfl_xor(ss, 2); ss += __shfl_xor(ss, 4); ss += __shfl_xor(ss, 8);
        if (g == 0) st[(size_t)row * 16 + cb] = ss;
    }
};
struct GranScale {
    const float* st; bf16_t* o; float scale;
    __device__ __forceinline__ void operator()(int row, int col, const f32x4& acc, int, int) const {
        const float rs = row_rs(st, row) * scale;
        *(unsigned long long*)(o + (size_t)row * D + col) = (unsigned long long)pk_bf16(acc[0] * rs, acc[1] * rs) | ((unsigned long long)pk_bf16(acc[2] * rs, acc[3] * rs) << 32);
    }
};
#define IN_REC(lo, hi) ((lo) <= 2 && 2 < (hi))
#ifndef ECHO_PHASE
#define ECHO_PHASE (-1)
#endif
#ifndef DUP_PHASE
#define DUP_PHASE (-1)
#endif
enum { PH_PREP = 0, PH_INPROJ = 1, PH_REC = 2, PH_OUTPROJ = 3, PH_XQ = 4, PH_ATTN = 5, PH_XO = 6, PH_GU = 7, PH_DOWN = 8, PH_FINAL = 9, PH_MEMKV = 10, PH_COUNT = 11 };

__global__ void __launch_bounds__(NWAVES * 64, 2) mega(Args args) {
    extern __shared__ __attribute__((aligned(16))) unsigned char lds[];
    Frame F;
    F.lds = (LAS unsigned char*)lds; F.MISC = (volatile LAS unsigned*)(F.lds + MISC_OFF);
    F.wave = __builtin_amdgcn_readfirstlane((int)threadIdx.x >> 6);
    F.G = gridDim.x; { const int bx = blockIdx.x; F.vcu = (F.G % 8 == 0) ? (bx % 8) * (F.G / 8) + bx / 8 : bx; }
    unsigned char* ws = args.ws;
    F.ctl = (gu32*)(ws + WS_CTL);
    for (int u = (int)threadIdx.x; u < (LDS_BYTES - LDSCTL_OFF) / 4; u += NWAVES * 64) ((LAS unsigned*)(F.lds + LDSCTL_OFF))[u] = 0u;
    __syncthreads();
    const int lo = args.ph_lo, hi = args.ph_hi;
    unsigned long long echo_t0 = 0, echo_t1 = 0;
    XcdBarrier bar; bar.bar = (unsigned*)(F.ctl + CW_BAR) + args.li * XCD_BAR_WORDS; bar.x = 0; bar.st = nullptr; bar.wave = F.wave;
    if (hi - lo > 1 || IN_REC(lo, hi)) bar = xcd_barrier_post((unsigned*)(F.ctl + CW_BAR) + args.li * XCD_BAR_WORDS, F.MISC + 8, F.wave);
#define IN(k) (lo <= (k) && (k) < hi)
#define BOTH(k) (IN(k) && IN((k) + 1))
    if (ECHO_PHASE == PH_PREP) echo_t0 = __builtin_amdgcn_s_memrealtime();
    if (IN(PH_PREP)) for (int rep = 0; rep < (DUP_PHASE == PH_PREP ? 2 : 1); ++rep) { phase_prep(F, args); if (BOTH(PH_PREP) || rep + 1 < (DUP_PHASE == PH_PREP ? 2 : 1)) xcd_barrier(bar); }
    if (ECHO_PHASE == PH_PREP) echo_t1 = __builtin_amdgcn_s_memrealtime();
    if (ECHO_PHASE == PH_INPROJ) echo_t0 = __builtin_amdgcn_s_memrealtime();
    if (IN(PH_INPROJ)) for (int rep = 0; rep < (DUP_PHASE == PH_INPROJ ? 2 : 1); ++rep) {
        pg8::Gemm g{(const bf16_t*)(ws + WS_XB0), (const bf16_t*)(ws + WS_W_IN), MT, INW, D};
        pg8::StaticOrder S; S.init(MT, INW, F.G, (int)blockIdx.x);
        EpiInProj E{(const float*)(ws + WS_RS0), (const float*)(ws + WS_CS), (const float*)(ws + WS_LOW), args.in[I_RGAIN], args.in[I_HGAIN], (bf16_t*)(ws + WS_PB), (float*)(ws + WS_LF)};
        pg8::gemm_phase<EpiInProj, pg8::StaticOrder, PG8_ALIGN, PG8_SP2>(F.lds + RING_OFF, g, S, E, F.wave);
        {
            pg8::Gemm g2{(const bf16_t*)(ws + WS_MB), (const bf16_t*)(ws + WS_W_KV), MMEM, 2 * D, D};
            pg8::StaticOrder S2; S2.init(MMEM, 2 * D, F.G, F.G - 1 - (int)blockIdx.x);
            EpiMemKV E2{(const float*)(ws + WS_RSM), args.out + O_MEMK, args.out + O_MEMV, (bf16_t*)(ws + WS_MK), (bf16_t*)(ws + WS_MV)};
            pg8::gemm_phase<EpiMemKV, pg8::StaticOrder, PG8_ALIGN, PG8_SP2>(F.lds + RING_OFF, g2, S2, E2, F.wave);
        }
        if (F.G == 256 && (int)blockIdx.x >= 32 && (int)blockIdx.x < 192) convert_items(F, args, CV_EARLY, CV_ALL, ((int)blockIdx.x - 32) * NWAVES + F.wave, 160 * NWAVES);
        if (BOTH(PH_INPROJ) || rep + 1 < (DUP_PHASE == PH_INPROJ ? 2 : 1)) xcd_barrier(bar);
    }
    if (ECHO_PHASE == PH_INPROJ) echo_t1 = __builtin_amdgcn_s_memrealtime();
    if (ECHO_PHASE == PH_REC) echo_t0 = __builtin_amdgcn_s_memrealtime();
    if (IN(PH_REC)) for (int rep = 0; rep < (DUP_PHASE == PH_REC ? 2 : 1); ++rep) {
        { const int bid = (int)blockIdx.x;
          for (int u = bid; u < 192; u += F.G) rec_state_unit(F, args, u / 3, u % 3);
          for (int it = bid; it < 1024; it += F.G) rec_sample_item(F, args, it);
          xcd_barrier(bar);
          for (int u = bid; u < 256; u += F.G) rec_prompt_unit(F, args, u >> 2, u & 3); }
        if (BOTH(PH_REC) || rep + 1 < (DUP_PHASE == PH_REC ? 2 : 1)) xcd_barrier(bar);
    }
    if (ECHO_PHASE == PH_REC) echo_t1 = __builtin_amdgcn_s_memrealtime();
    if (ECHO_PHASE == PH_OUTPROJ) echo_t0 = __builtin_amdgcn_s_memrealtime();
    if (IN(PH_OUTPROJ)) for (int rep = 0; rep < (DUP_PHASE == PH_OUTPROJ ? 2 : 1); ++rep) {
        pg8::Gemm g{(const bf16_t*)(ws + WS_OB), (const bf16_t*)(ws + WS_W_OUT), MP, D, D};
        pg8::StaticOrder S; S.init(MP, D, F.G, (int)blockIdx.x);
        EpiResid E{args.in[I_XP], args.in[I_XS], args.out + O_Y, (bf16_t*)(ws + WS_XB1), (float*)(ws + WS_ST1)};
        pg8::gemm_phase<EpiResid, pg8::StaticOrder, PG8_ALIGN, PG8_SP2>(F.lds + RING_OFF, g, S, E, F.wave);
        { GranResid Gm{args.in[I_XS], args.out + O_Y, (bf16_t*)(ws + WS_XB1), (float*)(ws + WS_ST1)};
          for (int u = (int)blockIdx.x; u < 256; u += F.G) mini_unit(F, (const bf16_t*)(ws + WS_OB), (const bf16_t*)(ws + WS_W_OUT), D, u, Gm); }
        if (BOTH(PH_OUTPROJ) || rep + 1 < (DUP_PHASE == PH_OUTPROJ ? 2 : 1)) xcd_barrier(bar);
    }
    if (ECHO_PHASE == PH_OUTPROJ) echo_t1 = __builtin_amdgcn_s_memrealtime();
    if (ECHO_PHASE == PH_XQ) echo_t0 = __builtin_amdgcn_s_memrealtime();
    if (IN(PH_XQ)) for (int rep = 0; rep < (DUP_PHASE == PH_XQ ? 2 : 1); ++rep) {
        pg8::Gemm g{(const bf16_t*)(ws + WS_XB1), (const bf16_t*)(ws + WS_W_XQ), MP, D, D};
        pg8::StaticOrder S; S.init(MP, D, F.G, (int)blockIdx.x);
        EpiScaleBf16 E{(const float*)(ws + WS_ST1), (bf16_t*)(ws + WS_Q), 0.0625f};
        pg8::gemm_phase<EpiScaleBf16, pg8::StaticOrder, PG8_ALIGN, PG8_SP2>(F.lds + RING_OFF, g, S, E, F.wave);
        { GranScale Gm{(const float*)(ws + WS_ST1), (bf16_t*)(ws + WS_Q), 0.0625f};
          for (int u = (int)blockIdx.x; u < 256; u += F.G) mini_unit(F, (const bf16_t*)(ws + WS_XB1), (const bf16_t*)(ws + WS_W_XQ), D, u, Gm); }
        if (BOTH(PH_XQ) || rep + 1 < (DUP_PHASE == PH_XQ ? 2 : 1)) xcd_barrier(bar);
    }
    if (ECHO_PHASE == PH_XQ) echo_t1 = __builtin_amdgcn_s_memrealtime();
    if (ECHO_PHASE == PH_ATTN) echo_t0 = __builtin_amdgcn_s_memrealtime();
    if (IN(PH_ATTN)) for (int rep = 0; rep < (DUP_PHASE == PH_ATTN ? 2 : 1); ++rep) {
        for (int u = (int)blockIdx.x; u < 256; u += F.G) attn_prompt_unit(F, args, u);
        for (int it = (int)blockIdx.x; it < 512; it += F.G) attn_sample_item(F, args, it);
        if (BOTH(PH_ATTN) || rep + 1 < (DUP_PHASE == PH_ATTN ? 2 : 1)) xcd_barrier(bar);
    }
    if (ECHO_PHASE == PH_ATTN) echo_t1 = __builtin_amdgcn_s_memrealtime();
    if (ECHO_PHASE == PH_XO) echo_t0 = __builtin_amdgcn_s_memrealtime();
    if (IN(PH_XO)) for (int rep = 0; rep < (DUP_PHASE == PH_XO ? 2 : 1); ++rep) {
        pg8::Gemm g{(const bf16_t*)(ws + WS_OB), (const bf16_t*)(ws + WS_W_XO), MP, D, D};
        pg8::StaticOrder S; S.init(MP, D, F.G, (int)blockIdx.x);
        EpiResid E{args.out + O_Y, args.out + O_Y + (size_t)MP * D, (float*)(ws + WS_Y2), (bf16_t*)(ws + WS_XB2), (float*)(ws + WS_ST2)};
        pg8::gemm_phase<EpiResid, pg8::StaticOrder, PG8_ALIGN, PG8_SP2>(F.lds + RING_OFF, g, S, E, F.wave);
        { GranResid Gm{args.out + O_Y + (size_t)MP * D, (float*)(ws + WS_Y2), (bf16_t*)(ws + WS_XB2), (float*)(ws + WS_ST2)};
          for (int u = (int)blockIdx.x; u < 256; u += F.G) mini_unit(F, (const bf16_t*)(ws + WS_OB), (const bf16_t*)(ws + WS_W_XO), D, u, Gm); }
        if (BOTH(PH_XO) || rep + 1 < (DUP_PHASE == PH_XO ? 2 : 1)) xcd_barrier(bar);
    }
    if (ECHO_PHASE == PH_XO) echo_t1 = __builtin_amdgcn_s_memrealtime();
    if (ECHO_PHASE == PH_GU) echo_t0 = __builtin_amdgcn_s_memrealtime();
    if (IN(PH_GU)) for (int rep = 0; rep < (DUP_PHASE == PH_GU ? 2 : 1); ++rep) {
        pg8::Gemm g{(const bf16_t*)(ws + WS_XB2), (const bf16_t*)(ws + WS_W_GU), MT, 2 * DFF, D};
        pg8::StaticOrder S; S.init(MT, 2 * DFF, F.G, (int)blockIdx.x);
        EpiGateUp E{(const float*)(ws + WS_ST2), (bf16_t*)(ws + WS_ACT)};
        pg8::gemm_phase<EpiGateUp, pg8::StaticOrder, PG8_ALIGN, PG8_SP2>(F.lds + RING_OFF, g, S, E, F.wave);
        if (BOTH(PH_GU) || rep + 1 < (DUP_PHASE == PH_GU ? 2 : 1)) xcd_barrier(bar);
    }
    if (ECHO_PHASE == PH_GU) echo_t1 = __builtin_amdgcn_s_memrealtime();
    if (ECHO_PHASE == PH_DOWN) echo_t0 = __builtin_amdgcn_s_memrealtime();
    if (IN(PH_DOWN)) for (int rep = 0; rep < (DUP_PHASE == PH_DOWN ? 2 : 1); ++rep) {
        pg8::Gemm g{(const bf16_t*)(ws + WS_ACT), (const bf16_t*)(ws + WS_W_DN), MP, D, DFF};
        pg8::StaticOrder S; S.init(MP, D, F.G, (int)blockIdx.x);
        EpiResid E{(const float*)(ws + WS_Y2), (const float*)(ws + WS_Y2) + (size_t)MP * D, (float*)(ws + WS_Y3), (bf16_t*)(ws + WS_XB1), (float*)(ws + WS_ST3)};
        pg8::gemm_phase<EpiResid, pg8::StaticOrder, PG8_ALIGN, PG8_SP2>(F.lds + RING_OFF, g, S, E, F.wave);
        { GranResid Gm{(const float*)(ws + WS_Y2) + (size_t)MP * D, (float*)(ws + WS_Y3), (bf16_t*)(ws + WS_XB1), (float*)(ws + WS_ST3)};
          for (int u = (int)blockIdx.x; u < 256; u += F.G) mini_unit(F, (const bf16_t*)(ws + WS_ACT), (const bf16_t*)(ws + WS_W_DN), DFF, u, Gm); }
        if (BOTH(PH_DOWN) || rep + 1 < (DUP_PHASE == PH_DOWN ? 2 : 1)) xcd_barrier(bar);
    }
    if (ECHO_PHASE == PH_DOWN) echo_t1 = __builtin_amdgcn_s_memrealtime();
    if (ECHO_PHASE == PH_FINAL) echo_t0 = __builtin_amdgcn_s_memrealtime();
    if (IN(PH_FINAL)) for (int rep = 0; rep < (DUP_PHASE == PH_FINAL ? 2 : 1); ++rep) { phase_final(F, args); if (rep + 1 < (DUP_PHASE == PH_FINAL ? 2 : 1)) xcd_barrier(bar); }
    if (ECHO_PHASE == PH_FINAL) echo_t1 = __builtin_amdgcn_s_memrealtime();
    if (ECHO_PHASE >= 0 && blockIdx.x == 0) { const unsigned long long te = __builtin_amdgcn_s_memrealtime(); while (__builtin_amdgcn_s_memrealtime() - te < echo_t1 - echo_t0) __builtin_amdgcn_s_sleep(4); }
#undef IN
#undef BOTH
}

__global__ void __launch_bounds__(128) mixer_naive2(const bf16_t* __restrict__ pb, const float* __restrict__ lf, const float* __restrict__ s0_ret, const float* __restrict__ s0_hg,
                                                    float* __restrict__ sout_ret, float* __restrict__ sout_hg, float* o_f32, bf16_t* ob, int Tn, int row0, int prompt) {
    __shared__ float qs[128], ks[128], fs[128], red[2];
    const int bh = blockIdx.x, b = bh >> 2, h = bh & 3, e = threadIdx.x, kind = blockIdx.y;
    float S[128];
    const float* s0 = kind == 0 ? s0_ret : s0_hg;
#pragma unroll
    for (int d = 0; d < 128; ++d) { const int dor = kind == 0 ? ((d & 1) ? 64 + (d >> 1) : (d >> 1)) : d; S[d] = s0 ? s0[((size_t)bh * 128 + dor) * 128 + e] : 0.f; }
    const float gamma = 1.f - exp2f(-5.f - (float)h);
    for (int t = 0; t < Tn; ++t) {
        const size_t row = (size_t)row0 + (size_t)b * Tn + t;
        const bf16_t* pr = pb + row * PBW;
        __syncthreads();
        if (kind == 0) {
            float q = bf2f(pr[h * 128 + e]), k = bf2f(pr[512 + h * 128 + e]);
            if (prompt) { const float n = (float)((t & 31) + 1); q *= powf(gamma, -n); k *= powf(gamma, n); }
            qs[e] = q; ks[e] = k; fs[e] = gamma;
        } else {
            const float f = expf(lf[row * 512 + h * 128 + e]);
            fs[e] = f; ks[e] = 1.f - f; qs[e] = bf2f(pr[2048 + h * 128 + e]);
        }
        __syncthreads();
        const float v = bf2f(kind == 0 ? pr[1024 + h * 128 + e] : pr[2560 + h * 128 + e]);
        float o = 0.f;
#pragma unroll
        for (int d = 0; d < 128; ++d) { S[d] = fs[d] * S[d] + ks[d] * v; o += qs[d] * S[d]; }
        float ss = o * o;
        for (int of = 32; of > 0; of >>= 1) ss += __shfl_xor(ss, of);
        __syncthreads();
        if ((e & 63) == 0) red[e >> 6] = ss;
        __syncthreads();
        ss = red[0] + red[1];
        const float rs = rsqrtf(ss * (1.f / 128.f) + EPS);
        const float gate = bf2f(kind == 0 ? pr[1536 + h * 128 + e] : pr[3072 + h * 128 + e]);
        const float val = o * rs * gate;
        if (o_f32) o_f32[((size_t)b * Tn + t) * D + kind * 512 + h * 128 + e] = val;
        if (ob) { const float other = __shfl_xor(val, 1); if ((e & 1) == 0) *(unsigned*)(ob + row * D + kind * 512 + h * 128 + e) = pk_bf16(val, other); }
    }
    float* so = kind == 0 ? sout_ret : sout_hg;
#pragma unroll
    for (int d = 0; d < 128; ++d) { const int dor = kind == 0 ? ((d & 1) ? 64 + (d >> 1) : (d >> 1)) : d; so[((size_t)bh * 128 + dor) * 128 + e] = S[d]; }
}
__global__ void __launch_bounds__(256) xattn_naive2(const bf16_t* __restrict__ q, const bf16_t* __restrict__ Kb, const bf16_t* __restrict__ Vb, const float* __restrict__ Kf, const float* __restrict__ Vf,
                                                    bf16_t* __restrict__ out, int row0, int tpb) {
    __shared__ float qs[256], ps[256], red[4];
    const int r = blockIdx.x, head = blockIdx.y, b = r / tpb, tid = threadIdx.x; const size_t row = (size_t)row0 + r;
    qs[tid] = bf2f(q[row * D + head * XHD + tid]);
    __syncthreads();
    const size_t kro = (((size_t)b * NMEM + tid) * XH + head) * XHD;
    float s = 0.f;
    for (int d = 0; d < XHD; ++d) s += qs[d] * (Kf ? Kf[kro + d] : bf2f(Kb[kro + d]));
    for (int o = 32; o > 0; o >>= 1) {}
    float mx = s;
    for (int o = 32; o > 0; o >>= 1) mx = fmaxf(mx, __shfl_xor(mx, o));
    if ((tid & 63) == 0) red[tid >> 6] = mx;
    __syncthreads();
    mx = fmaxf(fmaxf(red[0], red[1]), fmaxf(red[2], red[3]));
    __syncthreads();
    const float p = expf(s - mx);
    float sum = p;
    for (int o = 32; o > 0; o >>= 1) sum += __shfl_xor(sum, o);
    if ((tid & 63) == 0) red[tid >> 6] = sum;
    __syncthreads();
    sum = (red[0] + red[1]) + (red[2] + red[3]);
    ps[tid] = p / sum;
    __syncthreads();
    float o = 0.f;
    for (int m = 0; m < NMEM; ++m) { const size_t vo = (((size_t)b * NMEM + m) * XH + head) * XHD + tid; o += ps[m] * (Vf ? Vf[vo] : bf2f(Vb[vo])); }
    const float other = __shfl_xor(o, 1);
    if ((tid & 1) == 0) *(unsigned*)(out + row * D + head * XHD + tid) = pk_bf16(o, other);
}
}
namespace nv {
constexpr int D = 1024, T = 2048, NB = 8, MP = NB * T, SB = 128, ST = 4, MS = SB * ST;
constexpr int INW = 4096, NMEM = 256, XH = 4, XHD = 256, DFF = 2816, PAST = 16384;
constexpr float EPS = 1e-6f;

struct RopeTab { float inv_freq[64]; };

__device__ __forceinline__ void sincos_d(double x, double& s, double& c) {
    const double two_over_pi = 0.63661977236758134308;
    const double pio2_hi = 1.57079632673412561417e+00, pio2_lo = 6.07710050650619224932e-11, pio2_lo2 = 2.02226624879595063154e-21;
    double qd = rint(x * two_over_pi);
    double r = x - qd * pio2_hi; r -= qd * pio2_lo; r -= qd * pio2_lo2;
    long long q = (long long)qd;
    double r2 = r * r;
    double sp = r * (1.0 + r2 * (-1.0 / 6 + r2 * (1.0 / 120 + r2 * (-1.0 / 5040 + r2 * (1.0 / 362880 + r2 * (-1.0 / 39916800 + r2 * (1.0 / 6227020800.0 + r2 * (-1.0 / 1307674368000.0))))))));
    double cp = 1.0 + r2 * (-0.5 + r2 * (1.0 / 24 + r2 * (-1.0 / 720 + r2 * (1.0 / 40320 + r2 * (-1.0 / 3628800 + r2 * (1.0 / 479001600.0 + r2 * (-1.0 / 87178291200.0 + r2 * (1.0 / 20922789888000.0))))))));
    switch (q & 3) {
        case 0: s = sp; c = cp; break;
        case 1: s = cp; c = -sp; break;
        case 2: s = -sp; c = -cp; break;
        default: s = -cp; c = sp; break;
    }
}

__device__ __forceinline__ float silu_f(float x) { return x / (1.f + expf(-x)); }
__device__ __forceinline__ float sigmoid_f(float x) { return 1.f / (1.f + expf(-x)); }

__device__ __forceinline__ float block_sum_256(float v, float* red) {
    for (int o = 32; o > 0; o >>= 1) v += __shfl_xor(v, o);
    const int w = threadIdx.x >> 6;
    __syncthreads();
    if ((threadIdx.x & 63) == 0) red[w] = v;
    __syncthreads();
    float s = 0.f;
    for (int i = 0; i < (int)(blockDim.x >> 6); ++i) s += red[i];
    return s;
}
__device__ __forceinline__ float block_max_256(float v, float* red) {
    for (int o = 32; o > 0; o >>= 1) v = fmaxf(v, __shfl_xor(v, o));
    const int w = threadIdx.x >> 6;
    __syncthreads();
    if ((threadIdx.x & 63) == 0) red[w] = v;
    __syncthreads();
    float s = red[0];
    for (int i = 1; i < (int)(blockDim.x >> 6); ++i) s = fmaxf(s, red[i]);
    return s;
}

__global__ void __launch_bounds__(256) rmsnorm_k(const float* x, const float* __restrict__ g, float* y) {
    __shared__ float red[4];
    const size_t row = blockIdx.x;
    const float4 v = ((const float4*)(x + row * D))[threadIdx.x];
    float ss = v.x * v.x + v.y * v.y + v.z * v.z + v.w * v.w;
    ss = block_sum_256(ss, red);
    const float rs = rsqrtf(ss * (1.f / D) + EPS);
    const float4 gg = ((const float4*)g)[threadIdx.x];
    float4 o; o.x = v.x * rs * gg.x; o.y = v.y * rs * gg.y; o.z = v.z * rs * gg.z; o.w = v.w * rs * gg.w;
    ((float4*)(y + row * D))[threadIdx.x] = o;
}

template <int MODE>
__global__ void __launch_bounds__(256) gemm_naive(const float* __restrict__ A, const float* __restrict__ B, const float* __restrict__ B2,
                                                  const float* R, float* C, int M, int N, int K) {
    __shared__ float As[16][64 + 4];
    __shared__ float Bs[16][64 + 4];
    __shared__ float Bs2[MODE == 2 ? 16 : 1][64 + 4];
    const int tx = threadIdx.x & 15, ty = threadIdx.x >> 4;
    const int m0 = blockIdx.y * 64, n0 = blockIdx.x * 64;
    float acc[4][4] = {}, acc2[4][4] = {};
    for (int k0 = 0; k0 < K; k0 += 16) {
        {
            const int r = threadIdx.x >> 2, c4 = (threadIdx.x & 3) * 4;
            const float4 v = *(const float4*)(A + (size_t)(m0 + r) * K + k0 + c4);
            As[c4 + 0][r] = v.x; As[c4 + 1][r] = v.y; As[c4 + 2][r] = v.z; As[c4 + 3][r] = v.w;
            const int kr = threadIdx.x >> 4, c = (threadIdx.x & 15) * 4;
            const float4 w = *(const float4*)(B + (size_t)(k0 + kr) * N + n0 + c);
            Bs[kr][c] = w.x; Bs[kr][c + 1] = w.y; Bs[kr][c + 2] = w.z; Bs[kr][c + 3] = w.w;
            if (MODE == 2) {
                const float4 w2 = *(const float4*)(B2 + (size_t)(k0 + kr) * N + n0 + c);
                Bs2[kr][c] = w2.x; Bs2[kr][c + 1] = w2.y; Bs2[kr][c + 2] = w2.z; Bs2[kr][c + 3] = w2.w;
            }
        }
        __syncthreads();
#pragma unroll
        for (int kk = 0; kk < 16; ++kk) {
            float a[4], b[4], b2[4];
#pragma unroll
            for (int i = 0; i < 4; ++i) a[i] = As[kk][ty * 4 + i];
#pragma unroll
            for (int j = 0; j < 4; ++j) { b[j] = Bs[kk][tx * 4 + j]; b2[j] = (MODE == 2) ? Bs2[kk][tx * 4 + j] : 0.f; }
#pragma unroll
            for (int i = 0; i < 4; ++i)
#pragma unroll
                for (int j = 0; j < 4; ++j) { acc[i][j] += a[i] * b[j]; if (MODE == 2) acc2[i][j] += a[i] * b2[j]; }
        }
        __syncthreads();
    }
#pragma unroll
    for (int i = 0; i < 4; ++i) {
        const size_t off = (size_t)(m0 + ty * 4 + i) * N + n0 + tx * 4;
        float4 o;
        if (MODE == 0) { o.x = acc[i][0]; o.y = acc[i][1]; o.z = acc[i][2]; o.w = acc[i][3]; }
        else if (MODE == 1) { const float4 r = *(const float4*)(R + off); o.x = r.x + acc[i][0]; o.y = r.y + acc[i][1]; o.z = r.z + acc[i][2]; o.w = r.w + acc[i][3]; }
        else { o.x = silu_f(acc[i][0]) * acc2[i][0]; o.y = silu_f(acc[i][1]) * acc2[i][1]; o.z = silu_f(acc[i][2]) * acc2[i][2]; o.w = silu_f(acc[i][3]) * acc2[i][3]; }
        *(float4*)(C + off) = o;
    }
}

__global__ void __launch_bounds__(128) mixer_naive(const float* __restrict__ proj, const float* __restrict__ s0_ret, const float* __restrict__ s0_hg,
                                                   float* __restrict__ sout_ret, float* __restrict__ sout_hg, float* __restrict__ o_out,
                                                   const float* __restrict__ ret_gain, const float* __restrict__ hg_gain, const float* __restrict__ hg_lb,
                                                   int Tn, int pos0, RopeTab rt) {
    __shared__ float qs[128], ks[128], fs[128], red[2];
    const int bh = blockIdx.x, b = bh >> 2, h = bh & 3, e = threadIdx.x, kind = blockIdx.y;
    float S[128];
    const float* s0 = kind == 0 ? s0_ret : s0_hg;
#pragma unroll
    for (int d = 0; d < 128; ++d) S[d] = s0 ? s0[((size_t)bh * 128 + d) * 128 + e] : 0.f;
    const float gamma = 1.f - exp2f(-5.f - (float)h);
    float lower = 0.f;
    if (kind == 1) { const float a = hg_lb[h * 128 + e], c = hg_lb[512 + h * 128 + e]; const float m = fmaxf(a, c); const float ea = expf(a - m), ec = expf(c - m); lower = ea / (ea + ec); }
    for (int t = 0; t < Tn; ++t) {
        const float* pr = proj + (size_t)(b * Tn + t) * INW;
        __syncthreads();
        if (kind == 0) {
            if (e < 64) {
                const float ang = (float)(pos0 + t) * rt.inv_freq[e];
                double sd, cd; sincos_d((double)ang, sd, cd);
                const float cs = (float)cd, sn = (float)sd;
                const float q1 = pr[h * 128 + e], q2 = pr[h * 128 + e + 64];
                qs[e] = q1 * cs - q2 * sn; qs[e + 64] = q1 * sn + q2 * cs;
                const float k1 = pr[512 + h * 128 + e], k2 = pr[512 + h * 128 + e + 64];
                const float sc = 0.08838834764831845f;
                ks[e] = (k1 * cs - k2 * sn) * sc; ks[e + 64] = (k1 * sn + k2 * cs) * sc;
            }
            fs[e] = gamma;
        } else {
            const float f = lower + (1.f - lower) * sigmoid_f(pr[2560 + h * 128 + e]);
            fs[e] = f; ks[e] = 1.f - f; qs[e] = silu_f(pr[2048 + h * 128 + e]);
        }
        __syncthreads();
        const float v = kind == 0 ? pr[1024 + h * 128 + e] : pr[3072 + h * 128 + e];
        float o = 0.f;
#pragma unroll
        for (int d = 0; d < 128; ++d) { S[d] = fs[d] * S[d] + ks[d] * v; o += qs[d] * S[d]; }
        float ss = o * o;
        for (int of = 32; of > 0; of >>= 1) ss += __shfl_xor(ss, of);
        __syncthreads();
        if ((e & 63) == 0) red[e >> 6] = ss;
        __syncthreads();
        ss = red[0] + red[1];
        const float rs = rsqrtf(ss * (1.f / 128.f) + EPS);
        const float gate = kind == 0 ? pr[1536 + h * 128 + e] : pr[3584 + h * 128 + e];
        const float gn = kind == 0 ? ret_gain[h * 128 + e] : hg_gain[h * 128 + e];
        o_out[(size_t)(b * Tn + t) * D + kind * 512 + h * 128 + e] = o * rs * gn * silu_f(gate);
    }
    float* so = kind == 0 ? sout_ret : sout_hg;
#pragma unroll
    for (int d = 0; d < 128; ++d) so[((size_t)bh * 128 + d) * 128 + e] = S[d];
}

__global__ void __launch_bounds__(256) xattn_naive(const float* __restrict__ q, const float* __restrict__ K, const float* __restrict__ V, float* __restrict__ out, int tpb) {
    __shared__ float qs[256], ps[256], red[4];
    const int row = blockIdx.x, head = blockIdx.y, b = row / tpb, tid = threadIdx.x;
    qs[tid] = q[(size_t)row * D + head * XHD + tid];
    __syncthreads();
    const float* kr = K + (((size_t)b * NMEM + tid) * XH + head) * XHD;
    float s = 0.f;
    for (int d = 0; d < XHD; d += 4) { const float4 kv = *(const float4*)(kr + d); s += qs[d] * kv.x + qs[d + 1] * kv.y + qs[d + 2] * kv.z + qs[d + 3] * kv.w; }
    s *= 0.0625f;
    const float mx = block_max_256(s, red);
    const float p = expf(s - mx);
    const float sum = block_sum_256(p, red);
    ps[tid] = p / sum;
    __syncthreads();
    float o = 0.f;
    for (int m = 0; m < NMEM; ++m) o += ps[m] * V[(((size_t)b * NMEM + m) * XH + head) * XHD + tid];
    out[(size_t)row * D + head * XHD + tid] = o;
}
}
extern "C" void kernel_launch(void* const* d_in, const int* in_sizes, int n_in, void* d_out, int out_size, void* d_ws, size_t ws_size, hipStream_t stream) {
    using namespace mk;
    static int grid = 0;
    if (grid == 0) {
        int dev = 0, cus = 0;
        if (hipGetDevice(&dev) != hipSuccess || hipDeviceGetAttribute(&cus, hipDeviceAttributeMultiprocessorCount, dev) != hipSuccess) { fprintf(stderr, "kernel_launch: device query failed\n"); grid = -1; return; }
        if (hipFuncSetAttribute((const void*)mega, hipFuncAttributeMaxDynamicSharedMemorySize, LDS_BYTES) != hipSuccess) { fprintf(stderr, "kernel_launch: hipFuncSetAttribute failed\n"); grid = -1; return; }
        (void)hipGetLastError();
        grid = cus;
    }
    if (grid < 0) return;
    hipMemsetAsync((char*)d_ws + WS_CTL, 0, CTL_ZERO_BYTES, stream);
    Args a{};
    for (int i = 0; i < 24; ++i) a.in[i] = (const float*)d_in[i];
    a.out = (float*)d_out; a.ws = (unsigned char*)d_ws;
    for (int i = 0; i < 64; ++i) a.inv_freq[i] = (float)std::pow(10000.0, -(double)i / 64.0);
    int li_next = 0;
    auto run = [&](int lo, int hi) { a.ph_lo = lo; a.ph_hi = hi; a.li = li_next++; hipLaunchKernelGGL(mega, dim3(grid), dim3(NWAVES * 64), LDS_BYTES, stream, a); };
    unsigned char* ws = (unsigned char*)d_ws; float* out = (float*)d_out;
#if STEP >= 7
#ifdef PROBE_SPLIT
    run(PH_PREP, PROBE_SPLIT + 1);
#ifdef PROBE_MASK
    a.pad = PROBE_MASK;
#endif
    run(PROBE_SPLIT, PROBE_SPLIT + 1);
    a.pad = 0;
    run(PROBE_SPLIT + 1, PH_FINAL + 1);
#else
    run(PH_PREP, PH_FINAL + 1);
#endif
#else
    run(PH_PREP, PH_PREP + 1);
    run(PH_INPROJ, PH_INPROJ + 1);
#if STEP == 2
    float* bufAp = (float*)(ws + 280 * MiB);
    float* bufAs = (float*)(ws + 344 * MiB);
    float* bufB = (float*)(ws + 91 * MiB);
    for (int pass = 0; pass < 2; ++pass) {
        const int nb = pass == 0 ? NB : SB, Tn = pass == 0 ? T : ST;
        mixer_naive2<<<dim3(nb * 4, 2), 128, 0, stream>>>((const bf16_t*)(ws + WS_PB), (const float*)(ws + WS_LF), pass == 0 ? nullptr : (const float*)d_in[3], pass == 0 ? nullptr : (const float*)d_in[4],
                                                          out + (pass == 0 ? O_RETP : O_RETS), out + (pass == 0 ? O_HGP : O_HGS), pass == 0 ? bufAp : bufAs, nullptr, Tn, pass == 0 ? 0 : MP, pass == 0);
    }
    for (int pass = 0; pass < 2; ++pass) {
        const int M = pass == 0 ? MP : MS, Tn = pass == 0 ? T : ST;
        float* bufA = pass == 0 ? bufAp : bufAs;
        const float* x = (const float*)d_in[pass == 0 ? 0 : 1];
        float* y = out + O_Y + (pass == 0 ? 0 : (size_t)MP * D);
        const float* mkp = pass == 0 ? out + O_MEMK : (const float*)d_in[5]; const float* mvp = pass == 0 ? out + O_MEMV : (const float*)d_in[6];
        nv::gemm_naive<1><<<dim3(D / 64, M / 64), 256, 0, stream>>>(bufA, (const float*)d_in[12], nullptr, x, y, M, D, D);
        nv::rmsnorm_k<<<M, 256, 0, stream>>>(y, (const float*)d_in[13], bufA);
        float* qb = bufB; float* ob = bufB + (size_t)MP * D;
        nv::gemm_naive<0><<<dim3(D / 64, M / 64), 256, 0, stream>>>(bufA, (const float*)d_in[15], nullptr, nullptr, qb, M, D, D);
        nv::xattn_naive<<<dim3(M, XH), 256, 0, stream>>>(qb, mkp, mvp, ob, Tn);
        nv::gemm_naive<1><<<dim3(D / 64, M / 64), 256, 0, stream>>>(ob, (const float*)d_in[18], nullptr, y, y, M, D, D);
        nv::rmsnorm_k<<<M, 256, 0, stream>>>(y, (const float*)d_in[19], bufA);
        nv::gemm_naive<2><<<dim3(DFF / 64, M / 64), 256, 0, stream>>>(bufA, (const float*)d_in[20], (const float*)d_in[21], nullptr, bufB, M, DFF, D);
        nv::gemm_naive<1><<<dim3(D / 64, M / 64), 256, 0, stream>>>(bufB, (const float*)d_in[22], nullptr, y, y, M, D, DFF);
        nv::rmsnorm_k<<<M, 256, 0, stream>>>(y, (const float*)d_in[23], y);
    }
#else
#if STEP >= 4
    run(PH_REC, PH_REC + 1);
#else
    for (int pass = 0; pass < 2; ++pass) {
        const int nb = pass == 0 ? NB : SB, Tn = pass == 0 ? T : ST;
        mixer_naive2<<<dim3(nb * 4, 2), 128, 0, stream>>>((const bf16_t*)(ws + WS_PB), (const float*)(ws + WS_LF), pass == 0 ? nullptr : (const float*)d_in[3], pass == 0 ? nullptr : (const float*)d_in[4],
                                                          out + (pass == 0 ? O_RETP : O_RETS), out + (pass == 0 ? O_HGP : O_HGS), nullptr, (bf16_t*)(ws + WS_OB), Tn, pass == 0 ? 0 : MP, pass == 0);
    }
#endif
    run(PH_OUTPROJ, PH_OUTPROJ + 1);
    run(PH_XQ, PH_XQ + 1);
#if STEP >= 6
    run(PH_ATTN, PH_ATTN + 1);
#else
    xattn_naive2<<<dim3(MP, XH), 256, 0, stream>>>((const bf16_t*)(ws + WS_Q), (const bf16_t*)(ws + WS_MK), (const bf16_t*)(ws + WS_MV), nullptr, nullptr, (bf16_t*)(ws + WS_OB), 0, T);
    xattn_naive2<<<dim3(MS, XH), 256, 0, stream>>>((const bf16_t*)(ws + WS_Q), nullptr, nullptr, (const float*)d_in[5], (const float*)d_in[6], (bf16_t*)(ws + WS_OB), MP, ST);
#endif
    run(PH_XO, PH_XO + 1);
    run(PH_GU, PH_GU + 1);
    run(PH_DOWN, PH_DOWN + 1);
    run(PH_FINAL, PH_FINAL + 1);
#endif
#endif
}
```
